# Optimizing an MI355X kernel written in HIP

```python
import jax, jax.numpy as jnp
from jax import lax
import numpy as np

D_MODEL = 1024
BATCH = 8
SEQ = 2048
DEPTH = 1
DEC_BATCH = 128
DEC_SEQ = 4
PAST_LEN = 16384
PAGE_SIZE = 128

H_A = 8
DK_A = 128
DV_A = 64
D_QA = H_A * DK_A
D_VA = H_A * DV_A
HGRN_CHUNK = 64
H_B = 4
CH_B = 128
D_B = H_B * CH_B
CHUNK = 128
D_FF = 2816
CONV_W = 3
EPS = 1e-6

SIZES = (D_QA, D_QA, D_VA, D_VA, D_B, D_B, D_MODEL, D_MODEL)
D_IN = sum(SIZES)
SPLIT_IDX = tuple(int(s) for s in np.cumsum(SIZES)[:-1])

kernel_name = 'hgrn2_gmlp_convffn_hybrid_step'


def rms_norm(x, g):
    xf = x.astype(jnp.float32)
    y = xf * lax.rsqrt(jnp.mean(xf * xf, axis=-1, keepdims=True) + EPS)
    return (y * g.astype(jnp.float32)).astype(x.dtype)


def layer_norm(x, g, b):
    xf = x.astype(jnp.float32)
    mu = jnp.mean(xf, axis=-1, keepdims=True)
    xc = xf - mu
    y = xc * lax.rsqrt(jnp.mean(xc * xc, axis=-1, keepdims=True) + EPS)
    return (y * g.astype(jnp.float32) + b.astype(jnp.float32)).astype(x.dtype)


def hgrn2_chunk(S, q, k, i, logf):
    C = q.shape[-2]
    b = jnp.cumsum(logf, axis=-2)
    causal = jnp.tril(jnp.ones((C, C), dtype=bool))
    diff = b[..., :, None, :] - b[..., None, :, :]
    decay = jnp.exp(jnp.where(causal[:, :, None], diff, -jnp.inf))
    scores = jnp.einsum('bhtk,bhtsk,bhsk->bhts', q, decay, k)
    o = jnp.einsum('bhts,bhsv->bhtv', scores, i) + jnp.einsum('bhtk,bhkv->bhtv', q * jnp.exp(b), S)
    b_last = b[..., -1:, :]
    S_new = jnp.exp(b_last[..., 0, :])[..., None] * S + jnp.einsum('bhsk,bhsv->bhkv', k * jnp.exp(b_last - b), i)
    return S_new, o


def hgrn2_mixer(q, f_logit, i, S0, lb):
    B, L, _ = q.shape
    qf = jax.nn.silu(q.astype(jnp.float32))
    f = lb + (1.0 - lb) * jax.nn.sigmoid(f_logit.astype(jnp.float32))
    logf = jnp.log(f)
    k = 1.0 - f
    heads = lambda t, d: t.reshape(B, L, H_A, d).transpose(0, 2, 1, 3)
    qh, kh, lfh = heads(qf, DK_A), heads(k, DK_A), heads(logf, DK_A)
    ih = heads(i.astype(jnp.float32), DV_A)
    C = HGRN_CHUNK if L % HGRN_CHUNK == 0 else L
    nc = L // C
    to_chunks = lambda t: jnp.moveaxis(t.reshape(B, H_A, nc, C, t.shape[-1]), 2, 0)
    S_fin, o = lax.scan(lambda S, xs: hgrn2_chunk(S, *xs), S0.astype(jnp.float32),
                        (to_chunks(qh), to_chunks(kh), to_chunks(ih), to_chunks(lfh)))
    o = jnp.moveaxis(o, 0, 2).reshape(B, H_A, L, DV_A).transpose(0, 2, 1, 3)
    return o, S_fin


def chunk_spatial_gate(u, vn, w_s, b_s):
    B, L, _ = u.shape
    c = min(L, CHUNK)
    n = L // c
    vg = vn.reshape(B, n, c, H_B, CH_B)
    w = jnp.tril(w_s[:, :c, :c])
    s = jnp.einsum('gts,bnsgc->bntgc', w, vg) + b_s[:, :c].T[None, None, :, :, None]
    return u * s.reshape(B, L, D_B)


def decoder_layer(x, S0, conv_prev, lb, mix_pre_g, w_in, hgrn_norm_g, gmlp_ln_g, gmlp_ln_b, w_s, b_s,
                  w_pa, w_pb, w_o, mix_post_g, ffn_pre_g, w_up, conv_w, conv_b, w_down, ffn_post_g):
    B, L, _ = x.shape
    xn = rms_norm(x, mix_pre_g)
    z = xn @ w_in
    q, f_logit, i, og, u, v, ga, gb = jnp.split(z, SPLIT_IDX, axis=-1)
    oa, S_new = hgrn2_mixer(q, f_logit, i, S0, lb)
    oa = rms_norm(oa.astype(x.dtype), hgrn_norm_g) * jax.nn.silu(og.reshape(B, L, H_A, DV_A))
    oa = oa.reshape(B, L, D_VA)
    vn = layer_norm(jax.nn.gelu(v), gmlp_ln_g, gmlp_ln_b)
    ob = chunk_spatial_gate(jax.nn.gelu(u), vn, w_s, b_s)
    h = jax.nn.sigmoid(ga) * (oa @ w_pa) + jax.nn.sigmoid(gb) * (ob @ w_pb)
    x = x + rms_norm(h @ w_o, mix_post_g)
    xn = rms_norm(x, ffn_pre_g)
    up = xn @ w_up
    hp = jnp.concatenate([conv_prev.astype(up.dtype), up], axis=1)
    conv = conv_b + sum(conv_w[j] * hp[:, j:j + L] for j in range(CONV_W))
    gate, val = jnp.split(conv, 2, axis=-1)
    x = x + rms_norm((jax.nn.gelu(gate) * val) @ w_down, ffn_post_g)
    return x, S_new, hp[:, -(CONV_W - 1):], vn


def setup_inputs(seed: int = 0) -> dict:
    key = jax.random.key(seed)
    ks = jax.random.split(key, 24)
    nrm = lambda k, shape, s: jax.random.normal(k, shape, jnp.float32) * s
    gain = lambda k, shape: 1.0 + 0.05 * jax.random.normal(k, shape, jnp.float32)
    return {
        'x_prompt': nrm(ks[0], (BATCH, SEQ, D_MODEL), 1.0),
        'x_sample': nrm(ks[1], (DEC_BATCH, DEC_SEQ, D_MODEL), 1.0),
        'state_hgrn': nrm(ks[2], (DEPTH, DEC_BATCH, H_A, DK_A, DV_A), 0.5),
        'cache_ffn_conv': nrm(ks[3], (DEPTH, DEC_BATCH, CONV_W - 1, 2 * D_FF), 1.0),
        'lb_param': nrm(ks[4], (DEPTH + 1, D_QA), 0.1),
        'mix_pre_g': gain(ks[5], (DEPTH, D_MODEL)),
        'w_in': nrm(ks[6], (DEPTH, D_MODEL, D_IN), D_MODEL ** -0.5),
        'hgrn_norm_g': gain(ks[7], (DEPTH, DV_A)),
        'gmlp_ln_g': gain(ks[8], (DEPTH, D_B)),
        'gmlp_ln_b': nrm(ks[9], (DEPTH, D_B), 0.02),
        'w_s': nrm(ks[10], (DEPTH, H_B, CHUNK, CHUNK), CHUNK ** -0.5),
        'b_s': 1.0 + nrm(ks[11], (DEPTH, H_B, CHUNK), 0.1),
        'w_pa': nrm(ks[12], (DEPTH, D_VA, D_MODEL), D_VA ** -0.5),
        'w_pb': nrm(ks[13], (DEPTH, D_B, D_MODEL), D_B ** -0.5),
        'w_o': nrm(ks[14], (DEPTH, D_MODEL, D_MODEL), D_MODEL ** -0.5),
        'mix_post_g': gain(ks[15], (DEPTH, D_MODEL)),
        'ffn_pre_g': gain(ks[16], (DEPTH, D_MODEL)),
        'w_up': nrm(ks[17], (DEPTH, D_MODEL, 2 * D_FF), D_MODEL ** -0.5),
        'conv_w': nrm(ks[18], (DEPTH, CONV_W, 2 * D_FF), CONV_W ** -0.5),
        'conv_b': nrm(ks[19], (DEPTH, 2 * D_FF), 0.02),
        'w_down': nrm(ks[20], (DEPTH, D_FF, D_MODEL), D_FF ** -0.5),
        'ffn_post_g': gain(ks[21], (DEPTH, D_MODEL)),
    }


def reference(x_prompt, x_sample, state_hgrn, cache_ffn_conv, lb_param, mix_pre_g, w_in, hgrn_norm_g,
              gmlp_ln_g, gmlp_ln_b, w_s, b_s, w_pa, w_pb, w_o, mix_post_g, ffn_pre_g, w_up, conv_w,
              conv_b, w_down, ffn_post_g):
    lb_all = jnp.cumsum(jax.nn.softmax(lb_param.astype(jnp.float32), axis=0), axis=0)
    yp, ys = x_prompt, x_sample
    sp_l, ss_l, cp_l, cs_l, vs_l = [], [], [], [], []
    S_zero = jnp.zeros((x_prompt.shape[0], H_A, DK_A, DV_A), jnp.float32)
    conv_zero = jnp.zeros((x_prompt.shape[0], CONV_W - 1, 2 * D_FF), x_prompt.dtype)
    for l in range(DEPTH):
        w = (mix_pre_g[l], w_in[l], hgrn_norm_g[l], gmlp_ln_g[l], gmlp_ln_b[l], w_s[l], b_s[l],
             w_pa[l], w_pb[l], w_o[l], mix_post_g[l], ffn_pre_g[l], w_up[l], conv_w[l], conv_b[l],
             w_down[l], ffn_post_g[l])
        yp, sp, cp, _ = decoder_layer(yp, S_zero, conv_zero, lb_all[l], *w)
        ys, ss, cs, vs = decoder_layer(ys, state_hgrn[l], cache_ffn_conv[l], lb_all[l], *w)
        sp_l.append(sp); ss_l.append(ss); cp_l.append(cp); cs_l.append(cs); vs_l.append(vs)
    return (yp, ys, jnp.stack(sp_l), jnp.stack(ss_l), jnp.stack(cp_l), jnp.stack(cs_l), jnp.stack(vs_l))
```

```cpp
#include <hip/hip_runtime.h>
#include <cstdio>
#include <cstdint>
namespace pg8 {
#define PG8_LAS __attribute__((address_space(3)))
typedef unsigned short bf16_t;
typedef short bf16x8 __attribute__((ext_vector_type(8)));
typedef float f32x4 __attribute__((ext_vector_type(4)));
typedef unsigned u32x4 __attribute__((ext_vector_type(4)));
constexpr int BM = 256, BK = 64, HALF = 128, HTB = HALF * BK * 2  , STAGE_BYTES = 8 * HTB, NXCD = 8, WGM = 8;

__host__ __device__ __forceinline__ int lds_byte(int r, int c) { const int st = (r >> 4) * 2 + (c >> 5), rr = r & 15, cc = c & 31, ob = rr * 64 + cc * 2; return st * 1024 + (ob ^ (((ob >> 9) & 1) << 5)); }
__host__ __device__ __forceinline__ void stage_rc(int b, int& R, int& C) { const int st = b / 1024, sb = b % 1024, swz = sb ^ (((sb >> 9) & 1) << 5); R = (st >> 1) * 16 + swz / 64; C = (st & 1) * 32 + (swz % 64) / 2; }
__host__ __device__ __forceinline__ int perm32(int rho) { const int n = rho >> 4, i = rho & 15; return 8 * (i >> 2) + 4 * n + (i & 3); }

struct Unit { int pm, pn; };
struct Gemm { const bf16_t* A; const bf16_t* Bt; int M, N, K, lda; };

struct StaticOrder {
    int nM, nN, nwg, G, c;
    __host__ __device__ void init(int M, int N, int G_, int c_) { nM = M / BM; nN = N / BM; nwg = nM * nN; G = G_; c = c_; }
    __host__ __device__ bool next(int i, Unit& u) const {
        const long L = (long)i * G + c; if (L >= nwg) return false;
        int wgid = (int)L; { const int q = nwg / NXCD, r = nwg % NXCD, xcd = wgid % NXCD, off = wgid / NXCD; wgid = (xcd < r ? xcd * (q + 1) : r * (q + 1) + (xcd - r) * q) + off; }
        const int nig = WGM * nN, gid = wgid / nig, fm = gid * WGM, gsz = (nM - fm) < WGM ? (nM - fm) : WGM;
        u.pm = fm + ((wgid % nig) % gsz); u.pn = (wgid % nig) / gsz; return true;
    }
    __device__ __forceinline__ void a_ready(const Unit&) const {}
    __device__ __forceinline__ void done(const Unit&) const {}
};

typedef __bf16 bf16x2_t __attribute__((ext_vector_type(2)));
typedef float f32x2_t __attribute__((ext_vector_type(2)));
__device__ __forceinline__ unsigned cvt_pk_bf16(float lo, float hi) { const f32x2_t v = {lo, hi}; const bf16x2_t b = __builtin_convertvector(v, bf16x2_t); return __builtin_bit_cast(unsigned, b); }
typedef float f32x2 __attribute__((ext_vector_type(2)));
__device__ __forceinline__ f32x2 gelu_pk(f32x2 v) {
    const f32x2 av = __builtin_elementwise_abs(v), d = av * 0.2316418882f + 1.0f;
    f32x2 t; t.x = __builtin_amdgcn_rcpf(d.x); t.y = __builtin_amdgcn_rcpf(d.y);
    f32x2 q = t * 0.5307027145f + (-0.7265760135f); q = q * t + 0.7107068705f; q = q * t + (-0.142248368f); q = q * t + 0.127414796f; q = q * t;
    const f32x2 s = (v * v) * (-0.72134752044f);
    f32x2 e; e.x = __builtin_amdgcn_exp2f(s.x); e.y = __builtin_amdgcn_exp2f(s.y);
    const f32x2 m = v * (q * e), r = v - m;
    f32x2 o; o.x = v.x < 0.f ? m.x : r.x; o.y = v.y < 0.f ? m.y : r.y; return o;
}

template <int ACT  > struct EpiBf16 {
    static constexpr bool PERM = true, AFTER_DRAIN = false; static_assert(ACT == 0 || ACT == 1, "EpiBf16: ACT is 0 (none) or 1 (gelu_pk)");
    bf16_t* O; int ldc; const float* bias; int split_cols; size_t split_stride; float scale0;
    __device__ __forceinline__ void operator()(const f32x4 (&acc)[2][2][4][2], const Unit& u, int wr, int wc, int fr, int fq) const {
        const int row0 = u.pm * BM + wr * 64 + fr; int colt = u.pn * BM; bf16_t* base = O;
        float sc = 1.f; if (split_cols) { const int t = colt / split_cols; base += (size_t)t * split_stride; colt -= t * split_cols; if (t == 0) sc = scale0; }
        const int col0 = colt + wc * 32 + 8 * fq, bcol0 = u.pn * BM + wc * 32 + 8 * fq;
        f32x4 bv[2][2];
#pragma unroll
        for (int bj = 0; bj < 2; ++bj)
#pragma unroll
            for (int n = 0; n < 2; ++n) bv[bj][n] = bias ? *(const f32x4*)(bias + bcol0 + bj * HALF + 4 * n) : (f32x4){0.f, 0.f, 0.f, 0.f};
#pragma unroll
        for (int ai = 0; ai < 2; ++ai)
#pragma unroll
            for (int m = 0; m < 4; ++m) { bf16_t* rowp = base + (size_t)(row0 + ai * HALF + m * 16) * ldc + col0;
#pragma unroll
                for (int bj = 0; bj < 2; ++bj) { f32x4 v0 = acc[ai][bj][m][0] + bv[bj][0], v1 = acc[ai][bj][m][1] + bv[bj][1];
                    if (ACT == 1) { f32x2 a = gelu_pk((f32x2){v0[0], v0[1]}), b = gelu_pk((f32x2){v0[2], v0[3]}), c = gelu_pk((f32x2){v1[0], v1[1]}), d = gelu_pk((f32x2){v1[2], v1[3]});
                        v0 = (f32x4){a.x, a.y, b.x, b.y}; v1 = (f32x4){c.x, c.y, d.x, d.y}; }
                    v0 = v0 * sc; v1 = v1 * sc; u32x4 w; w.x = cvt_pk_bf16(v0[0], v0[1]); w.y = cvt_pk_bf16(v0[2], v0[3]); w.z = cvt_pk_bf16(v1[0], v1[1]); w.w = cvt_pk_bf16(v1[2], v1[3]);
                    *(u32x4*)(rowp + bj * HALF) = w; } }
    }
};

template <class Epi, class Sched, bool ALIGN_EPI = false, bool SP2 = false>
__device__ __forceinline__ void gemm_phase(PG8_LAS unsigned char* lds, const Gemm g, const Sched& S, const Epi& E) {
    const int tid = threadIdx.x, wid = __builtin_amdgcn_readfirstlane(tid >> 6), lane = tid & 63, wr = wid >> 2, wc = wid & 3, fr = lane & 15, fq = lane >> 4;
    const int K = g.K, nt = K / BK;
    unsigned voffA[2], voffB[2];
#pragma unroll
    for (int i = 0; i < 2; ++i) { int R, C; stage_rc(tid * 16 + i * 8192, R, C); const int Rb = Epi::PERM ? ((R & ~31) + perm32(R & 31)) : R;
        voffA[i] = (unsigned)(R * g.lda + C) * 2u; voffB[i] = (unsigned)(Rb * K + C) * 2u; }
    const size_t kstep = (size_t)(BK * 2);
    const size_t hstepA = (size_t)HALF * g.lda * 2, hstepB = (size_t)HALF * K * 2;
    const size_t tstepA = 2 * hstepA, tstepB = 2 * hstepB;
    const unsigned ldsw = (unsigned)wid * 1024u;
    const int aoff = lds_byte(wr * 64 + fr, fq * 8), boff = lds_byte(wc * 32 + fr, fq * 8);
#define PG8_SA(b, h) (((b) * 2 + (h)) * HTB)
#define PG8_SB(b, h) ((4 + (b) * 2 + (h)) * HTB)
#define PG8_STAGE(bufoff, gbase, voff) do { _Pragma("unroll") for (int _i = 0; _i < 2; ++_i) \
        __builtin_amdgcn_global_load_lds((const unsigned*)((const char*)(gbase) + (voff)[_i]), (PG8_LAS unsigned*)(lds + (bufoff) + ldsw + _i * 8192), 16, 0, 0); } while (0)
#define PG8_LDA(dst, b, h) do { _Pragma("unroll") for (int m = 0; m < 4; ++m) _Pragma("unroll") for (int k = 0; k < 2; ++k) dst[m][k] = *(const PG8_LAS bf16x8*)(lds + PG8_SA(b, h) + aoff + m * 2048 + k * 1024); } while (0)
#define PG8_LDB(dst, b, h) do { _Pragma("unroll") for (int n = 0; n < 2; ++n) _Pragma("unroll") for (int k = 0; k < 2; ++k) dst[n][k] = *(const PG8_LAS bf16x8*)(lds + PG8_SB(b, h) + boff + n * 2048 + k * 1024); } while (0)
#define PG8_MMA(ai, bj, At, Bt) do { __builtin_amdgcn_s_setprio(1); _Pragma("unroll") for (int m = 0; m < 4; ++m) _Pragma("unroll") for (int n = 0; n < 2; ++n) _Pragma("unroll") for (int k = 0; k < 2; ++k) \
        acc[ai][bj][m][n] = __builtin_amdgcn_mfma_f32_16x16x32_bf16(Bt[n][k], At[m][k], acc[ai][bj][m][n], 0, 0, 0); __builtin_amdgcn_s_setprio(0); } while (0)
#define PG8_WAIT_V(n) asm volatile("s_waitcnt vmcnt(" #n ")" ::: "memory")
#define PG8_WAIT_L(n) asm volatile("s_waitcnt lgkmcnt(" #n ")" ::: "memory")
#define PG8_BAR __builtin_amdgcn_s_barrier()
#define PG8_SCHED __builtin_amdgcn_sched_barrier(0)
    Unit cur, nxt; int ui = 0;
    if (!S.next(0, cur)) return;
    f32x4 acc[2][2][4][2];
#pragma unroll
    for (int a = 0; a < 2; ++a)
#pragma unroll
        for (int b = 0; b < 2; ++b)
#pragma unroll
            for (int m = 0; m < 4; ++m)
#pragma unroll
                for (int n = 0; n < 2; ++n) acc[a][b][m][n] = (f32x4){0.f, 0.f, 0.f, 0.f};
    bf16x8 At[4][2], B0[2][2], B1[2][2];
    const char* cA = (const char*)g.A + (size_t)cur.pm * tstepA; const char* cB = (const char*)g.Bt + (size_t)cur.pn * tstepB;
    S.a_ready(cur);
    if constexpr (SP2) {
        PG8_STAGE(PG8_SB(0, 0), cB, voffB); PG8_STAGE(PG8_SB(0, 1), cB + hstepB, voffB); PG8_STAGE(PG8_SA(0, 0), cA, voffA); PG8_STAGE(PG8_SA(0, 1), cA + hstepA, voffA);
        if (wr == 1) PG8_BAR;
        PG8_WAIT_V(2); PG8_BAR;
        PG8_STAGE(PG8_SB(1, 0), cB + kstep, voffB); PG8_STAGE(PG8_SA(1, 0), cA + kstep, voffA); PG8_STAGE(PG8_SB(1, 1), cB + hstepB + kstep, voffB);
        PG8_WAIT_V(6); PG8_BAR;
    } else {
        PG8_STAGE(PG8_SB(0, 0), cB, voffB); PG8_STAGE(PG8_SA(0, 0), cA, voffA); PG8_STAGE(PG8_SB(0, 1), cB + hstepB, voffB); PG8_STAGE(PG8_SA(0, 1), cA + hstepA, voffA);
        if (wr == 1) PG8_BAR;
        PG8_WAIT_V(4); PG8_BAR;
        PG8_STAGE(PG8_SB(1, 0), cB + kstep, voffB); PG8_STAGE(PG8_SA(1, 0), cA + kstep, voffA); PG8_STAGE(PG8_SB(1, 1), cB + hstepB + kstep, voffB);
        PG8_WAIT_V(6); PG8_BAR;
    }
    for (;;) {
        const bool has_next = S.next(ui + 1, nxt);
        const char* nA = has_next ? (const char*)g.A + (size_t)nxt.pm * tstepA : cA; const char* nB = has_next ? (const char*)g.Bt + (size_t)nxt.pn * tstepB : cB;
        for (int t = 0; t < nt; t += 2) {
            const bool last = (t == nt - 2);
            const char* a1 = cA + (size_t)(t + 1) * kstep;
            const char* a2 = last ? nA : cA + (size_t)(t + 2) * kstep; const char* b2 = last ? nB : cB + (size_t)(t + 2) * kstep;
            const char* a3 = a2 + kstep; const char* b3 = b2 + kstep;
            if (last && has_next) S.a_ready(nxt);
            if constexpr (SP2) {
            PG8_LDB(B0, 0, 0); PG8_LDB(B1, 0, 1); PG8_SCHED; PG8_LDA(At, 0, 0); PG8_STAGE(PG8_SA(1, 1), a1 + hstepA, voffA);
            PG8_WAIT_V(8); PG8_WAIT_L(0); PG8_BAR; PG8_MMA(0, 0, At, B0); PG8_MMA(0, 1, At, B1); PG8_BAR; PG8_SCHED;
            PG8_LDA(At, 0, 1); PG8_STAGE(PG8_SB(0, 0), b2, voffB); PG8_STAGE(PG8_SB(0, 1), b2 + hstepB, voffB); PG8_STAGE(PG8_SA(0, 0), a2, voffA);
            PG8_WAIT_V(8); PG8_WAIT_L(0); PG8_BAR; PG8_MMA(1, 0, At, B0); PG8_MMA(1, 1, At, B1); PG8_BAR; PG8_SCHED;
            PG8_LDB(B0, 1, 0); PG8_LDB(B1, 1, 1); PG8_SCHED; PG8_LDA(At, 1, 0); PG8_STAGE(PG8_SA(0, 1), a2 + hstepA, voffA);
            PG8_WAIT_V(8); PG8_WAIT_L(0); PG8_BAR; PG8_MMA(0, 0, At, B0); PG8_MMA(0, 1, At, B1); PG8_BAR; PG8_SCHED;
            PG8_LDA(At, 1, 1); PG8_STAGE(PG8_SB(1, 0), b3, voffB); PG8_STAGE(PG8_SB(1, 1), b3 + hstepB, voffB); PG8_STAGE(PG8_SA(1, 0), a3, voffA);
            PG8_WAIT_V(8); PG8_WAIT_L(0); PG8_BAR; PG8_MMA(1, 0, At, B0); PG8_MMA(1, 1, At, B1); PG8_BAR; PG8_SCHED;
            } else {
            PG8_LDB(B0, 0, 0); PG8_SCHED; PG8_LDA(At, 0, 0); PG8_STAGE(PG8_SA(1, 1), a1 + hstepA, voffA);
            PG8_WAIT_L(8); PG8_BAR; PG8_WAIT_L(0); PG8_MMA(0, 0, At, B0); PG8_BAR; PG8_SCHED;
            PG8_LDB(B1, 0, 1); PG8_STAGE(PG8_SB(0, 0), b2, voffB);
            PG8_BAR; PG8_WAIT_L(0); PG8_MMA(0, 1, At, B1); PG8_BAR;
            PG8_LDA(At, 0, 1); PG8_STAGE(PG8_SA(0, 0), a2, voffA);
            PG8_BAR; PG8_WAIT_L(0); PG8_MMA(1, 0, At, B0); PG8_BAR; PG8_SCHED;
            PG8_STAGE(PG8_SB(0, 1), b2 + hstepB, voffB);
            PG8_WAIT_V(6); PG8_BAR; PG8_MMA(1, 1, At, B1); PG8_BAR;
            PG8_LDB(B0, 1, 0); PG8_SCHED; PG8_LDA(At, 1, 0); PG8_STAGE(PG8_SA(0, 1), a2 + hstepA, voffA);
            PG8_WAIT_L(8); PG8_BAR; PG8_WAIT_L(0); PG8_MMA(0, 0, At, B0); PG8_BAR; PG8_SCHED;
            PG8_LDB(B1, 1, 1); PG8_STAGE(PG8_SB(1, 0), b3, voffB);
            PG8_BAR; PG8_WAIT_L(0); PG8_MMA(0, 1, At, B1); PG8_BAR;
            PG8_LDA(At, 1, 1); PG8_STAGE(PG8_SA(1, 0), a3, voffA);
            PG8_BAR; PG8_WAIT_L(0); PG8_MMA(1, 0, At, B0); PG8_BAR; PG8_SCHED;
            PG8_STAGE(PG8_SB(1, 1), b3 + hstepB, voffB);
            PG8_WAIT_V(6); PG8_BAR; PG8_MMA(1, 1, At, B1); PG8_BAR;
            }
        }
        if constexpr (ALIGN_EPI) { if (wr == 0) PG8_BAR; }
        if constexpr (!Epi::AFTER_DRAIN) { E(acc, cur, wr, wc, fr, fq); S.done(cur); }
        if (!has_next) break;
#pragma unroll
        for (int a = 0; a < 2; ++a)
#pragma unroll
            for (int b = 0; b < 2; ++b)
#pragma unroll
                for (int m = 0; m < 4; ++m)
#pragma unroll
                    for (int n = 0; n < 2; ++n) acc[a][b][m][n] = (f32x4){0.f, 0.f, 0.f, 0.f};
        cur = nxt; cA = nA; cB = nB; ++ui;
        if constexpr (ALIGN_EPI) { if (wr == 1) PG8_BAR; }
    }
    PG8_WAIT_V(0);
    if constexpr (!ALIGN_EPI) { if (wr == 0) PG8_BAR; }
    PG8_BAR;
    if constexpr (Epi::AFTER_DRAIN) { E.fused(acc, cur, wr, wc, fr, fq, lds, wid, lane); S.done(cur); }
#undef PG8_SA
#undef PG8_SB
#undef PG8_STAGE
#undef PG8_LDA
#undef PG8_LDB
#undef PG8_MMA
#undef PG8_WAIT_V
#undef PG8_WAIT_L
#undef PG8_BAR
#undef PG8_SCHED
}
struct EpiF32 {
    static constexpr bool PERM = false, AFTER_DRAIN = false;
    float* C; int ldc;
    __device__ __forceinline__ void operator()(const f32x4 (&acc)[2][2][4][2], const Unit& u, int wr, int wc, int fr, int fq) const {
        const int row0 = u.pm * BM + wr * 64 + fr, col0 = u.pn * BM + wc * 32 + 4 * fq;
#pragma unroll
        for (int ai = 0; ai < 2; ++ai)
#pragma unroll
            for (int m = 0; m < 4; ++m) { float* rowp = C + (size_t)(row0 + ai * HALF + m * 16) * ldc + col0;
#pragma unroll
                for (int bj = 0; bj < 2; ++bj)
#pragma unroll
                    for (int n = 0; n < 2; ++n) *(f32x4*)(rowp + bj * HALF + n * 16) = acc[ai][bj][m][n]; }
    }
};
__device__ __forceinline__ float bf_lo(unsigned w) { return __uint_as_float(w << 16); }
__device__ __forceinline__ float bf_hi(unsigned w) { return __uint_as_float(w & 0xffff0000u); }
__device__ __forceinline__ float sigm(float x) { return __builtin_amdgcn_rcpf(1.0f + __builtin_amdgcn_exp2f(-1.4426950408889634f * x)); }
template <int MODE> __device__ __forceinline__ float zact(float x, float lb) {
    if (MODE == 0) return x * sigm(x);
    if (MODE == 1) { const float f = lb + (1.0f - lb) * sigm(x); return 0.6931471805599453f * __builtin_amdgcn_logf(f); }
    if (MODE == 2) return x;
    if (MODE == 3) return x * sigm(1.5957691216057308f * (x + 0.044715f * x * x * x));
    return sigm(x);
}
struct EpiZ {
    static constexpr bool PERM = true, AFTER_DRAIN = false;
    bf16_t* Z; const float* lb;
    template <int MODE> __device__ __forceinline__ void run(const f32x4 (&acc)[2][2][4][2], const Unit& u, int wr, int wc, int fr, int fq) const {
        const int row0 = u.pm * BM + wr * 64 + fr, col0 = u.pn * BM + wc * 32 + 8 * fq;
        f32x4 lv[2][2];
#pragma unroll
        for (int bj = 0; bj < 2; ++bj)
#pragma unroll
            for (int n = 0; n < 2; ++n) lv[bj][n] = (MODE == 1) ? *(const f32x4*)(lb + (col0 - 1024) + bj * HALF + 4 * n) : (f32x4){0.f, 0.f, 0.f, 0.f};
#pragma unroll
        for (int ai = 0; ai < 2; ++ai)
#pragma unroll
            for (int m = 0; m < 4; ++m) { bf16_t* rowp = Z + (size_t)(row0 + ai * HALF + m * 16) * 6144 + col0;
#pragma unroll
                for (int bj = 0; bj < 2; ++bj) { const f32x4 a = acc[ai][bj][m][0], b = acc[ai][bj][m][1]; const f32x4 l0 = lv[bj][0], l1 = lv[bj][1];
                    u32x4 w; w.x = cvt_pk_bf16(zact<MODE>(a[0], l0[0]), zact<MODE>(a[1], l0[1])); w.y = cvt_pk_bf16(zact<MODE>(a[2], l0[2]), zact<MODE>(a[3], l0[3]));
                    w.z = cvt_pk_bf16(zact<MODE>(b[0], l1[0]), zact<MODE>(b[1], l1[1])); w.w = cvt_pk_bf16(zact<MODE>(b[2], l1[2]), zact<MODE>(b[3], l1[3]));
                    *(u32x4*)(rowp + bj * HALF) = w; } }
    }
    __device__ __forceinline__ void operator()(const f32x4 (&acc)[2][2][4][2], const Unit& u, int wr, int wc, int fr, int fq) const {
        const int pn = u.pn;
        if (pn < 4) run<0>(acc, u, wr, wc, fr, fq);
        else if (pn < 8) run<1>(acc, u, wr, wc, fr, fq);
        else if (pn < 10) run<2>(acc, u, wr, wc, fr, fq);
        else if (pn < 12) run<0>(acc, u, wr, wc, fr, fq);
        else if (pn < 16) run<3>(acc, u, wr, wc, fr, fq);
        else run<4>(acc, u, wr, wc, fr, fq);
    }
};
struct EpiGateF32 {
    static constexpr bool PERM = true, AFTER_DRAIN = false;
    float* C; const bf16_t* Z; int gcol;
    __device__ __forceinline__ void operator()(const f32x4 (&acc)[2][2][4][2], const Unit& u, int wr, int wc, int fr, int fq) const {
        const int row0 = u.pm * BM + wr * 64 + fr, col0 = u.pn * BM + wc * 32 + 8 * fq;
#pragma unroll
        for (int ai = 0; ai < 2; ++ai)
#pragma unroll
            for (int m = 0; m < 4; ++m) { const size_t r = (size_t)(row0 + ai * HALF + m * 16);
#pragma unroll
                for (int bj = 0; bj < 2; ++bj) { const u32x4 gw = *(const u32x4*)(Z + r * 6144 + gcol + col0 + bj * HALF);
                    const f32x4 a = acc[ai][bj][m][0], b = acc[ai][bj][m][1];
                    f32x4 o0, o1; o0[0] = a[0] * bf_lo(gw.x); o0[1] = a[1] * bf_hi(gw.x); o0[2] = a[2] * bf_lo(gw.y); o0[3] = a[3] * bf_hi(gw.y);
                    o1[0] = b[0] * bf_lo(gw.z); o1[1] = b[1] * bf_hi(gw.z); o1[2] = b[2] * bf_lo(gw.w); o1[3] = b[3] * bf_hi(gw.w);
                    float* p = C + r * 1024 + col0 + bj * HALF; *(f32x4*)p = o0; *(f32x4*)(p + 4) = o1; } }
    }
};
struct EpiComb {
    static constexpr bool PERM = true, AFTER_DRAIN = false;
    bf16_t* H; const float* Hf; const bf16_t* Z; int gcol;
    __device__ __forceinline__ void operator()(const f32x4 (&acc)[2][2][4][2], const Unit& u, int wr, int wc, int fr, int fq) const {
        const int row0 = u.pm * BM + wr * 64 + fr, col0 = u.pn * BM + wc * 32 + 8 * fq;
#pragma unroll
        for (int ai = 0; ai < 2; ++ai)
#pragma unroll
            for (int m = 0; m < 4; ++m) { const size_t r = (size_t)(row0 + ai * HALF + m * 16);
#pragma unroll
                for (int bj = 0; bj < 2; ++bj) { const u32x4 gw = *(const u32x4*)(Z + r * 6144 + gcol + col0 + bj * HALF);
                    const float* hp = Hf + r * 1024 + col0 + bj * HALF; const f32x4 h0 = *(const f32x4*)hp, h1 = *(const f32x4*)(hp + 4);
                    const f32x4 a = acc[ai][bj][m][0], b = acc[ai][bj][m][1];
                    u32x4 w; w.x = cvt_pk_bf16(h0[0] + a[0] * bf_lo(gw.x), h0[1] + a[1] * bf_hi(gw.x)); w.y = cvt_pk_bf16(h0[2] + a[2] * bf_lo(gw.y), h0[3] + a[3] * bf_hi(gw.y));
                    w.z = cvt_pk_bf16(h1[0] + b[0] * bf_lo(gw.z), h1[1] + b[1] * bf_hi(gw.z)); w.w = cvt_pk_bf16(h1[2] + b[2] * bf_lo(gw.w), h1[3] + b[3] * bf_hi(gw.w));
                    *(u32x4*)(H + r * 1024 + col0 + bj * HALF) = w; } }
    }
};
}
constexpr int NWAVES = 8, NT = 512;
constexpr int MP = 16384, MS = 512, M = MP + MS;
constexpr int D = 1024, DIN = 6144, FF = 2816, FF2 = 5632;
constexpr int ZQ = 0, ZF = 1024, ZI = 2048, ZOG = 2560, ZU = 3072, ZV = 3584, ZGA = 4096, ZGB = 5120;
constexpr float EPS = 1e-6f;
constexpr size_t O_YP = 0, O_YS = 16777216, O_SP = 17301504, O_SS = 17825792, O_CP = 26214400, O_CS = 26304512, O_VS = 27746304, O_END = 28008448;
constexpr size_t MiB = 1u << 20, KiB = 1u << 10;
constexpr size_t WS_CTL = 0, CTL_ZERO_BYTES = 1 * MiB;
constexpr size_t WS_WIN = 1 * MiB, WS_WPA = 13 * MiB, WS_WPB = 14 * MiB, WS_WO = 15 * MiB, WS_WUP = 17 * MiB, WS_WDN = 28 * MiB;
constexpr size_t WS_LB = 33 * MiB + 512 * KiB;
constexpr size_t WS_XN = 34 * MiB;
constexpr size_t WS_Z = 67 * MiB;
constexpr size_t WS_OA = 265 * MiB, WS_OB = 281 * MiB + 512 * KiB;
constexpr size_t WS_HF = 298 * MiB;
constexpr size_t WS_H = 364 * MiB;
constexpr size_t WS_Y = 67 * MiB;
constexpr size_t WS_UP = 133 * MiB;
constexpr size_t WS_G = 314 * MiB + 512 * KiB;
constexpr size_t WS_END = 406 * MiB;
constexpr int CW_BAR = 4096;

constexpr int RING_OFF = 0, RING_BYTES = 131072;
constexpr int LDSCTL_OFF = RING_BYTES, MISC_OFF = LDSCTL_OFF + 320;
constexpr int AUX_OFF = RING_BYTES + 1024;
constexpr int LDS_BYTES = 147456;

#define GAS __attribute__((address_space(1)))
#define LAS __attribute__((address_space(3)))
typedef unsigned short bf16;
typedef unsigned v4u __attribute__((ext_vector_type(4)));
typedef unsigned v2u __attribute__((ext_vector_type(2)));
typedef float f32x4 __attribute__((ext_vector_type(4)));
#define LDS_WAIT() asm volatile("s_waitcnt lgkmcnt(0)" ::: "memory")
__device__ __forceinline__ unsigned f2bf(float f) { unsigned u = __builtin_bit_cast(unsigned, f); return (u + 0x7fffu + ((u >> 16) & 1u)) >> 16; }
__device__ __forceinline__ unsigned pk2(float lo, float hi) { return f2bf(lo) | (f2bf(hi) << 16); }
__device__ __forceinline__ float bf2f(unsigned short h) { return __uint_as_float(((unsigned)h) << 16); }
__device__ __forceinline__ float bflo(unsigned w) { return __uint_as_float(w << 16); }
__device__ __forceinline__ float bfhi(unsigned w) { return __uint_as_float(w & 0xffff0000u); }
__device__ __forceinline__ float wave_sum(float v) {
#pragma unroll
    for (int o = 1; o < 64; o <<= 1) v += __shfl_xor(v, o);
    return v;
}

#define XB_TMO      128
#define XB_XCNT(j)  (256  + 64 * (j))
#define XB_XSUB(j)  (1280 + 64 * (j))
#define XB_XGEN(j)  (2304 + 64 * (j))
#define XB_TOP      3328
#define XB_TOPGEN   3392
#define XCD_BAR_WORDS 3456
#define XB_SPIN_CAP (1u << 18)
__device__ __forceinline__ unsigned xb_ld(unsigned* p)              { return __hip_atomic_load(p, __ATOMIC_RELAXED, __HIP_MEMORY_SCOPE_AGENT); }
__device__ __forceinline__ unsigned xb_add(unsigned* p, unsigned v) { return __hip_atomic_fetch_add(p, v, __ATOMIC_RELAXED, __HIP_MEMORY_SCOPE_AGENT); }
__device__ __forceinline__ unsigned xb_xcc_id() { return (unsigned)__builtin_amdgcn_s_getreg((3 << 11) | 20) & 0xFu; }
#define XB_SPIN(cond, bar) do { unsigned _sp = 0; while (cond) { __builtin_amdgcn_s_sleep(1); \
    if ((++_sp & 255u) == 0u) { if (xb_ld(&(bar)[XB_TMO])) break; if (_sp > XB_SPIN_CAP) { atomicAdd(&(bar)[XB_TMO], 1u); break; } } } } while (0)
struct XcdBarrier { unsigned* bar; unsigned x; volatile LAS unsigned* st; };
__device__ __forceinline__ XcdBarrier xcd_barrier_post(unsigned* bar, volatile LAS unsigned* st) {
    XcdBarrier b; b.bar = bar; b.x = xb_xcc_id(); b.st = st;
    if (threadIdx.x == 0) (void)xb_add(&bar[XB_XCNT(b.x)], 1u);
    return b;
}
__device__ __forceinline__ void xcd_barrier_complete(unsigned* bar, unsigned x, unsigned& nloc, unsigned& nx) {
    const unsigned G = gridDim.x * gridDim.y * gridDim.z;
    unsigned sum, cnt, mine, sp = 0u;
    for (;;) {
        sum = 0u; cnt = 0u; mine = 0u;
#pragma unroll
        for (unsigned j = 0; j < 16; ++j) { const unsigned c = xb_ld(&bar[XB_XCNT(j)]); sum += c; cnt += (c > 0u) ? 1u : 0u; mine = (j == x) ? c : mine; }
        if (sum == G) break;
        __builtin_amdgcn_s_sleep(1);
        if ((++sp & 255u) == 0u) { if (xb_ld(&bar[XB_TMO])) break; if (sp > XB_SPIN_CAP) { atomicAdd(&bar[XB_TMO], 1u); break; } }
    }
    nloc = mine > 0u ? mine : 1u; nx = cnt > 0u ? cnt : 1u;
}
__device__ __forceinline__ void xcd_barrier(const XcdBarrier& b) {
    asm volatile("s_waitcnt vmcnt(0)" ::: "memory");
    __syncthreads();
    if (threadIdx.x == 0) {
        unsigned* bar = b.bar;
        __builtin_amdgcn_s_waitcnt(0);
        unsigned nloc = b.st[0], nx = b.st[1];
        if (nloc == 0u) { xcd_barrier_complete(bar, b.x, nloc, nx); b.st[0] = nloc; b.st[1] = nx; }
        const unsigned old = xb_add(&bar[XB_XSUB(b.x)], 1u);
        const unsigned gen = old / nloc;
        if (old + 1u == (gen + 1u) * nloc) {
            __builtin_amdgcn_fence(__ATOMIC_RELEASE, "agent");
            asm volatile("s_waitcnt vmcnt(0)" ::: "memory");
            const unsigned og = xb_add(&bar[XB_TOP], 1u);
            const unsigned tg = og / nx;
            if (og + 1u == (tg + 1u) * nx) xb_add(&bar[XB_TOPGEN], 1u);
            else XB_SPIN(xb_ld(&bar[XB_TOPGEN]) == tg, bar);
            __builtin_amdgcn_fence(__ATOMIC_ACQUIRE, "agent");
            xb_add(&bar[XB_XGEN(b.x)], 1u);
            asm volatile("s_waitcnt vmcnt(0)" ::: "memory");
        } else {
            XB_SPIN(xb_ld(&bar[XB_XGEN(b.x)]) == gen, bar);
            __builtin_amdgcn_fence(__ATOMIC_ACQUIRE, "agent");
            asm volatile("s_waitcnt vmcnt(0)" ::: "memory");
        }
    }
    __syncthreads();
}

__device__ __forceinline__ void p0_transpose_item(const float* W, int N, bf16* WT, int ldwt, int koff, LAS float* scr, int item, int lane) {
    const int nblk = N / 32, kb = item / nblk, nb = item % nblk, k0 = 64 * kb, n0 = 32 * nb;
#pragma unroll 8
    for (int i = 0; i < 32; ++i) { const int kk = 2 * i + (lane >> 5); scr[kk * 33 + (lane & 31)] = W[(size_t)(k0 + kk) * N + n0 + (lane & 31)]; }
    LDS_WAIT(); asm volatile("" ::: "memory");
    const int c = lane & 7;
#pragma unroll
    for (int j = 0; j < 4; ++j) { const int n = (lane >> 3) + 8 * j; const LAS float* s = scr + (8 * c) * 33 + n;
        v4u o; o.x = pk2(s[0 * 33], s[1 * 33]); o.y = pk2(s[2 * 33], s[3 * 33]); o.z = pk2(s[4 * 33], s[5 * 33]); o.w = pk2(s[6 * 33], s[7 * 33]);
        *(GAS v4u*)(WT + (size_t)(n0 + n) * ldwt + koff + k0 + 8 * c) = o; }
    LDS_WAIT(); asm volatile("" ::: "memory");
}
__device__ __forceinline__ void rms_row_to_bf16(const float* xrow, const float* g, bf16* orow, int lane) {
    const GAS f32x4* xr = (const GAS f32x4*)xrow + lane; const GAS f32x4* gr = (const GAS f32x4*)g + lane;
    f32x4 v[4]; float s = 0.f;
#pragma unroll
    for (int j = 0; j < 4; ++j) { v[j] = xr[64 * j]; s += (v[j].x * v[j].x + v[j].y * v[j].y) + (v[j].z * v[j].z + v[j].w * v[j].w); }
    const float r = 1.0f / sqrtf(wave_sum(s) * (1.f / D) + EPS);
    GAS v2u* o8 = (GAS v2u*)orow + lane;
#pragma unroll
    for (int j = 0; j < 4; ++j) { const f32x4 gg = gr[64 * j]; v2u o; o.x = pk2(v[j].x * r * gg.x, v[j].y * r * gg.y); o.y = pk2(v[j].z * r * gg.z, v[j].w * r * gg.w); o8[64 * j] = o; }
}
constexpr int HG_TB = 16;
__device__ __forceinline__ void hgrn_recurrent(LAS unsigned char* lds, const bf16* Z, int row0, int T, int h, const float* S0, float* Sout, bf16* OA, const float* ng, int tid) {
    LAS float* Lq = (LAS float*)lds;
    LAS float* Lf = Lq + HG_TB * 128;
    LAS float* Li = Lf + HG_TB * 128;
    LAS float* Lo = Li + HG_TB * 64;
    const int lane = tid & 63, kg = tid >> 6;
    float S[16];
#pragma unroll
    for (int j = 0; j < 16; ++j) S[j] = S0 ? S0[(size_t)(16 * kg + j) * 64 + lane] : 0.f;
    const float gn = ng[lane];
    for (int t0 = 0; t0 < T; t0 += HG_TB) {
        const int nb = (T - t0) < HG_TB ? (T - t0) : HG_TB;
        for (int idx = tid; idx < nb * 128; idx += NT) { const int t = idx >> 7, k = idx & 127; const bf16* zr = Z + (size_t)(row0 + t0 + t) * DIN;
            Lq[idx] = bf2f(zr[ZQ + h * 128 + k]); Lf[idx] = __expf(bf2f(zr[ZF + h * 128 + k])); }
        for (int idx = tid; idx < nb * 64; idx += NT) { const int t = idx >> 6, v = idx & 63; Li[idx] = bf2f(Z[(size_t)(row0 + t0 + t) * DIN + ZI + h * 64 + v]); }
        __syncthreads();
        for (int t = 0; t < nb; ++t) {
            const float iv = Li[t * 64 + lane]; float o = 0.f;
#pragma unroll
            for (int jj = 0; jj < 4; ++jj) { const f32x4 f4 = *(const LAS f32x4*)(Lf + t * 128 + 16 * kg + 4 * jj), q4 = *(const LAS f32x4*)(Lq + t * 128 + 16 * kg + 4 * jj);
#pragma unroll
                for (int e = 0; e < 4; ++e) { const float f = f4[e]; S[4 * jj + e] = f * S[4 * jj + e] + (1.0f - f) * iv; o += q4[e] * S[4 * jj + e]; } }
            Lo[(t * 8 + kg) * 64 + lane] = o;
        }
        __syncthreads();
        for (int t = kg; t < nb; t += 8) {
            float o = 0.f;
#pragma unroll
            for (int w = 0; w < 8; ++w) o += Lo[(t * 8 + w) * 64 + lane];
            const float r = 1.0f / sqrtf(wave_sum(o * o) * (1.f / 64.f) + EPS);
            const size_t row = (size_t)(row0 + t0 + t);
            const float gs = bf2f(Z[row * DIN + ZOG + h * 64 + lane]);
            OA[row * 512 + h * 64 + lane] = (bf16)f2bf(o * r * gn * gs);
        }
    }
    if (Sout) {
#pragma unroll
        for (int j = 0; j < 16; ++j) Sout[(size_t)(16 * kg + j) * 64 + lane] = S[j];
    }
    __syncthreads();
}

__device__ __forceinline__ void gmlp_prompt_item(LAS unsigned char* lds, const bf16* Z, int r0, int g, const float* lng, const float* lnb, const float* ws, const float* bs, bf16* OB, int tid) {
    LAS float* VN = (LAS float*)lds;
    LAS float* WT = VN + 128 * 128;
    LAS float* ST = (LAS float*)(lds + AUX_OFF);
    const int lane = tid & 63, wave = tid >> 6;
    for (int rr = 0; rr < 16; ++rr) { const int row = 16 * wave + rr; const v4u w = *(const GAS v4u*)(Z + (size_t)(r0 + row) * DIN + ZV + 8 * lane);
        const float a0 = bflo(w.x), a1 = bfhi(w.x), a2 = bflo(w.y), a3 = bfhi(w.y), a4 = bflo(w.z), a5 = bfhi(w.z), a6 = bflo(w.w), a7 = bfhi(w.w);
        const float s = wave_sum(((a0 + a1) + (a2 + a3)) + ((a4 + a5) + (a6 + a7)));
        const float mean = s * (1.f / 512.f);
        const float d0 = a0 - mean, d1 = a1 - mean, d2 = a2 - mean, d3 = a3 - mean, d4 = a4 - mean, d5 = a5 - mean, d6 = a6 - mean, d7 = a7 - mean;
        const float q = wave_sum(((d0 * d0 + d1 * d1) + (d2 * d2 + d3 * d3)) + ((d4 * d4 + d5 * d5) + (d6 * d6 + d7 * d7)));
        if (lane == 0) { ST[2 * row] = mean; ST[2 * row + 1] = 1.0f / sqrtf(q * (1.f / 512.f) + EPS); } }
    const float* wg = ws + (size_t)g * 128 * 128;
    for (int idx = tid; idx < 128 * 32; idx += NT) { const int t = idx >> 5, s4 = (idx & 31) * 4; const f32x4 w = *(const GAS f32x4*)(wg + t * 128 + s4);
#pragma unroll
        for (int e = 0; e < 4; ++e) WT[(s4 + e) * 128 + t] = (s4 + e <= t) ? w[e] : 0.f; }
    __syncthreads();
    for (int idx = tid; idx < 128 * 16; idx += NT) { const int row = idx >> 4, oc = idx & 15; const v4u w = *(const GAS v4u*)(Z + (size_t)(r0 + row) * DIN + ZV + 128 * g + 8 * oc);
        const float mean = ST[2 * row], rstd = ST[2 * row + 1]; const float* gp = lng + 128 * g + 8 * oc; const float* bp = lnb + 128 * g + 8 * oc;
        f32x4 o0, o1; o0[0] = (bflo(w.x) - mean) * rstd * gp[0] + bp[0]; o0[1] = (bfhi(w.x) - mean) * rstd * gp[1] + bp[1]; o0[2] = (bflo(w.y) - mean) * rstd * gp[2] + bp[2]; o0[3] = (bfhi(w.y) - mean) * rstd * gp[3] + bp[3];
        o1[0] = (bflo(w.z) - mean) * rstd * gp[4] + bp[4]; o1[1] = (bfhi(w.z) - mean) * rstd * gp[5] + bp[5]; o1[2] = (bflo(w.w) - mean) * rstd * gp[6] + bp[6]; o1[3] = (bfhi(w.w) - mean) * rstd * gp[7] + bp[7];
        *(LAS f32x4*)(VN + row * 128 + 8 * oc) = o0; *(LAS f32x4*)(VN + row * 128 + 8 * oc + 4) = o1; }
    __syncthreads();
    const int c = tid & 127, tq = tid >> 7;
    float acc[32];
#pragma unroll
    for (int j = 0; j < 32; ++j) acc[j] = 0.f;
    const int smax = 32 * tq + 32;
    for (int s = 0; s < smax; ++s) { const float vn = VN[s * 128 + c]; const LAS float* wr_ = WT + s * 128 + 32 * tq;
#pragma unroll
        for (int j4 = 0; j4 < 8; ++j4) { const f32x4 w = *(const LAS f32x4*)(wr_ + 4 * j4);
#pragma unroll
            for (int e = 0; e < 4; ++e) acc[4 * j4 + e] += w[e] * vn; } }
    const float* bsg = bs + g * 128;
#pragma unroll
    for (int j = 0; j < 32; ++j) { const int t = 32 * tq + j; const size_t row = (size_t)(r0 + t);
        const float gu = bf2f(Z[row * DIN + ZU + 128 * g + c]);
        OB[row * 512 + 128 * g + c] = (bf16)f2bf(gu * (acc[j] + bsg[t])); }
    __syncthreads();
}

__device__ __forceinline__ void gmlp_sample_item(LAS unsigned char* lds, const bf16* Z, int sb, const float* lng, const float* lnb, const float* ws, const float* bs, bf16* OB, float* vs_out, int tid) {
    LAS float* VN = (LAS float*)lds;
    const int lane = tid & 63, wave = tid >> 6; const int r0 = MP + 4 * sb;
    if (wave < 4) { const int row = wave; const v4u w = *(const GAS v4u*)(Z + (size_t)(r0 + row) * DIN + ZV + 8 * lane);
        float a[8] = {bflo(w.x), bfhi(w.x), bflo(w.y), bfhi(w.y), bflo(w.z), bfhi(w.z), bflo(w.w), bfhi(w.w)};
        const float s = wave_sum(((a[0] + a[1]) + (a[2] + a[3])) + ((a[4] + a[5]) + (a[6] + a[7]))); const float mean = s * (1.f / 512.f); float q = 0.f;
#pragma unroll
        for (int e = 0; e < 8; ++e) { a[e] -= mean; q += a[e] * a[e]; }
        const float rstd = 1.0f / sqrtf(wave_sum(q) * (1.f / 512.f) + EPS);
#pragma unroll
        for (int e = 0; e < 8; ++e) { const float vn = a[e] * rstd * lng[8 * lane + e] + lnb[8 * lane + e]; VN[row * 512 + 8 * lane + e] = vn; vs_out[(size_t)(4 * sb + row) * 512 + 8 * lane + e] = vn; } }
    __syncthreads();
    for (int idx = tid; idx < 4 * 512; idx += NT) { const int t = idx >> 9, c = idx & 511, g = c >> 7; float s = bs[g * 128 + t];
        for (int q = 0; q <= t; ++q) s += ws[(size_t)g * 16384 + t * 128 + q] * VN[q * 512 + c];
        const size_t row = (size_t)(r0 + t); const float gu = bf2f(Z[row * DIN + ZU + c]);
        OB[row * 512 + c] = (bf16)f2bf(gu * s); }
    __syncthreads();
}

__device__ __forceinline__ void conv_gate_item(const bf16* UP, const float* cache, const float* cw, const float* cb, bf16* G, float* cp, float* cs, int rb, int oc) {
    const int j0 = 8 * oc; const int r0 = 16 * rb; const bool sample = r0 >= MP;
    float w0g[8], w1g[8], w2g[8], bg[8], w0v[8], w1v[8], w2v[8], bv[8];
#pragma unroll
    for (int e = 0; e < 8; ++e) { w0g[e] = cw[j0 + e]; w1g[e] = cw[FF2 + j0 + e]; w2g[e] = cw[2 * FF2 + j0 + e]; bg[e] = cb[j0 + e];
        w0v[e] = cw[FF + j0 + e]; w1v[e] = cw[FF2 + FF + j0 + e]; w2v[e] = cw[2 * FF2 + FF + j0 + e]; bv[e] = cb[FF + j0 + e]; }
    float g2[8], g1[8], v2[8], v1[8];
    if (!sample) {
        if ((r0 & 2047) == 0) {
#pragma unroll
            for (int e = 0; e < 8; ++e) { g2[e] = 0.f; g1[e] = 0.f; v2[e] = 0.f; v1[e] = 0.f; }
        } else {
            const v4u a = *(const GAS v4u*)(UP + (size_t)(r0 - 2) * FF2 + j0), b = *(const GAS v4u*)(UP + (size_t)(r0 - 1) * FF2 + j0);
            const v4u c = *(const GAS v4u*)(UP + (size_t)(r0 - 2) * FF2 + FF + j0), d = *(const GAS v4u*)(UP + (size_t)(r0 - 1) * FF2 + FF + j0);
            g2[0] = bflo(a.x); g2[1] = bfhi(a.x); g2[2] = bflo(a.y); g2[3] = bfhi(a.y); g2[4] = bflo(a.z); g2[5] = bfhi(a.z); g2[6] = bflo(a.w); g2[7] = bfhi(a.w);
            g1[0] = bflo(b.x); g1[1] = bfhi(b.x); g1[2] = bflo(b.y); g1[3] = bfhi(b.y); g1[4] = bflo(b.z); g1[5] = bfhi(b.z); g1[6] = bflo(b.w); g1[7] = bfhi(b.w);
            v2[0] = bflo(c.x); v2[1] = bfhi(c.x); v2[2] = bflo(c.y); v2[3] = bfhi(c.y); v2[4] = bflo(c.z); v2[5] = bfhi(c.z); v2[6] = bflo(c.w); v2[7] = bfhi(c.w);
            v1[0] = bflo(d.x); v1[1] = bfhi(d.x); v1[2] = bflo(d.y); v1[3] = bfhi(d.y); v1[4] = bflo(d.z); v1[5] = bfhi(d.z); v1[6] = bflo(d.w); v1[7] = bfhi(d.w);
        }
    }
#pragma unroll 4
    for (int i = 0; i < 16; ++i) {
        const int r = r0 + i;
        if (sample && (i & 3) == 0) { const int sb = (r - MP) >> 2; const float* c0 = cache + (size_t)sb * 2 * FF2;
#pragma unroll
            for (int e = 0; e < 8; ++e) { g2[e] = c0[j0 + e]; g1[e] = c0[FF2 + j0 + e]; v2[e] = c0[FF + j0 + e]; v1[e] = c0[FF2 + FF + j0 + e]; } }
        const v4u a = *(const GAS v4u*)(UP + (size_t)r * FF2 + j0), c = *(const GAS v4u*)(UP + (size_t)r * FF2 + FF + j0);
        float g0[8] = {bflo(a.x), bfhi(a.x), bflo(a.y), bfhi(a.y), bflo(a.z), bfhi(a.z), bflo(a.w), bfhi(a.w)};
        float v0[8] = {bflo(c.x), bfhi(c.x), bflo(c.y), bfhi(c.y), bflo(c.z), bfhi(c.z), bflo(c.w), bfhi(c.w)};
        float o[8];
#pragma unroll
        for (int e = 0; e < 8; ++e) { const float cg = bg[e] + w0g[e] * g2[e] + w1g[e] * g1[e] + w2g[e] * g0[e]; const float cv = bv[e] + w0v[e] * v2[e] + w1v[e] * v1[e] + w2v[e] * v0[e];
            const float ge = cg * pg8::sigm(1.5957691216057308f * (cg + 0.044715f * cg * cg * cg)); o[e] = ge * cv; }
        v4u ow; ow.x = pk2(o[0], o[1]); ow.y = pk2(o[2], o[3]); ow.z = pk2(o[4], o[5]); ow.w = pk2(o[6], o[7]);
        *(GAS v4u*)(G + (size_t)r * FF + j0) = ow;
        if (!sample) { const int t = r & 2047; if (t >= 2046) { float* dst = cp + ((size_t)(r >> 11) * 2 + (t - 2046)) * FF2;
#pragma unroll
                for (int e = 0; e < 8; ++e) { dst[j0 + e] = g0[e]; dst[FF + j0 + e] = v0[e]; } } }
        else { const int t = (r - MP) & 3; if (t >= 2) { float* dst = cs + ((size_t)((r - MP) >> 2) * 2 + (t - 2)) * FF2;
#pragma unroll
                for (int e = 0; e < 8; ++e) { dst[j0 + e] = g0[e]; dst[FF + j0 + e] = v0[e]; } } }
#pragma unroll
        for (int e = 0; e < 8; ++e) { g2[e] = g1[e]; g1[e] = g0[e]; v2[e] = v1[e]; v1[e] = v0[e]; }
    }
}
struct Args { const float* in[22]; float* out; unsigned char* ws; };
__global__ void __launch_bounds__(NWAVES * 64, 2) mk_fwd(Args args) {
    extern __shared__ __attribute__((aligned(16))) unsigned char lds[];
    LAS unsigned char* L = (LAS unsigned char*)lds;
    volatile LAS unsigned* MISC = (volatile LAS unsigned*)(L + MISC_OFF);
    const int tid = threadIdx.x, lane = tid & 63, wave = __builtin_amdgcn_readfirstlane(tid >> 6);
    const int G = gridDim.x, bx = blockIdx.x;
    const int vcu = (G % 8 == 0) ? (bx % 8) * (G / 8) + bx / 8 : bx;
    unsigned char* ws = args.ws;
    for (int u = tid; u < (LDS_BYTES - LDSCTL_OFF) / 4; u += NT) ((LAS unsigned*)(L + LDSCTL_OFF))[u] = 0u;
    __syncthreads();
    XcdBarrier bar = xcd_barrier_post((unsigned*)(ws + WS_CTL) + CW_BAR, MISC + 8);

    const float* x_prompt = args.in[0]; const float* x_sample = args.in[1]; const float* state_hgrn = args.in[2]; const float* cache_conv = args.in[3];
    const float* lb_param = args.in[4]; const float* mix_pre_g = args.in[5]; const float* w_in = args.in[6]; const float* hgrn_norm_g = args.in[7];
    const float* gmlp_ln_g = args.in[8]; const float* gmlp_ln_b = args.in[9]; const float* w_s = args.in[10]; const float* b_s = args.in[11];
    const float* w_pa = args.in[12]; const float* w_pb = args.in[13]; const float* w_o = args.in[14]; const float* mix_post_g = args.in[15];
    const float* ffn_pre_g = args.in[16]; const float* w_up = args.in[17]; const float* conv_w = args.in[18]; const float* conv_b = args.in[19];
    const float* w_down = args.in[20]; const float* ffn_post_g = args.in[21];
    float* out = args.out;
    bf16* WinT = (bf16*)(ws + WS_WIN); bf16* WpaT = (bf16*)(ws + WS_WPA); bf16* WpbT = (bf16*)(ws + WS_WPB); bf16* WoT = (bf16*)(ws + WS_WO);
    bf16* WupT = (bf16*)(ws + WS_WUP); bf16* WdnT = (bf16*)(ws + WS_WDN); float* LB = (float*)(ws + WS_LB);
    bf16* XN = (bf16*)(ws + WS_XN); bf16* Z = (bf16*)(ws + WS_Z); bf16* OA = (bf16*)(ws + WS_OA); bf16* OB = (bf16*)(ws + WS_OB);
    float* HF = (float*)(ws + WS_HF); bf16* H = (bf16*)(ws + WS_H); float* Y = (float*)(ws + WS_Y); bf16* UP = (bf16*)(ws + WS_UP); bf16* GG = (bf16*)(ws + WS_G);
    float* X1 = out;

    {
        LAS float* scr = (LAS float*)(L + RING_OFF + wave * 16384);
        const int gw = vcu * NWAVES + wave, NGW = G * NWAVES;
        constexpr int I_IN = (D / 64) * (DIN / 32), I_PA = (512 / 64) * (D / 32), I_O = (D / 64) * (D / 32), I_UP = (D / 64) * (FF2 / 32), I_DN = (FF / 64) * (D / 32);
        constexpr int NITEMS = I_IN + 2 * I_PA + I_O + I_UP + I_DN;
        for (int it = gw; it < NITEMS; it += NGW) {
            int r = it;
            if (r < I_IN) { p0_transpose_item(w_in, DIN, WinT, D, 0, scr, r, lane); continue; } r -= I_IN;
            if (r < I_PA) { p0_transpose_item(w_pa, D, WpaT, 512, 0, scr, r, lane); continue; } r -= I_PA;
            if (r < I_PA) { p0_transpose_item(w_pb, D, WpbT, 512, 0, scr, r, lane); continue; } r -= I_PA;
            if (r < I_O) { p0_transpose_item(w_o, D, WoT, D, 0, scr, r, lane); continue; } r -= I_O;
            if (r < I_UP) { p0_transpose_item(w_up, FF2, WupT, D, 0, scr, r, lane); continue; } r -= I_UP;
            p0_transpose_item(w_down, D, WdnT, FF, 0, scr, r, lane);
        }
        for (int m = gw; m < M; m += NGW) { const float* xr = (m < MP) ? x_prompt + (size_t)m * D : x_sample + (size_t)(m - MP) * D; rms_row_to_bf16(xr, mix_pre_g, XN + (size_t)m * D, lane); }
        if (bx == 0) for (int k = tid; k < 1024; k += NT) LB[k] = 1.0f / (1.0f + __expf(lb_param[1024 + k] - lb_param[k]));
    }
    xcd_barrier(bar);

    { pg8::Gemm g{XN, WinT, M, DIN, D, D}; pg8::StaticOrder S; S.init(M, DIN, G, bx); pg8::EpiZ E{Z, LB};
      pg8::gemm_phase<pg8::EpiZ, pg8::StaticOrder, true, true>(L + RING_OFF, g, S, E); }
    xcd_barrier(bar);

    if (bx < 64) {
        const int b = bx >> 3, h = bx & 7;
        hgrn_recurrent(L, Z, b * 2048, 2048, h, nullptr, out + O_SP + (size_t)bx * 8192, OA, hgrn_norm_g, tid);
    } else {
        for (int it = bx - 64; it < 512 + 1024 + 128; it += G - 64) {
            if (it < 512) { const int b = it >> 6, n = (it >> 2) & 15, g = it & 3; gmlp_prompt_item(L, Z, b * 2048 + n * 128, g, gmlp_ln_g, gmlp_ln_b, w_s, b_s, OB, tid); }
            else if (it < 1536) { const int i2 = it - 512, sb = i2 >> 3, h = i2 & 7;
                hgrn_recurrent(L, Z, MP + 4 * sb, 4, h, state_hgrn + (size_t)i2 * 8192, out + O_SS + (size_t)i2 * 8192, OA, hgrn_norm_g, tid); }
            else gmlp_sample_item(L, Z, it - 1536, gmlp_ln_g, gmlp_ln_b, w_s, b_s, OB, out + O_VS, tid);
        }
    }
    xcd_barrier(bar);

    { pg8::Gemm g{OA, WpaT, M, D, 512, 512}; pg8::StaticOrder S; S.init(M, D, G, bx); pg8::EpiGateF32 E{HF, Z, ZGA};
      pg8::gemm_phase<pg8::EpiGateF32, pg8::StaticOrder, true, true>(L + RING_OFF, g, S, E); }
    xcd_barrier(bar);
    { pg8::Gemm g{OB, WpbT, M, D, 512, 512}; pg8::StaticOrder S; S.init(M, D, G, bx); pg8::EpiComb E{H, HF, Z, ZGB};
      pg8::gemm_phase<pg8::EpiComb, pg8::StaticOrder, true, true>(L + RING_OFF, g, S, E); }
    xcd_barrier(bar);
    { pg8::Gemm g{H, WoT, M, D, D, D}; pg8::StaticOrder S; S.init(M, D, G, bx); pg8::EpiF32 E{Y, D};
      pg8::gemm_phase<pg8::EpiF32, pg8::StaticOrder, true, true>(L + RING_OFF, g, S, E); }
    xcd_barrier(bar);
    {
        const int gw = bx * NWAVES + wave, NGW = G * NWAVES;
        for (int m = gw; m < M; m += NGW) {
            const float* xr = (m < MP) ? x_prompt + (size_t)m * D : x_sample + (size_t)(m - MP) * D;
            const GAS f32x4* yr = (const GAS f32x4*)(Y + (size_t)m * D) + lane; const GAS f32x4* xv = (const GAS f32x4*)xr + lane;
            f32x4 y[4]; float s = 0.f;
#pragma unroll
            for (int j = 0; j < 4; ++j) { y[j] = yr[64 * j]; s += (y[j].x * y[j].x + y[j].y * y[j].y) + (y[j].z * y[j].z + y[j].w * y[j].w); }
            const float r = 1.0f / sqrtf(wave_sum(s) * (1.f / D) + EPS); float s2 = 0.f;
            GAS f32x4* x1r = (GAS f32x4*)(X1 + (size_t)m * D) + lane;
#pragma unroll
            for (int j = 0; j < 4; ++j) { const f32x4 gg = ((const GAS f32x4*)mix_post_g)[lane + 64 * j]; const f32x4 xx = xv[64 * j];
                y[j].x = xx.x + y[j].x * r * gg.x; y[j].y = xx.y + y[j].y * r * gg.y; y[j].z = xx.z + y[j].z * r * gg.z; y[j].w = xx.w + y[j].w * r * gg.w;
                x1r[64 * j] = y[j]; s2 += (y[j].x * y[j].x + y[j].y * y[j].y) + (y[j].z * y[j].z + y[j].w * y[j].w); }
            const float r2 = 1.0f / sqrtf(wave_sum(s2) * (1.f / D) + EPS);
            GAS v2u* o8 = (GAS v2u*)(XN + (size_t)m * D) + lane;
#pragma unroll
            for (int j = 0; j < 4; ++j) { const f32x4 gg = ((const GAS f32x4*)ffn_pre_g)[lane + 64 * j]; v2u o; o.x = pk2(y[j].x * r2 * gg.x, y[j].y * r2 * gg.y); o.y = pk2(y[j].z * r2 * gg.z, y[j].w * r2 * gg.w); o8[64 * j] = o; }
        }
    }
    xcd_barrier(bar);
    { pg8::Gemm g{XN, WupT, M, FF2, D, D}; pg8::StaticOrder S; S.init(M, FF2, G, bx); pg8::EpiBf16<0> E{UP, FF2, nullptr, 0, 0, 1.f};
      pg8::gemm_phase<pg8::EpiBf16<0>, pg8::StaticOrder, true, true>(L + RING_OFF, g, S, E); }
    xcd_barrier(bar);
    for (int it = bx; it < (M / 16) * (FF / 8) / NT; it += G) { const int idx = it * NT + tid; conv_gate_item(UP, cache_conv, conv_w, conv_b, GG, out + O_CP, out + O_CS, idx / (FF / 8), idx % (FF / 8)); }
    xcd_barrier(bar);
    { pg8::Gemm g{GG, WdnT, M, D, FF, FF}; pg8::StaticOrder S; S.init(M, D, G, bx); pg8::EpiF32 E{Y, D};
      pg8::gemm_phase<pg8::EpiF32, pg8::StaticOrder, true, true>(L + RING_OFF, g, S, E); }
    xcd_barrier(bar);
    {
        const int gw = bx * NWAVES + wave, NGW = G * NWAVES;
        const bool bad = xb_ld((unsigned*)(ws + WS_CTL) + CW_BAR + XB_TMO) != 0u;
        for (int m = gw; m < M; m += NGW) {
            const GAS f32x4* yr = (const GAS f32x4*)(Y + (size_t)m * D) + lane; GAS f32x4* x1r = (GAS f32x4*)(X1 + (size_t)m * D) + lane;
            f32x4 y[4]; float s = 0.f;
#pragma unroll
            for (int j = 0; j < 4; ++j) { y[j] = yr[64 * j]; s += (y[j].x * y[j].x + y[j].y * y[j].y) + (y[j].z * y[j].z + y[j].w * y[j].w); }
            float r = 1.0f / sqrtf(wave_sum(s) * (1.f / D) + EPS); if (bad) r = __builtin_nanf("");
#pragma unroll
            for (int j = 0; j < 4; ++j) { const f32x4 gg = ((const GAS f32x4*)ffn_post_g)[lane + 64 * j]; f32x4 xx = x1r[64 * j];
                xx.x += y[j].x * r * gg.x; xx.y += y[j].y * r * gg.y; xx.z += y[j].z * r * gg.z; xx.w += y[j].w * r * gg.w; x1r[64 * j] = xx; }
        }
    }
}

extern "C" void kernel_launch(void* const* d_in, const int* in_sizes, int n_in, void* d_out, int out_size, void* d_ws, size_t ws_size, hipStream_t stream) {
    static int grid = 0;
    if (grid == 0) {
        if (n_in != 22 || (size_t)out_size != O_END || ws_size < WS_END) { fprintf(stderr, "kernel_launch: unexpected shapes (n_in %d out %d ws %zu)\n", n_in, out_size, ws_size); grid = -1; return; }
        int dev = 0, cus = 0, per_cu = 0;
        if (hipGetDevice(&dev) != hipSuccess || hipDeviceGetAttribute(&cus, hipDeviceAttributeMultiprocessorCount, dev) != hipSuccess) { grid = -1; return; }
        if (hipFuncSetAttribute((const void*)mk_fwd, hipFuncAttributeMaxDynamicSharedMemorySize, LDS_BYTES) != hipSuccess) { fprintf(stderr, "kernel_launch: hipFuncSetAttribute failed\n"); grid = -1; return; }
        if (hipOccupancyMaxActiveBlocksPerMultiprocessor(&per_cu, (const void*)mk_fwd, NWAVES * 64, LDS_BYTES) != hipSuccess || per_cu < 1) { fprintf(stderr, "kernel_launch: occupancy query says %d blocks per CU\n", per_cu); (void)hipGetLastError(); grid = -1; return; }
        grid = cus;
        if (grid != 256) { fprintf(stderr, "kernel_launch: built for 256 CUs, found %d\n", cus); grid = -1; return; }
    }
    if (grid < 0) return;
    (void)hipMemsetAsync((char*)d_ws + WS_CTL, 0, CTL_ZERO_BYTES, stream);
    Args a{};
    for (int i = 0; i < 22; ++i) a.in[i] = (const float*)d_in[i];
    a.out = (float*)d_out; a.ws = (unsigned char*)d_ws;
    hipLaunchKernelGGL(mk_fwd, dim3(grid), dim3(NWAVES * 64), LDS_BYTES, stream, a);
}
```

```cpp
#include <hip/hip_runtime.h>
#include <cstdio>
#include <cstdint>
namespace pg8 {
#define PG8_LAS __attribute__((address_space(3)))
typedef unsigned short bf16_t;
typedef short bf16x8 __attribute__((ext_vector_type(8)));
typedef float f32x4 __attribute__((ext_vector_type(4)));
typedef unsigned u32x4 __attribute__((ext_vector_type(4)));
constexpr int BM = 256, BK = 64, HALF = 128, HTB = HALF * BK * 2  , STAGE_BYTES = 8 * HTB, NXCD = 8, WGM = 8;

__host__ __device__ __forceinline__ int lds_byte(int r, int c) { const int st = (r >> 4) * 2 + (c >> 5), rr = r & 15, cc = c & 31, ob = rr * 64 + cc * 2; return st * 1024 + (ob ^ (((ob >> 9) & 1) << 5)); }
__host__ __device__ __forceinline__ void stage_rc(int b, int& R, int& C) { const int st = b / 1024, sb = b % 1024, swz = sb ^ (((sb >> 9) & 1) << 5); R = (st >> 1) * 16 + swz / 64; C = (st & 1) * 32 + (swz % 64) / 2; }
__host__ __device__ __forceinline__ int perm32(int rho) { const int n = rho >> 4, i = rho & 15; return 8 * (i >> 2) + 4 * n + (i & 3); }

struct Unit { int pm, pn; };
struct Gemm { const bf16_t* A; const bf16_t* Bt; int M, N, K, lda; };

struct StaticOrder {
    int nM, nN, nwg, G, c;
    __host__ __device__ void init(int M, int N, int G_, int c_) { nM = M / BM; nN = N / BM; nwg = nM * nN; G = G_; c = c_; }
    __host__ __device__ bool next(int i, Unit& u) const {
        const long L = (long)i * G + c; if (L >= nwg) return false;
        int wgid = (int)L; { const int q = nwg / NXCD, r = nwg % NXCD, xcd = wgid % NXCD, off = wgid / NXCD; wgid = (xcd < r ? xcd * (q + 1) : r * (q + 1) + (xcd - r) * q) + off; }
        const int nig = WGM * nN, gid = wgid / nig, fm = gid * WGM, gsz = (nM - fm) < WGM ? (nM - fm) : WGM;
        u.pm = fm + ((wgid % nig) % gsz); u.pn = (wgid % nig) / gsz; return true;
    }
    __device__ __forceinline__ void a_ready(const Unit&) const {}
    __device__ __forceinline__ void done(const Unit&) const {}
};

typedef __bf16 bf16x2_t __attribute__((ext_vector_type(2)));
typedef float f32x2_t __attribute__((ext_vector_type(2)));
__device__ __forceinline__ unsigned cvt_pk_bf16(float lo, float hi) { const f32x2_t v = {lo, hi}; const bf16x2_t b = __builtin_convertvector(v, bf16x2_t); return __builtin_bit_cast(unsigned, b); }
typedef float f32x2 __attribute__((ext_vector_type(2)));
__device__ __forceinline__ f32x2 gelu_pk(f32x2 v) {
    const f32x2 av = __builtin_elementwise_abs(v), d = av * 0.2316418882f + 1.0f;
    f32x2 t; t.x = __builtin_amdgcn_rcpf(d.x); t.y = __builtin_amdgcn_rcpf(d.y);
    f32x2 q = t * 0.5307027145f + (-0.7265760135f); q = q * t + 0.7107068705f; q = q * t + (-0.142248368f); q = q * t + 0.127414796f; q = q * t;
    const f32x2 s = (v * v) * (-0.72134752044f);
    f32x2 e; e.x = __builtin_amdgcn_exp2f(s.x); e.y = __builtin_amdgcn_exp2f(s.y);
    const f32x2 m = v * (q * e), r = v - m;
    f32x2 o; o.x = v.x < 0.f ? m.x : r.x; o.y = v.y < 0.f ? m.y : r.y; return o;
}

template <int ACT  > struct EpiBf16 {
    static constexpr bool PERM = true, AFTER_DRAIN = false; static_assert(ACT == 0 || ACT == 1, "EpiBf16: ACT is 0 (none) or 1 (gelu_pk)");
    bf16_t* O; int ldc; const float* bias; int split_cols; size_t split_stride; float scale0;
    __device__ __forceinline__ void operator()(const f32x4 (&acc)[2][2][4][2], const Unit& u, int wr, int wc, int fr, int fq) const {
        const int row0 = u.pm * BM + wr * 64 + fr; int colt = u.pn * BM; bf16_t* base = O;
        float sc = 1.f; if (split_cols) { const int t = colt / split_cols; base += (size_t)t * split_stride; colt -= t * split_cols; if (t == 0) sc = scale0; }
        const int col0 = colt + wc * 32 + 8 * fq, bcol0 = u.pn * BM + wc * 32 + 8 * fq;
        f32x4 bv[2][2];
#pragma unroll
        for (int bj = 0; bj < 2; ++bj)
#pragma unroll
            for (int n = 0; n < 2; ++n) bv[bj][n] = bias ? *(const f32x4*)(bias + bcol0 + bj * HALF + 4 * n) : (f32x4){0.f, 0.f, 0.f, 0.f};
#pragma unroll
        for (int ai = 0; ai < 2; ++ai)
#pragma unroll
            for (int m = 0; m < 4; ++m) { bf16_t* rowp = base + (size_t)(row0 + ai * HALF + m * 16) * ldc + col0;
#pragma unroll
                for (int bj = 0; bj < 2; ++bj) { f32x4 v0 = acc[ai][bj][m][0] + bv[bj][0], v1 = acc[ai][bj][m][1] + bv[bj][1];
                    if (ACT == 1) { f32x2 a = gelu_pk((f32x2){v0[0], v0[1]}), b = gelu_pk((f32x2){v0[2], v0[3]}), c = gelu_pk((f32x2){v1[0], v1[1]}), d = gelu_pk((f32x2){v1[2], v1[3]});
                        v0 = (f32x4){a.x, a.y, b.x, b.y}; v1 = (f32x4){c.x, c.y, d.x, d.y}; }
                    v0 = v0 * sc; v1 = v1 * sc; u32x4 w; w.x = cvt_pk_bf16(v0[0], v0[1]); w.y = cvt_pk_bf16(v0[2], v0[3]); w.z = cvt_pk_bf16(v1[0], v1[1]); w.w = cvt_pk_bf16(v1[2], v1[3]);
                    *(u32x4*)(rowp + bj * HALF) = w; } }
    }
};

template <class Epi, class Sched, bool ALIGN_EPI = false, bool SP2 = false>
__device__ __forceinline__ void gemm_phase(PG8_LAS unsigned char* lds, const Gemm g, const Sched& S, const Epi& E) {
    const int tid = threadIdx.x, wid = __builtin_amdgcn_readfirstlane(tid >> 6), lane = tid & 63, wr = wid >> 2, wc = wid & 3, fr = lane & 15, fq = lane >> 4;
    const int K = g.K, nt = K / BK;
    unsigned voffA[2], voffB[2];
#pragma unroll
    for (int i = 0; i < 2; ++i) { int R, C; stage_rc(tid * 16 + i * 8192, R, C); const int Rb = Epi::PERM ? ((R & ~31) + perm32(R & 31)) : R;
        voffA[i] = (unsigned)(R * g.lda + C) * 2u; voffB[i] = (unsigned)(Rb * K + C) * 2u; }
    const size_t kstep = (size_t)(BK * 2);
    const size_t hstepA = (size_t)HALF * g.lda * 2, hstepB = (size_t)HALF * K * 2;
    const size_t tstepA = 2 * hstepA, tstepB = 2 * hstepB;
    const unsigned ldsw = (unsigned)wid * 1024u;
    const int aoff = lds_byte(wr * 64 + fr, fq * 8), boff = lds_byte(wc * 32 + fr, fq * 8);
#define PG8_SA(b, h) (((b) * 2 + (h)) * HTB)
#define PG8_SB(b, h) ((4 + (b) * 2 + (h)) * HTB)
#define PG8_STAGE(bufoff, gbase, voff) do { _Pragma("unroll") for (int _i = 0; _i < 2; ++_i) \
        __builtin_amdgcn_global_load_lds((const unsigned*)((const char*)(gbase) + (voff)[_i]), (PG8_LAS unsigned*)(lds + (bufoff) + ldsw + _i * 8192), 16, 0, 0); } while (0)
#define PG8_LDA(dst, b, h) do { _Pragma("unroll") for (int m = 0; m < 4; ++m) _Pragma("unroll") for (int k = 0; k < 2; ++k) dst[m][k] = *(const PG8_LAS bf16x8*)(lds + PG8_SA(b, h) + aoff + m * 2048 + k * 1024); } while (0)
#define PG8_LDB(dst, b, h) do { _Pragma("unroll") for (int n = 0; n < 2; ++n) _Pragma("unroll") for (int k = 0; k < 2; ++k) dst[n][k] = *(const PG8_LAS bf16x8*)(lds + PG8_SB(b, h) + boff + n * 2048 + k * 1024); } while (0)
#define PG8_MMA(ai, bj, At, Bt) do { __builtin_amdgcn_s_setprio(1); _Pragma("unroll") for (int m = 0; m < 4; ++m) _Pragma("unroll") for (int n = 0; n < 2; ++n) _Pragma("unroll") for (int k = 0; k < 2; ++k) \
        acc[ai][bj][m][n] = __builtin_amdgcn_mfma_f32_16x16x32_bf16(Bt[n][k], At[m][k], acc[ai][bj][m][n], 0, 0, 0); __builtin_amdgcn_s_setprio(0); } while (0)
#define PG8_WAIT_V(n) asm volatile("s_waitcnt vmcnt(" #n ")" ::: "memory")
#define PG8_WAIT_L(n) asm volatile("s_waitcnt lgkmcnt(" #n ")" ::: "memory")
#define PG8_BAR __builtin_amdgcn_s_barrier()
#define PG8_SCHED __builtin_amdgcn_sched_barrier(0)
    Unit cur, nxt; int ui = 0;
    if (!S.next(0, cur)) return;
    f32x4 acc[2][2][4][2];
#pragma unroll
    for (int a = 0; a < 2; ++a)
#pragma unroll
        for (int b = 0; b < 2; ++b)
#pragma unroll
            for (int m = 0; m < 4; ++m)
#pragma unroll
                for (int n = 0; n < 2; ++n) acc[a][b][m][n] = (f32x4){0.f, 0.f, 0.f, 0.f};
    bf16x8 At[4][2], B0[2][2], B1[2][2];
    const char* cA = (const char*)g.A + (size_t)cur.pm * tstepA; const char* cB = (const char*)g.Bt + (size_t)cur.pn * tstepB;
    S.a_ready(cur);
    if constexpr (SP2) {
        PG8_STAGE(PG8_SB(0, 0), cB, voffB); PG8_STAGE(PG8_SB(0, 1), cB + hstepB, voffB); PG8_STAGE(PG8_SA(0, 0), cA, voffA); PG8_STAGE(PG8_SA(0, 1), cA + hstepA, voffA);
        if (wr == 1) PG8_BAR;
        PG8_WAIT_V(2); PG8_BAR;
        PG8_STAGE(PG8_SB(1, 0), cB + kstep, voffB); PG8_STAGE(PG8_SA(1, 0), cA + kstep, voffA); PG8_STAGE(PG8_SB(1, 1), cB + hstepB + kstep, voffB);
        PG8_WAIT_V(6); PG8_BAR;
    } else {
        PG8_STAGE(PG8_SB(0, 0), cB, voffB); PG8_STAGE(PG8_SA(0, 0), cA, voffA); PG8_STAGE(PG8_SB(0, 1), cB + hstepB, voffB); PG8_STAGE(PG8_SA(0, 1), cA + hstepA, voffA);
        if (wr == 1) PG8_BAR;
        PG8_WAIT_V(4); PG8_BAR;
        PG8_STAGE(PG8_SB(1, 0), cB + kstep, voffB); PG8_STAGE(PG8_SA(1, 0), cA + kstep, voffA); PG8_STAGE(PG8_SB(1, 1), cB + hstepB + kstep, voffB);
        PG8_WAIT_V(6); PG8_BAR;
    }
    for (;;) {
        const bool has_next = S.next(ui + 1, nxt);
        const char* nA = has_next ? (const char*)g.A + (size_t)nxt.pm * tstepA : cA; const char* nB = has_next ? (const char*)g.Bt + (size_t)nxt.pn * tstepB : cB;
        for (int t = 0; t < nt; t += 2) {
            const bool last = (t == nt - 2);
            const char* a1 = cA + (size_t)(t + 1) * kstep;
            const char* a2 = last ? nA : cA + (size_t)(t + 2) * kstep; const char* b2 = last ? nB : cB + (size_t)(t + 2) * kstep;
            const char* a3 = a2 + kstep; const char* b3 = b2 + kstep;
            if (last && has_next) S.a_ready(nxt);
            if constexpr (SP2) {
            PG8_LDB(B0, 0, 0); PG8_LDB(B1, 0, 1); PG8_SCHED; PG8_LDA(At, 0, 0); PG8_STAGE(PG8_SA(1, 1), a1 + hstepA, voffA);
            PG8_WAIT_V(8); PG8_WAIT_L(0); PG8_BAR; PG8_MMA(0, 0, At, B0); PG8_MMA(0, 1, At, B1); PG8_BAR; PG8_SCHED;
            PG8_LDA(At, 0, 1); PG8_STAGE(PG8_SB(0, 0), b2, voffB); PG8_STAGE(PG8_SB(0, 1), b2 + hstepB, voffB); PG8_STAGE(PG8_SA(0, 0), a2, voffA);
            PG8_WAIT_V(8); PG8_WAIT_L(0); PG8_BAR; PG8_MMA(1, 0, At, B0); PG8_MMA(1, 1, At, B1); PG8_BAR; PG8_SCHED;
            PG8_LDB(B0, 1, 0); PG8_LDB(B1, 1, 1); PG8_SCHED; PG8_LDA(At, 1, 0); PG8_STAGE(PG8_SA(0, 1), a2 + hstepA, voffA);
            PG8_WAIT_V(8); PG8_WAIT_L(0); PG8_BAR; PG8_MMA(0, 0, At, B0); PG8_MMA(0, 1, At, B1); PG8_BAR; PG8_SCHED;
            PG8_LDA(At, 1, 1); PG8_STAGE(PG8_SB(1, 0), b3, voffB); PG8_STAGE(PG8_SB(1, 1), b3 + hstepB, voffB); PG8_STAGE(PG8_SA(1, 0), a3, voffA);
            PG8_WAIT_V(8); PG8_WAIT_L(0); PG8_BAR; PG8_MMA(1, 0, At, B0); PG8_MMA(1, 1, At, B1); PG8_BAR; PG8_SCHED;
            } else {
            PG8_LDB(B0, 0, 0); PG8_SCHED; PG8_LDA(At, 0, 0); PG8_STAGE(PG8_SA(1, 1), a1 + hstepA, voffA);
            PG8_WAIT_L(8); PG8_BAR; PG8_WAIT_L(0); PG8_MMA(0, 0, At, B0); PG8_BAR; PG8_SCHED;
            PG8_LDB(B1, 0, 1); PG8_STAGE(PG8_SB(0, 0), b2, voffB);
            PG8_BAR; PG8_WAIT_L(0); PG8_MMA(0, 1, At, B1); PG8_BAR;
            PG8_LDA(At, 0, 1); PG8_STAGE(PG8_SA(0, 0), a2, voffA);
            PG8_BAR; PG8_WAIT_L(0); PG8_MMA(1, 0, At, B0); PG8_BAR; PG8_SCHED;
            PG8_STAGE(PG8_SB(0, 1), b2 + hstepB, voffB);
            PG8_WAIT_V(6); PG8_BAR; PG8_MMA(1, 1, At, B1); PG8_BAR;
            PG8_LDB(B0, 1, 0); PG8_SCHED; PG8_LDA(At, 1, 0); PG8_STAGE(PG8_SA(0, 1), a2 + hstepA, voffA);
            PG8_WAIT_L(8); PG8_BAR; PG8_WAIT_L(0); PG8_MMA(0, 0, At, B0); PG8_BAR; PG8_SCHED;
            PG8_LDB(B1, 1, 1); PG8_STAGE(PG8_SB(1, 0), b3, voffB);
            PG8_BAR; PG8_WAIT_L(0); PG8_MMA(0, 1, At, B1); PG8_BAR;
            PG8_LDA(At, 1, 1); PG8_STAGE(PG8_SA(1, 0), a3, voffA);
            PG8_BAR; PG8_WAIT_L(0); PG8_MMA(1, 0, At, B0); PG8_BAR; PG8_SCHED;
            PG8_STAGE(PG8_SB(1, 1), b3 + hstepB, voffB);
            PG8_WAIT_V(6); PG8_BAR; PG8_MMA(1, 1, At, B1); PG8_BAR;
            }
        }
        if constexpr (ALIGN_EPI) { if (wr == 0) PG8_BAR; }
        if constexpr (!Epi::AFTER_DRAIN) { E(acc, cur, wr, wc, fr, fq); S.done(cur); }
        if (!has_next) break;
#pragma unroll
        for (int a = 0; a < 2; ++a)
#pragma unroll
            for (int b = 0; b < 2; ++b)
#pragma unroll
                for (int m = 0; m < 4; ++m)
#pragma unroll
                    for (int n = 0; n < 2; ++n) acc[a][b][m][n] = (f32x4){0.f, 0.f, 0.f, 0.f};
        cur = nxt; cA = nA; cB = nB; ++ui;
        if constexpr (ALIGN_EPI) { if (wr == 1) PG8_BAR; }
    }
    PG8_WAIT_V(0);
    if constexpr (!ALIGN_EPI) { if (wr == 0) PG8_BAR; }
    PG8_BAR;
    if constexpr (Epi::AFTER_DRAIN) { E.fused(acc, cur, wr, wc, fr, fq, lds, wid, lane); S.done(cur); }
#undef PG8_SA
#undef PG8_SB
#undef PG8_STAGE
#undef PG8_LDA
#undef PG8_LDB
#undef PG8_MMA
#undef PG8_WAIT_V
#undef PG8_WAIT_L
#undef PG8_BAR
#undef PG8_SCHED
}
struct EpiF32 {
    static constexpr bool PERM = false, AFTER_DRAIN = false;
    float* C; int ldc;
    __device__ __forceinline__ void operator()(const f32x4 (&acc)[2][2][4][2], const Unit& u, int wr, int wc, int fr, int fq) const {
        const int row0 = u.pm * BM + wr * 64 + fr, col0 = u.pn * BM + wc * 32 + 4 * fq;
#pragma unroll
        for (int ai = 0; ai < 2; ++ai)
#pragma unroll
            for (int m = 0; m < 4; ++m) { float* rowp = C + (size_t)(row0 + ai * HALF + m * 16) * ldc + col0;
#pragma unroll
                for (int bj = 0; bj < 2; ++bj)
#pragma unroll
                    for (int n = 0; n < 2; ++n) *(f32x4*)(rowp + bj * HALF + n * 16) = acc[ai][bj][m][n]; }
    }
};
__device__ __forceinline__ float bf_lo(unsigned w) { return __uint_as_float(w << 16); }
__device__ __forceinline__ float bf_hi(unsigned w) { return __uint_as_float(w & 0xffff0000u); }
__device__ __forceinline__ float sigm(float x) { return __builtin_amdgcn_rcpf(1.0f + __builtin_amdgcn_exp2f(-1.4426950408889634f * x)); }
template <int MODE> __device__ __forceinline__ float zact(float x, float lb) {
    if (MODE == 0) return x * sigm(x);
    if (MODE == 1) { const float f = lb + (1.0f - lb) * sigm(x); return 0.6931471805599453f * __builtin_amdgcn_logf(f); }
    if (MODE == 2) return x;
    if (MODE == 3) return x * sigm(1.5957691216057308f * (x + 0.044715f * x * x * x));
    return sigm(x);
}
template <int N> __device__ __forceinline__ float row_shr(float v) {
    return __builtin_bit_cast(float, __builtin_amdgcn_update_dpp(0, __builtin_bit_cast(int, v), 0x110 + N, 0xf, 0xf, true));
}
struct EpiZ {
    static constexpr bool PERM = true, AFTER_DRAIN = false;
    bf16_t* Z; const float* lb; bf16_t* ZX;
    template <int MODE> __device__ __forceinline__ void run(const f32x4 (&acc)[2][2][4][2], const Unit& u, int wr, int wc, int fr, int fq) const {
        const int row0 = u.pm * BM + wr * 64 + fr, col0 = u.pn * BM + wc * 32 + 8 * fq;
        f32x4 lv[2][2];
#pragma unroll
        for (int bj = 0; bj < 2; ++bj)
#pragma unroll
            for (int n = 0; n < 2; ++n) lv[bj][n] = (MODE == 1) ? *(const f32x4*)(lb + (col0 - 1024) + bj * HALF + 4 * n) : (f32x4){0.f, 0.f, 0.f, 0.f};
#pragma unroll
        for (int ai = 0; ai < 2; ++ai)
#pragma unroll
            for (int m = 0; m < 4; ++m) { bf16_t* rowp = Z + (size_t)(row0 + ai * HALF + m * 16) * 6144 + col0;
#pragma unroll
                for (int bj = 0; bj < 2; ++bj) { const f32x4 a = acc[ai][bj][m][0], b = acc[ai][bj][m][1]; const f32x4 l0 = lv[bj][0], l1 = lv[bj][1];
                    u32x4 w; w.x = cvt_pk_bf16(zact<MODE>(a[0], l0[0]), zact<MODE>(a[1], l0[1])); w.y = cvt_pk_bf16(zact<MODE>(a[2], l0[2]), zact<MODE>(a[3], l0[3]));
                    w.z = cvt_pk_bf16(zact<MODE>(b[0], l1[0]), zact<MODE>(b[1], l1[1])); w.w = cvt_pk_bf16(zact<MODE>(b[2], l1[2]), zact<MODE>(b[3], l1[3]));
                    *(u32x4*)(rowp + bj * HALF) = w; } }
    }
    __device__ __forceinline__ void run_hgrn(const f32x4 (&acc)[2][2][4][2], const Unit& u, int wr, int wc, int fr, int fq) const {
        typedef unsigned u32x2 __attribute__((ext_vector_type(2)));
        const int row0 = u.pm * BM + wr * 64 + fr, col0 = u.pn * BM + wc * 32 + 8 * fq, kc0 = col0 - 1024;
#pragma unroll
        for (int ai = 0; ai < 2; ++ai)
#pragma unroll
            for (int bj = 0; bj < 2; ++bj)
#pragma unroll
                for (int n = 0; n < 2; ++n) { const f32x4 l4 = *(const f32x4*)(lb + kc0 + bj * HALF + 4 * n);
                    unsigned wE[4][2], wT[4][2], wH[4][2];
#pragma unroll
                    for (int e2 = 0; e2 < 2; ++e2) { float Ev[4][2], Tv[4][2], Hv[4][2];
#pragma unroll
                        for (int ee = 0; ee < 2; ++ee) { const int e = 2 * e2 + ee; const float lbv = l4[e]; float lfv[4], kkv[4];
#pragma unroll
                            for (int m = 0; m < 4; ++m) { const float x = acc[ai][bj][m][n][e]; const float s = sigm(x); const float f = lbv + (1.0f - lbv) * s;
                                lfv[m] = __builtin_amdgcn_logf(f); kkv[m] = (1.0f - lbv) * (1.0f - s); }
                            float run = 0.f, bc[4];
#pragma unroll
                            for (int m = 0; m < 4; ++m) { float v = lfv[m]; v += row_shr<1>(v); v += row_shr<2>(v); v += row_shr<4>(v); v += row_shr<8>(v);
                                const float tot = __shfl(v, 15, 16); bc[m] = v + run; run += tot; }
                            const float eL = __builtin_amdgcn_exp2f(run);
#pragma unroll
                            for (int m = 0; m < 4; ++m) { const float kt = kkv[m] * __builtin_amdgcn_exp2f(fminf(-bc[m], 120.f));
                                Ev[m][ee] = __builtin_amdgcn_exp2f(bc[m]); Tv[m][ee] = kt; Hv[m][ee] = kt * eL; } }
#pragma unroll
                        for (int m = 0; m < 4; ++m) { wE[m][e2] = cvt_pk_bf16(Ev[m][0], Ev[m][1]); wT[m][e2] = cvt_pk_bf16(Tv[m][0], Tv[m][1]); wH[m][e2] = cvt_pk_bf16(Hv[m][0], Hv[m][1]); } }
#pragma unroll
                    for (int m = 0; m < 4; ++m) { const size_t r = (size_t)(row0 + ai * HALF + m * 16);
                        *(u32x2*)(Z + r * 6144 + col0 + bj * HALF + 4 * n) = (u32x2){wE[m][0], wE[m][1]};
                        *(u32x2*)(ZX + r * 2048 + kc0 + bj * HALF + 4 * n) = (u32x2){wT[m][0], wT[m][1]};
                        *(u32x2*)(ZX + r * 2048 + 1024 + kc0 + bj * HALF + 4 * n) = (u32x2){wH[m][0], wH[m][1]}; }
                    asm volatile("" ::: "memory");
                }
    }
    __device__ __forceinline__ void operator()(const f32x4 (&acc)[2][2][4][2], const Unit& u, int wr, int wc, int fr, int fq) const {
        const int pn = u.pn;
        if (pn < 4) run<0>(acc, u, wr, wc, fr, fq);
        else if (pn < 8) { if (u.pm < 64) run_hgrn(acc, u, wr, wc, fr, fq); else run<1>(acc, u, wr, wc, fr, fq); }
        else if (pn < 10) run<2>(acc, u, wr, wc, fr, fq);
        else if (pn < 12) run<0>(acc, u, wr, wc, fr, fq);
        else if (pn < 16) run<3>(acc, u, wr, wc, fr, fq);
        else run<4>(acc, u, wr, wc, fr, fq);
    }
};
struct EpiGateF32 {
    static constexpr bool PERM = true, AFTER_DRAIN = false;
    float* C; const bf16_t* Z; int gcol;
    __device__ __forceinline__ void operator()(const f32x4 (&acc)[2][2][4][2], const Unit& u, int wr, int wc, int fr, int fq) const {
        const int row0 = u.pm * BM + wr * 64 + fr, col0 = u.pn * BM + wc * 32 + 8 * fq;
#pragma unroll
        for (int ai = 0; ai < 2; ++ai)
#pragma unroll
            for (int m = 0; m < 4; ++m) { const size_t r = (size_t)(row0 + ai * HALF + m * 16);
#pragma unroll
                for (int bj = 0; bj < 2; ++bj) { const u32x4 gw = *(const u32x4*)(Z + r * 6144 + gcol + col0 + bj * HALF);
                    const f32x4 a = acc[ai][bj][m][0], b = acc[ai][bj][m][1];
                    f32x4 o0, o1; o0[0] = a[0] * bf_lo(gw.x); o0[1] = a[1] * bf_hi(gw.x); o0[2] = a[2] * bf_lo(gw.y); o0[3] = a[3] * bf_hi(gw.y);
                    o1[0] = b[0] * bf_lo(gw.z); o1[1] = b[1] * bf_hi(gw.z); o1[2] = b[2] * bf_lo(gw.w); o1[3] = b[3] * bf_hi(gw.w);
                    float* p = C + r * 1024 + col0 + bj * HALF; *(f32x4*)p = o0; *(f32x4*)(p + 4) = o1; } }
    }
};
struct EpiComb {
    static constexpr bool PERM = true, AFTER_DRAIN = false;
    bf16_t* H; const float* Hf; const bf16_t* Z; int gcol;
    __device__ __forceinline__ void operator()(const f32x4 (&acc)[2][2][4][2], const Unit& u, int wr, int wc, int fr, int fq) const {
        const int row0 = u.pm * BM + wr * 64 + fr, col0 = u.pn * BM + wc * 32 + 8 * fq;
#pragma unroll
        for (int ai = 0; ai < 2; ++ai)
#pragma unroll
            for (int m = 0; m < 4; ++m) { const size_t r = (size_t)(row0 + ai * HALF + m * 16);
#pragma unroll
                for (int bj = 0; bj < 2; ++bj) { const u32x4 gw = *(const u32x4*)(Z + r * 6144 + gcol + col0 + bj * HALF);
                    const float* hp = Hf + r * 1024 + col0 + bj * HALF; const f32x4 h0 = *(const f32x4*)hp, h1 = *(const f32x4*)(hp + 4);
                    const f32x4 a = acc[ai][bj][m][0], b = acc[ai][bj][m][1];
                    u32x4 w; w.x = cvt_pk_bf16(h0[0] + a[0] * bf_lo(gw.x), h0[1] + a[1] * bf_hi(gw.x)); w.y = cvt_pk_bf16(h0[2] + a[2] * bf_lo(gw.y), h0[3] + a[3] * bf_hi(gw.y));
                    w.z = cvt_pk_bf16(h1[0] + b[0] * bf_lo(gw.z), h1[1] + b[1] * bf_hi(gw.z)); w.w = cvt_pk_bf16(h1[2] + b[2] * bf_lo(gw.w), h1[3] + b[3] * bf_hi(gw.w));
                    *(u32x4*)(H + r * 1024 + col0 + bj * HALF) = w; } }
    }
};
}
constexpr int NWAVES = 8, NT = 512;
constexpr int MP = 16384, MS = 512, M = MP + MS;
constexpr int D = 1024, DIN = 6144, FF = 2816, FF2 = 5632;
constexpr int ZQ = 0, ZF = 1024, ZI = 2048, ZOG = 2560, ZU = 3072, ZV = 3584, ZGA = 4096, ZGB = 5120;
constexpr float EPS = 1e-6f;
constexpr size_t O_YP = 0, O_YS = 16777216, O_SP = 17301504, O_SS = 17825792, O_CP = 26214400, O_CS = 26304512, O_VS = 27746304, O_END = 28008448;
constexpr size_t MiB = 1u << 20, KiB = 1u << 10;
constexpr size_t WS_CTL = 0, CTL_ZERO_BYTES = 1 * MiB;
constexpr size_t WS_WIN = 1 * MiB, WS_WPA = 13 * MiB, WS_WPB = 14 * MiB, WS_WO = 15 * MiB, WS_WUP = 17 * MiB, WS_WDN = 28 * MiB;
constexpr size_t WS_LB = 33 * MiB + 512 * KiB;
constexpr size_t WS_XN = 34 * MiB;
constexpr size_t WS_Z = 67 * MiB;
constexpr size_t WS_OA = 265 * MiB, WS_OB = 281 * MiB + 512 * KiB;
constexpr size_t WS_HF = 298 * MiB;
constexpr size_t WS_H = 364 * MiB;
constexpr size_t WS_Y = 67 * MiB;
constexpr size_t WS_UP = 133 * MiB;
constexpr size_t WS_G = 314 * MiB + 512 * KiB;
constexpr size_t WS_END = 406 * MiB;
constexpr int CW_BAR = 4096;

constexpr int RING_OFF = 0, RING_BYTES = 131072;
constexpr int LDSCTL_OFF = RING_BYTES, MISC_OFF = LDSCTL_OFF + 320;
constexpr int AUX_OFF = RING_BYTES + 1024;
constexpr int LDS_BYTES = 147456;

#define GAS __attribute__((address_space(1)))
#define LAS __attribute__((address_space(3)))
typedef unsigned short bf16;
typedef unsigned v4u __attribute__((ext_vector_type(4)));
typedef unsigned v2u __attribute__((ext_vector_type(2)));
typedef float f32x4 __attribute__((ext_vector_type(4)));
#define LDS_WAIT() asm volatile("s_waitcnt lgkmcnt(0)" ::: "memory")
__device__ __forceinline__ unsigned f2bf(float f) { unsigned u = __builtin_bit_cast(unsigned, f); return (u + 0x7fffu + ((u >> 16) & 1u)) >> 16; }
__device__ __forceinline__ unsigned pk2(float lo, float hi) { return f2bf(lo) | (f2bf(hi) << 16); }
__device__ __forceinline__ float bf2f(unsigned short h) { return __uint_as_float(((unsigned)h) << 16); }
__device__ __forceinline__ float bflo(unsigned w) { return __uint_as_float(w << 16); }
__device__ __forceinline__ float bfhi(unsigned w) { return __uint_as_float(w & 0xffff0000u); }
__device__ __forceinline__ float wave_sum(float v) {
#pragma unroll
    for (int o = 1; o < 64; o <<= 1) v += __shfl_xor(v, o);
    return v;
}

#define XB_TMO      128
#define XB_XCNT(j)  (256  + 64 * (j))
#define XB_XSUB(j)  (1280 + 64 * (j))
#define XB_XGEN(j)  (2304 + 64 * (j))
#define XB_TOP      3328
#define XB_TOPGEN   3392
#define XCD_BAR_WORDS 3456
#define XB_SPIN_CAP (1u << 18)
__device__ __forceinline__ unsigned xb_ld(unsigned* p)              { return __hip_atomic_load(p, __ATOMIC_RELAXED, __HIP_MEMORY_SCOPE_AGENT); }
__device__ __forceinline__ unsigned xb_add(unsigned* p, unsigned v) { return __hip_atomic_fetch_add(p, v, __ATOMIC_RELAXED, __HIP_MEMORY_SCOPE_AGENT); }
__device__ __forceinline__ unsigned xb_xcc_id() { return (unsigned)__builtin_amdgcn_s_getreg((3 << 11) | 20) & 0xFu; }
#define XB_SPIN(cond, bar) do { unsigned _sp = 0; while (cond) { __builtin_amdgcn_s_sleep(1); \
    if ((++_sp & 255u) == 0u) { if (xb_ld(&(bar)[XB_TMO])) break; if (_sp > XB_SPIN_CAP) { atomicAdd(&(bar)[XB_TMO], 1u); break; } } } } while (0)
struct XcdBarrier { unsigned* bar; unsigned x; volatile LAS unsigned* st; };
__device__ __forceinline__ XcdBarrier xcd_barrier_post(unsigned* bar, volatile LAS unsigned* st) {
    XcdBarrier b; b.bar = bar; b.x = xb_xcc_id(); b.st = st;
    if (threadIdx.x == 0) (void)xb_add(&bar[XB_XCNT(b.x)], 1u);
    return b;
}
__device__ __forceinline__ void xcd_barrier_complete(unsigned* bar, unsigned x, unsigned& nloc, unsigned& nx) {
    const unsigned G = gridDim.x * gridDim.y * gridDim.z;
    unsigned sum, cnt, mine, sp = 0u;
    for (;;) {
        sum = 0u; cnt = 0u; mine = 0u;
#pragma unroll
        for (unsigned j = 0; j < 16; ++j) { const unsigned c = xb_ld(&bar[XB_XCNT(j)]); sum += c; cnt += (c > 0u) ? 1u : 0u; mine = (j == x) ? c : mine; }
        if (sum == G) break;
        __builtin_amdgcn_s_sleep(1);
        if ((++sp & 255u) == 0u) { if (xb_ld(&bar[XB_TMO])) break; if (sp > XB_SPIN_CAP) { atomicAdd(&bar[XB_TMO], 1u); break; } }
    }
    nloc = mine > 0u ? mine : 1u; nx = cnt > 0u ? cnt : 1u;
}
__device__ __forceinline__ void xcd_barrier(const XcdBarrier& b) {
    asm volatile("s_waitcnt vmcnt(0)" ::: "memory");
    __syncthreads();
    if (threadIdx.x == 0) {
        unsigned* bar = b.bar;
        __builtin_amdgcn_s_waitcnt(0);
        unsigned nloc = b.st[0], nx = b.st[1];
        if (nloc == 0u) { xcd_barrier_complete(bar, b.x, nloc, nx); b.st[0] = nloc; b.st[1] = nx; }
        const unsigned old = xb_add(&bar[XB_XSUB(b.x)], 1u);
        const unsigned gen = old / nloc;
        if (old + 1u == (gen + 1u) * nloc) {
            __builtin_amdgcn_fence(__ATOMIC_RELEASE, "agent");
            asm volatile("s_waitcnt vmcnt(0)" ::: "memory");
            const unsigned og = xb_add(&bar[XB_TOP], 1u);
            const unsigned tg = og / nx;
            if (og + 1u == (tg + 1u) * nx) xb_add(&bar[XB_TOPGEN], 1u);
            else XB_SPIN(xb_ld(&bar[XB_TOPGEN]) == tg, bar);
            __builtin_amdgcn_fence(__ATOMIC_ACQUIRE, "agent");
            xb_add(&bar[XB_XGEN(b.x)], 1u);
            asm volatile("s_waitcnt vmcnt(0)" ::: "memory");
        } else {
            XB_SPIN(xb_ld(&bar[XB_XGEN(b.x)]) == gen, bar);
            __builtin_amdgcn_fence(__ATOMIC_ACQUIRE, "agent");
            asm volatile("s_waitcnt vmcnt(0)" ::: "memory");
        }
    }
    __syncthreads();
}

__device__ __forceinline__ void p0_transpose_item(const float* W, int N, bf16* WT, int ldwt, int koff, LAS float* scr, int item, int lane) {
    const int nblk = N / 32, kb = item / nblk, nb = item % nblk, k0 = 64 * kb, n0 = 32 * nb;
#pragma unroll 8
    for (int i = 0; i < 32; ++i) { const int kk = 2 * i + (lane >> 5); scr[kk * 33 + (lane & 31)] = W[(size_t)(k0 + kk) * N + n0 + (lane & 31)]; }
    LDS_WAIT(); asm volatile("" ::: "memory");
    const int c = lane & 7;
#pragma unroll
    for (int j = 0; j < 4; ++j) { const int n = (lane >> 3) + 8 * j; const LAS float* s = scr + (8 * c) * 33 + n;
        v4u o; o.x = pk2(s[0 * 33], s[1 * 33]); o.y = pk2(s[2 * 33], s[3 * 33]); o.z = pk2(s[4 * 33], s[5 * 33]); o.w = pk2(s[6 * 33], s[7 * 33]);
        *(GAS v4u*)(WT + (size_t)(n0 + n) * ldwt + koff + k0 + 8 * c) = o; }
    LDS_WAIT(); asm volatile("" ::: "memory");
}
__device__ __forceinline__ void rms_row_to_bf16(const float* xrow, const float* g, bf16* orow, int lane) {
    const GAS f32x4* xr = (const GAS f32x4*)xrow + lane; const GAS f32x4* gr = (const GAS f32x4*)g + lane;
    f32x4 v[4]; float s = 0.f;
#pragma unroll
    for (int j = 0; j < 4; ++j) { v[j] = xr[64 * j]; s += (v[j].x * v[j].x + v[j].y * v[j].y) + (v[j].z * v[j].z + v[j].w * v[j].w); }
    const float r = 1.0f / sqrtf(wave_sum(s) * (1.f / D) + EPS);
    GAS v2u* o8 = (GAS v2u*)orow + lane;
#pragma unroll
    for (int j = 0; j < 4; ++j) { const f32x4 gg = gr[64 * j]; v2u o; o.x = pk2(v[j].x * r * gg.x, v[j].y * r * gg.y); o.y = pk2(v[j].z * r * gg.z, v[j].w * r * gg.w); o8[64 * j] = o; }
}
constexpr int HG_TB = 16;
__device__ __forceinline__ void hgrn_recurrent(LAS unsigned char* lds, const bf16* Z, int row0, int T, int h, const float* S0, float* Sout, bf16* OA, const float* ng, int tid) {
    LAS float* Lq = (LAS float*)lds;
    LAS float* Lf = Lq + HG_TB * 128;
    LAS float* Li = Lf + HG_TB * 128;
    LAS float* Lo = Li + HG_TB * 64;
    const int lane = tid & 63, kg = tid >> 6;
    float S[16];
#pragma unroll
    for (int j = 0; j < 16; ++j) S[j] = S0 ? S0[(size_t)(16 * kg + j) * 64 + lane] : 0.f;
    const float gn = ng[lane];
    for (int t0 = 0; t0 < T; t0 += HG_TB) {
        const int nb = (T - t0) < HG_TB ? (T - t0) : HG_TB;
        for (int idx = tid; idx < nb * 128; idx += NT) { const int t = idx >> 7, k = idx & 127; const bf16* zr = Z + (size_t)(row0 + t0 + t) * DIN;
            Lq[idx] = bf2f(zr[ZQ + h * 128 + k]); Lf[idx] = __expf(bf2f(zr[ZF + h * 128 + k])); }
        for (int idx = tid; idx < nb * 64; idx += NT) { const int t = idx >> 6, v = idx & 63; Li[idx] = bf2f(Z[(size_t)(row0 + t0 + t) * DIN + ZI + h * 64 + v]); }
        __syncthreads();
        for (int t = 0; t < nb; ++t) {
            const float iv = Li[t * 64 + lane]; float o = 0.f;
#pragma unroll
            for (int jj = 0; jj < 4; ++jj) { const f32x4 f4 = *(const LAS f32x4*)(Lf + t * 128 + 16 * kg + 4 * jj), q4 = *(const LAS f32x4*)(Lq + t * 128 + 16 * kg + 4 * jj);
#pragma unroll
                for (int e = 0; e < 4; ++e) { const float f = f4[e]; S[4 * jj + e] = f * S[4 * jj + e] + (1.0f - f) * iv; o += q4[e] * S[4 * jj + e]; } }
            Lo[(t * 8 + kg) * 64 + lane] = o;
        }
        __syncthreads();
        for (int t = kg; t < nb; t += 8) {
            float o = 0.f;
#pragma unroll
            for (int w = 0; w < 8; ++w) o += Lo[(t * 8 + w) * 64 + lane];
            const float r = 1.0f / sqrtf(wave_sum(o * o) * (1.f / 64.f) + EPS);
            const size_t row = (size_t)(row0 + t0 + t);
            const float gs = bf2f(Z[row * DIN + ZOG + h * 64 + lane]);
            OA[row * 512 + h * 64 + lane] = (bf16)f2bf(o * r * gn * gs);
        }
    }
    if (Sout) {
#pragma unroll
        for (int j = 0; j < 16; ++j) Sout[(size_t)(16 * kg + j) * 64 + lane] = S[j];
    }
    __syncthreads();
}

__device__ __forceinline__ void gmlp_prompt_item(LAS unsigned char* lds, const bf16* Z, int r0, int g, const float* lng, const float* lnb, const float* ws, const float* bs, bf16* OB, int tid) {
    LAS float* VN = (LAS float*)lds;
    LAS float* WT = VN + 128 * 128;
    LAS float* ST = (LAS float*)(lds + AUX_OFF);
    const int lane = tid & 63, wave = tid >> 6;
    for (int rr = 0; rr < 16; ++rr) { const int row = 16 * wave + rr; const v4u w = *(const GAS v4u*)(Z + (size_t)(r0 + row) * DIN + ZV + 8 * lane);
        const float a0 = bflo(w.x), a1 = bfhi(w.x), a2 = bflo(w.y), a3 = bfhi(w.y), a4 = bflo(w.z), a5 = bfhi(w.z), a6 = bflo(w.w), a7 = bfhi(w.w);
        const float s = wave_sum(((a0 + a1) + (a2 + a3)) + ((a4 + a5) + (a6 + a7)));
        const float mean = s * (1.f / 512.f);
        const float d0 = a0 - mean, d1 = a1 - mean, d2 = a2 - mean, d3 = a3 - mean, d4 = a4 - mean, d5 = a5 - mean, d6 = a6 - mean, d7 = a7 - mean;
        const float q = wave_sum(((d0 * d0 + d1 * d1) + (d2 * d2 + d3 * d3)) + ((d4 * d4 + d5 * d5) + (d6 * d6 + d7 * d7)));
        if (lane == 0) { ST[2 * row] = mean; ST[2 * row + 1] = 1.0f / sqrtf(q * (1.f / 512.f) + EPS); } }
    const float* wg = ws + (size_t)g * 128 * 128;
    for (int idx = tid; idx < 128 * 32; idx += NT) { const int t = idx >> 5, s4 = (idx & 31) * 4; const f32x4 w = *(const GAS f32x4*)(wg + t * 128 + s4);
#pragma unroll
        for (int e = 0; e < 4; ++e) WT[(s4 + e) * 128 + t] = (s4 + e <= t) ? w[e] : 0.f; }
    __syncthreads();
    for (int idx = tid; idx < 128 * 16; idx += NT) { const int row = idx >> 4, oc = idx & 15; const v4u w = *(const GAS v4u*)(Z + (size_t)(r0 + row) * DIN + ZV + 128 * g + 8 * oc);
        const float mean = ST[2 * row], rstd = ST[2 * row + 1]; const float* gp = lng + 128 * g + 8 * oc; const float* bp = lnb + 128 * g + 8 * oc;
        f32x4 o0, o1; o0[0] = (bflo(w.x) - mean) * rstd * gp[0] + bp[0]; o0[1] = (bfhi(w.x) - mean) * rstd * gp[1] + bp[1]; o0[2] = (bflo(w.y) - mean) * rstd * gp[2] + bp[2]; o0[3] = (bfhi(w.y) - mean) * rstd * gp[3] + bp[3];
        o1[0] = (bflo(w.z) - mean) * rstd * gp[4] + bp[4]; o1[1] = (bfhi(w.z) - mean) * rstd * gp[5] + bp[5]; o1[2] = (bflo(w.w) - mean) * rstd * gp[6] + bp[6]; o1[3] = (bfhi(w.w) - mean) * rstd * gp[7] + bp[7];
        *(LAS f32x4*)(VN + row * 128 + 8 * oc) = o0; *(LAS f32x4*)(VN + row * 128 + 8 * oc + 4) = o1; }
    __syncthreads();
    const int c = tid & 127, tq = tid >> 7;
    float acc[32];
#pragma unroll
    for (int j = 0; j < 32; ++j) acc[j] = 0.f;
    const int smax = 32 * tq + 32;
    for (int s = 0; s < smax; ++s) { const float vn = VN[s * 128 + c]; const LAS float* wr_ = WT + s * 128 + 32 * tq;
#pragma unroll
        for (int j4 = 0; j4 < 8; ++j4) { const f32x4 w = *(const LAS f32x4*)(wr_ + 4 * j4);
#pragma unroll
            for (int e = 0; e < 4; ++e) acc[4 * j4 + e] += w[e] * vn; } }
    const float* bsg = bs + g * 128;
#pragma unroll
    for (int j = 0; j < 32; ++j) { const int t = 32 * tq + j; const size_t row = (size_t)(r0 + t);
        const float gu = bf2f(Z[row * DIN + ZU + 128 * g + c]);
        OB[row * 512 + 128 * g + c] = (bf16)f2bf(gu * (acc[j] + bsg[t])); }
    __syncthreads();
}

__device__ __forceinline__ void gmlp_sample_item(LAS unsigned char* lds, const bf16* Z, int sb, const float* lng, const float* lnb, const float* ws, const float* bs, bf16* OB, float* vs_out, int tid) {
    LAS float* VN = (LAS float*)lds;
    const int lane = tid & 63, wave = tid >> 6; const int r0 = MP + 4 * sb;
    if (wave < 4) { const int row = wave; const v4u w = *(const GAS v4u*)(Z + (size_t)(r0 + row) * DIN + ZV + 8 * lane);
        float a[8] = {bflo(w.x), bfhi(w.x), bflo(w.y), bfhi(w.y), bflo(w.z), bfhi(w.z), bflo(w.w), bfhi(w.w)};
        const float s = wave_sum(((a[0] + a[1]) + (a[2] + a[3])) + ((a[4] + a[5]) + (a[6] + a[7]))); const float mean = s * (1.f / 512.f); float q = 0.f;
#pragma unroll
        for (int e = 0; e < 8; ++e) { a[e] -= mean; q += a[e] * a[e]; }
        const float rstd = 1.0f / sqrtf(wave_sum(q) * (1.f / 512.f) + EPS);
#pragma unroll
        for (int e = 0; e < 8; ++e) { const float vn = a[e] * rstd * lng[8 * lane + e] + lnb[8 * lane + e]; VN[row * 512 + 8 * lane + e] = vn; vs_out[(size_t)(4 * sb + row) * 512 + 8 * lane + e] = vn; } }
    __syncthreads();
    for (int idx = tid; idx < 4 * 512; idx += NT) { const int t = idx >> 9, c = idx & 511, g = c >> 7; float s = bs[g * 128 + t];
        for (int q = 0; q <= t; ++q) s += ws[(size_t)g * 16384 + t * 128 + q] * VN[q * 512 + c];
        const size_t row = (size_t)(r0 + t); const float gu = bf2f(Z[row * DIN + ZU + c]);
        OB[row * 512 + c] = (bf16)f2bf(gu * s); }
    __syncthreads();
}

__device__ __forceinline__ void conv_gate_item(const bf16* UP, const float* cache, const float* cw, const float* cb, bf16* G, float* cp, float* cs, int rb, int oc) {
    const int j0 = 8 * oc; const int r0 = 16 * rb; const bool sample = r0 >= MP;
    float w0g[8], w1g[8], w2g[8], bg[8], w0v[8], w1v[8], w2v[8], bv[8];
#pragma unroll
    for (int e = 0; e < 8; ++e) { w0g[e] = cw[j0 + e]; w1g[e] = cw[FF2 + j0 + e]; w2g[e] = cw[2 * FF2 + j0 + e]; bg[e] = cb[j0 + e];
        w0v[e] = cw[FF + j0 + e]; w1v[e] = cw[FF2 + FF + j0 + e]; w2v[e] = cw[2 * FF2 + FF + j0 + e]; bv[e] = cb[FF + j0 + e]; }
    float g2[8], g1[8], v2[8], v1[8];
    if (!sample) {
        if ((r0 & 2047) == 0) {
#pragma unroll
            for (int e = 0; e < 8; ++e) { g2[e] = 0.f; g1[e] = 0.f; v2[e] = 0.f; v1[e] = 0.f; }
        } else {
            const v4u a = *(const GAS v4u*)(UP + (size_t)(r0 - 2) * FF2 + j0), b = *(const GAS v4u*)(UP + (size_t)(r0 - 1) * FF2 + j0);
            const v4u c = *(const GAS v4u*)(UP + (size_t)(r0 - 2) * FF2 + FF + j0), d = *(const GAS v4u*)(UP + (size_t)(r0 - 1) * FF2 + FF + j0);
            g2[0] = bflo(a.x); g2[1] = bfhi(a.x); g2[2] = bflo(a.y); g2[3] = bfhi(a.y); g2[4] = bflo(a.z); g2[5] = bfhi(a.z); g2[6] = bflo(a.w); g2[7] = bfhi(a.w);
            g1[0] = bflo(b.x); g1[1] = bfhi(b.x); g1[2] = bflo(b.y); g1[3] = bfhi(b.y); g1[4] = bflo(b.z); g1[5] = bfhi(b.z); g1[6] = bflo(b.w); g1[7] = bfhi(b.w);
            v2[0] = bflo(c.x); v2[1] = bfhi(c.x); v2[2] = bflo(c.y); v2[3] = bfhi(c.y); v2[4] = bflo(c.z); v2[5] = bfhi(c.z); v2[6] = bflo(c.w); v2[7] = bfhi(c.w);
            v1[0] = bflo(d.x); v1[1] = bfhi(d.x); v1[2] = bflo(d.y); v1[3] = bfhi(d.y); v1[4] = bflo(d.z); v1[5] = bfhi(d.z); v1[6] = bflo(d.w); v1[7] = bfhi(d.w);
        }
    }
#pragma unroll 4
    for (int i = 0; i < 16; ++i) {
        const int r = r0 + i;
        if (sample && (i & 3) == 0) { const int sb = (r - MP) >> 2; const float* c0 = cache + (size_t)sb * 2 * FF2;
#pragma unroll
            for (int e = 0; e < 8; ++e) { g2[e] = c0[j0 + e]; g1[e] = c0[FF2 + j0 + e]; v2[e] = c0[FF + j0 + e]; v1[e] = c0[FF2 + FF + j0 + e]; } }
        const v4u a = *(const GAS v4u*)(UP + (size_t)r * FF2 + j0), c = *(const GAS v4u*)(UP + (size_t)r * FF2 + FF + j0);
        float g0[8] = {bflo(a.x), bfhi(a.x), bflo(a.y), bfhi(a.y), bflo(a.z), bfhi(a.z), bflo(a.w), bfhi(a.w)};
        float v0[8] = {bflo(c.x), bfhi(c.x), bflo(c.y), bfhi(c.y), bflo(c.z), bfhi(c.z), bflo(c.w), bfhi(c.w)};
        float o[8];
#pragma unroll
        for (int e = 0; e < 8; ++e) { const float cg = bg[e] + w0g[e] * g2[e] + w1g[e] * g1[e] + w2g[e] * g0[e]; const float cv = bv[e] + w0v[e] * v2[e] + w1v[e] * v1[e] + w2v[e] * v0[e];
            const float ge = cg * pg8::sigm(1.5957691216057308f * (cg + 0.044715f * cg * cg * cg)); o[e] = ge * cv; }
        v4u ow; ow.x = pk2(o[0], o[1]); ow.y = pk2(o[2], o[3]); ow.z = pk2(o[4], o[5]); ow.w = pk2(o[6], o[7]);
        *(GAS v4u*)(G + (size_t)r * FF + j0) = ow;
        if (!sample) { const int t = r & 2047; if (t >= 2046) { float* dst = cp + ((size_t)(r >> 11) * 2 + (t - 2046)) * FF2;
#pragma unroll
                for (int e = 0; e < 8; ++e) { dst[j0 + e] = g0[e]; dst[FF + j0 + e] = v0[e]; } } }
        else { const int t = (r - MP) & 3; if (t >= 2) { float* dst = cs + ((size_t)((r - MP) >> 2) * 2 + (t - 2)) * FF2;
#pragma unroll
                for (int e = 0; e < 8; ++e) { dst[j0 + e] = g0[e]; dst[FF + j0 + e] = v0[e]; } } }
#pragma unroll
        for (int e = 0; e < 8; ++e) { g2[e] = g1[e]; g1[e] = g0[e]; v2[e] = v1[e]; v1[e] = v0[e]; }
    }
}
typedef short bf16x8v __attribute__((ext_vector_type(8)));
typedef short s16x4 __attribute__((ext_vector_type(4)));
constexpr int HC_PQ = 272, HC_PI = 144;
constexpr int HC_Q0 = 0, HC_KH0 = 17408, HC_I0 = 34816, HC_P0 = 44032, HC_D0 = 53248, HC_BUF = 53760;
constexpr int HC_KT = 2 * HC_BUF, HC_SSQ = HC_KT + 17408, HC_END = HC_SSQ + 1024;
static_assert(HC_END <= RING_BYTES, "HGRN LDS map");
#define HC_BAR() do { asm volatile("s_waitcnt lgkmcnt(0)" ::: "memory"); __builtin_amdgcn_s_barrier(); asm volatile("" ::: "memory"); } while (0)
__device__ __forceinline__ unsigned mul_bf2(unsigned a, unsigned b) { return pg8::cvt_pk_bf16(bflo(a) * bflo(b), bfhi(a) * bfhi(b)); }

struct HcRegs { v4u q[4], e[4], kt[4], kh[4], iv[2]; };
__device__ __forceinline__ void hc_load(HcRegs& R, const bf16* Z, const bf16* ZX, int grow0, int h, int ptid) {
#pragma unroll
    for (int j = 0; j < 4; ++j) { const int id = ptid + 256 * j, row = id >> 4, pc = id & 15; const size_t gr = (size_t)(grow0 + row);
        R.q[j] = *(const GAS v4u*)(Z + gr * DIN + ZQ + 128 * h + 8 * pc); R.e[j] = *(const GAS v4u*)(Z + gr * DIN + ZF + 128 * h + 8 * pc);
        R.kt[j] = *(const GAS v4u*)(ZX + gr * 2048 + 128 * h + 8 * pc); R.kh[j] = *(const GAS v4u*)(ZX + gr * 2048 + 1024 + 128 * h + 8 * pc); }
#pragma unroll
    for (int j = 0; j < 2; ++j) { const int id = ptid + 256 * j, row = id >> 3, pc = id & 7; R.iv[j] = *(const GAS v4u*)(Z + (size_t)(grow0 + row) * DIN + ZI + 64 * h + 8 * pc); }
}
__device__ __forceinline__ void hc_write(const HcRegs& R, LAS unsigned char* lds, LAS unsigned char* Bx, int ptid) {
#pragma unroll
    for (int j = 0; j < 4; ++j) { const int id = ptid + 256 * j, row = id >> 4, pc = id & 15;
        v4u qt; qt.x = mul_bf2(R.q[j].x, R.e[j].x); qt.y = mul_bf2(R.q[j].y, R.e[j].y); qt.z = mul_bf2(R.q[j].z, R.e[j].z); qt.w = mul_bf2(R.q[j].w, R.e[j].w);
        *(LAS v4u*)(Bx + HC_Q0 + row * HC_PQ + pc * 16) = qt;
        *(LAS v4u*)(lds + HC_KT + row * HC_PQ + pc * 16) = R.kt[j];
        *(LAS v4u*)(Bx + HC_KH0 + row * HC_PQ + pc * 16) = R.kh[j];
        if (row == 63) { LAS f32x4* dp = (LAS f32x4*)(Bx + HC_D0 + pc * 32);
            dp[0] = (f32x4){bflo(R.e[j].x), bfhi(R.e[j].x), bflo(R.e[j].y), bfhi(R.e[j].y)}; dp[1] = (f32x4){bflo(R.e[j].z), bfhi(R.e[j].z), bflo(R.e[j].w), bfhi(R.e[j].w)}; } }
#pragma unroll
    for (int j = 0; j < 2; ++j) { const int id = ptid + 256 * j, row = id >> 3, pc = id & 7; *(LAS v4u*)(Bx + HC_I0 + row * HC_PI + pc * 16) = R.iv[j]; }
}
__device__ __forceinline__ void hc_pcomp(LAS unsigned char* lds, LAS unsigned char* Bx, int pw, int c, int g) {
    const int ti = pw, t = 16 * ti + c;
#pragma unroll
    for (int si = 0; si < 4; ++si) { f32x4 acc = {0.f, 0.f, 0.f, 0.f};
        if (si <= ti) {
#pragma unroll
            for (int k4 = 0; k4 < 4; ++k4) { const bf16x8v a = *(const LAS bf16x8v*)(lds + HC_KT + (16 * si + c) * HC_PQ + (32 * k4 + 8 * g) * 2);
                const bf16x8v bq = *(const LAS bf16x8v*)(Bx + HC_Q0 + (16 * ti + c) * HC_PQ + (32 * k4 + 8 * g) * 2);
                acc = __builtin_amdgcn_mfma_f32_16x16x32_bf16(a, bq, acc, 0, 0, 0); } }
        const int s0 = 16 * si + 4 * g;
        v2u w; w.x = pg8::cvt_pk_bf16(s0 <= t ? acc[0] : 0.f, s0 + 1 <= t ? acc[1] : 0.f); w.y = pg8::cvt_pk_bf16(s0 + 2 <= t ? acc[2] : 0.f, s0 + 3 <= t ? acc[3] : 0.f);
        *(LAS v2u*)(Bx + HC_P0 + t * HC_PI + s0 * 2) = w; }
}
__device__ __forceinline__ bf16x8v hc_tr8(const LAS unsigned char* p, int rowpitch4) {
    const s16x4 v0 = __builtin_amdgcn_ds_read_tr16_b64_v4i16((LAS s16x4*)p), v1 = __builtin_amdgcn_ds_read_tr16_b64_v4i16((LAS s16x4*)(p + rowpitch4));
    return __builtin_shufflevector(v0, v1, 0, 1, 2, 3, 4, 5, 6, 7);
}
struct HcCons { f32x4 S[8]; f32x4 O[4]; float gs[16]; };
__device__ __forceinline__ void hc_main(HcCons& K, LAS unsigned char* lds, LAS unsigned char* Bx, int w, int c, int g, int q, int p, const bf16* Z, int grow0, int h) {
    const int vs = 16 * w;
#pragma unroll
    for (int mt = 0; mt < 4; ++mt)
#pragma unroll
        for (int r = 0; r < 4; ++r) K.gs[4 * mt + r] = bf2f(Z[(size_t)(grow0 + 16 * mt + 4 * g + r) * DIN + ZOG + 64 * h + vs + c]);
    bf16x8v bI[2];
#pragma unroll
    for (int ks = 0; ks < 2; ++ks) bI[ks] = hc_tr8(Bx + HC_I0 + (32 * ks + 8 * g + q) * HC_PI + (vs + 4 * p) * 2, 4 * HC_PI);
#pragma unroll
    for (int mt = 0; mt < 4; ++mt) { K.O[mt] = (f32x4){0.f, 0.f, 0.f, 0.f};
#pragma unroll
        for (int ks = 0; ks < 2; ++ks) { const bf16x8v a = *(const LAS bf16x8v*)(Bx + HC_P0 + (16 * mt + c) * HC_PI + (32 * ks + 8 * g) * 2);
            K.O[mt] = __builtin_amdgcn_mfma_f32_16x16x32_bf16(a, bI[ks], K.O[mt], 0, 0, 0); } }
#pragma unroll
    for (int k4 = 0; k4 < 4; ++k4) {
        v4u sb; sb.x = pg8::cvt_pk_bf16(K.S[2 * k4][0], K.S[2 * k4][1]); sb.y = pg8::cvt_pk_bf16(K.S[2 * k4][2], K.S[2 * k4][3]);
        sb.z = pg8::cvt_pk_bf16(K.S[2 * k4 + 1][0], K.S[2 * k4 + 1][1]); sb.w = pg8::cvt_pk_bf16(K.S[2 * k4 + 1][2], K.S[2 * k4 + 1][3]);
        const bf16x8v bS = __builtin_bit_cast(bf16x8v, sb);
#pragma unroll
        for (int mt = 0; mt < 4; ++mt) { const LAS unsigned char* qp = Bx + HC_Q0 + (16 * mt + c) * HC_PQ + (32 * k4 + 4 * g) * 2;
            const v2u a0 = *(const LAS v2u*)qp, a1 = *(const LAS v2u*)(qp + 32);
            const bf16x8v a = __builtin_bit_cast(bf16x8v, (v4u){a0.x, a0.y, a1.x, a1.y});
            K.O[mt] = __builtin_amdgcn_mfma_f32_16x16x32_bf16(a, bS, K.O[mt], 0, 0, 0); } }
#pragma unroll
    for (int kt = 0; kt < 8; ++kt) { const f32x4 d4 = *(const LAS f32x4*)(Bx + HC_D0 + (16 * kt + 4 * g) * 4); K.S[kt] = K.S[kt] * d4;
#pragma unroll
        for (int ks = 0; ks < 2; ++ks) { const bf16x8v a = hc_tr8(Bx + HC_KH0 + (32 * ks + 8 * g + q) * HC_PQ + (16 * kt + 4 * p) * 2, 4 * HC_PQ);
            K.S[kt] = __builtin_amdgcn_mfma_f32_16x16x32_bf16(a, bI[ks], K.S[kt], 0, 0, 0); } }
    LAS float* ssq = (LAS float*)(lds + HC_SSQ);
#pragma unroll
    for (int mt = 0; mt < 4; ++mt)
#pragma unroll
        for (int r = 0; r < 4; ++r) { float s = K.O[mt][r] * K.O[mt][r]; s += __shfl_xor(s, 1); s += __shfl_xor(s, 2); s += __shfl_xor(s, 4); s += __shfl_xor(s, 8);
            if (c == 0) ssq[w * 64 + 16 * mt + 4 * g + r] = s; }
}
__device__ __forceinline__ void hc_epi(const HcCons& K, LAS unsigned char* lds, int w, int c, int g, int grow0, int h, bf16* OA, float gn) {
    const LAS float* ssq = (const LAS float*)(lds + HC_SSQ); const int vs = 16 * w;
#pragma unroll
    for (int mt = 0; mt < 4; ++mt)
#pragma unroll
        for (int r = 0; r < 4; ++r) { const int t = 16 * mt + 4 * g + r; const float ss = (ssq[t] + ssq[64 + t]) + (ssq[128 + t] + ssq[192 + t]);
            const float rn = 1.0f / sqrtf(ss * (1.f / 64.f) + EPS);
            OA[(size_t)(grow0 + t) * 512 + 64 * h + vs + c] = (bf16)f2bf(K.O[mt][r] * rn * gn * K.gs[4 * mt + r]); }
}
__device__ __forceinline__ void hgrn_chunked(LAS unsigned char* lds, const bf16* Z, const bf16* ZX, int b, int h, float* Sout, bf16* OA, const float* ng, int tid) {
    const int lane = tid & 63, wave = __builtin_amdgcn_readfirstlane(tid >> 6);
    const int c = lane & 15, g = lane >> 4, q = (lane & 15) >> 2, p = lane & 3;
    const int rowbase = b * 2048; constexpr int NCH = 32;
    if (wave >= 4) {
        const int ptid = tid - 256, pw = wave - 4;
        HcRegs RA, RB;
        hc_load(RA, Z, ZX, rowbase, h, ptid);
        hc_load(RB, Z, ZX, rowbase + 64, h, ptid);
        hc_write(RA, lds, lds, ptid);
        HC_BAR();
        hc_pcomp(lds, lds, pw, c, g);
        hc_load(RA, Z, ZX, rowbase + 128, h, ptid);
        HC_BAR();
        for (int ch = 0; ch < NCH; ch += 2) {
            hc_write(RB, lds, lds + HC_BUF, ptid);
            HC_BAR();
            hc_pcomp(lds, lds + HC_BUF, pw, c, g);
            if (ch + 3 < NCH) hc_load(RB, Z, ZX, rowbase + 64 * (ch + 3), h, ptid);
            HC_BAR();
            if (ch + 2 < NCH) hc_write(RA, lds, lds, ptid);
            HC_BAR();
            if (ch + 2 < NCH) hc_pcomp(lds, lds, pw, c, g);
            if (ch + 4 < NCH) hc_load(RA, Z, ZX, rowbase + 64 * (ch + 4), h, ptid);
            HC_BAR();
        }
    } else {
        const int w = wave; const float gn = ng[16 * w + c];
        HcCons K;
#pragma unroll
        for (int kt = 0; kt < 8; ++kt) K.S[kt] = (f32x4){0.f, 0.f, 0.f, 0.f};
        HC_BAR();
        HC_BAR();
        for (int ch = 0; ch < NCH; ch += 2) {
            hc_main(K, lds, lds, w, c, g, q, p, Z, rowbase + 64 * ch, h);
            HC_BAR();
            hc_epi(K, lds, w, c, g, rowbase + 64 * ch, h, OA, gn);
            HC_BAR();
            hc_main(K, lds, lds + HC_BUF, w, c, g, q, p, Z, rowbase + 64 * (ch + 1), h);
            HC_BAR();
            hc_epi(K, lds, w, c, g, rowbase + 64 * (ch + 1), h, OA, gn);
            HC_BAR();
        }
#pragma unroll
        for (int kt = 0; kt < 8; ++kt)
#pragma unroll
            for (int r = 0; r < 4; ++r) Sout[(size_t)(16 * kt + 4 * g + r) * 64 + 16 * w + c] = K.S[kt][r];
    }
    __syncthreads();
}
struct Args { const float* in[22]; float* out; unsigned char* ws; };
__global__ void __launch_bounds__(NWAVES * 64, 2) mk_fwd(Args args) {
    extern __shared__ __attribute__((aligned(16))) unsigned char lds[];
    LAS unsigned char* L = (LAS unsigned char*)lds;
    volatile LAS unsigned* MISC = (volatile LAS unsigned*)(L + MISC_OFF);
    const int tid = threadIdx.x, lane = tid & 63, wave = __builtin_amdgcn_readfirstlane(tid >> 6);
    const int G = gridDim.x, bx = blockIdx.x;
    const int vcu = (G % 8 == 0) ? (bx % 8) * (G / 8) + bx / 8 : bx;
    unsigned char* ws = args.ws;
    for (int u = tid; u < (LDS_BYTES - LDSCTL_OFF) / 4; u += NT) ((LAS unsigned*)(L + LDSCTL_OFF))[u] = 0u;
    __syncthreads();
    XcdBarrier bar = xcd_barrier_post((unsigned*)(ws + WS_CTL) + CW_BAR, MISC + 8);

    const float* x_prompt = args.in[0]; const float* x_sample = args.in[1]; const float* state_hgrn = args.in[2]; const float* cache_conv = args.in[3];
    const float* lb_param = args.in[4]; const float* mix_pre_g = args.in[5]; const float* w_in = args.in[6]; const float* hgrn_norm_g = args.in[7];
    const float* gmlp_ln_g = args.in[8]; const float* gmlp_ln_b = args.in[9]; const float* w_s = args.in[10]; const float* b_s = args.in[11];
    const float* w_pa = args.in[12]; const float* w_pb = args.in[13]; const float* w_o = args.in[14]; const float* mix_post_g = args.in[15];
    const float* ffn_pre_g = args.in[16]; const float* w_up = args.in[17]; const float* conv_w = args.in[18]; const float* conv_b = args.in[19];
    const float* w_down = args.in[20]; const float* ffn_post_g = args.in[21];
    float* out = args.out;
    bf16* WinT = (bf16*)(ws + WS_WIN); bf16* WpaT = (bf16*)(ws + WS_WPA); bf16* WpbT = (bf16*)(ws + WS_WPB); bf16* WoT = (bf16*)(ws + WS_WO);
    bf16* WupT = (bf16*)(ws + WS_WUP); bf16* WdnT = (bf16*)(ws + WS_WDN); float* LB = (float*)(ws + WS_LB);
    bf16* XN = (bf16*)(ws + WS_XN); bf16* Z = (bf16*)(ws + WS_Z); bf16* OA = (bf16*)(ws + WS_OA); bf16* OB = (bf16*)(ws + WS_OB);
    float* HF = (float*)(ws + WS_HF); bf16* H = (bf16*)(ws + WS_H); float* Y = (float*)(ws + WS_Y); bf16* UP = (bf16*)(ws + WS_UP); bf16* GG = (bf16*)(ws + WS_G);
    bf16* ZX = (bf16*)out;
    float* X1 = out;

    {
        LAS float* scr = (LAS float*)(L + RING_OFF + wave * 16384);
        const int gw = vcu * NWAVES + wave, NGW = G * NWAVES;
        constexpr int I_IN = (D / 64) * (DIN / 32), I_PA = (512 / 64) * (D / 32), I_O = (D / 64) * (D / 32), I_UP = (D / 64) * (FF2 / 32), I_DN = (FF / 64) * (D / 32);
        constexpr int NITEMS = I_IN + 2 * I_PA + I_O + I_UP + I_DN;
        for (int it = gw; it < NITEMS; it += NGW) {
            int r = it;
            if (r < I_IN) { p0_transpose_item(w_in, DIN, WinT, D, 0, scr, r, lane); continue; } r -= I_IN;
            if (r < I_PA) { p0_transpose_item(w_pa, D, WpaT, 512, 0, scr, r, lane); continue; } r -= I_PA;
            if (r < I_PA) { p0_transpose_item(w_pb, D, WpbT, 512, 0, scr, r, lane); continue; } r -= I_PA;
            if (r < I_O) { p0_transpose_item(w_o, D, WoT, D, 0, scr, r, lane); continue; } r -= I_O;
            if (r < I_UP) { p0_transpose_item(w_up, FF2, WupT, D, 0, scr, r, lane); continue; } r -= I_UP;
            p0_transpose_item(w_down, D, WdnT, FF, 0, scr, r, lane);
        }
        for (int m = gw; m < M; m += NGW) { const float* xr = (m < MP) ? x_prompt + (size_t)m * D : x_sample + (size_t)(m - MP) * D; rms_row_to_bf16(xr, mix_pre_g, XN + (size_t)m * D, lane); }
        if (bx == 0) for (int k = tid; k < 1024; k += NT) LB[k] = 1.0f / (1.0f + __expf(lb_param[1024 + k] - lb_param[k]));
    }
    xcd_barrier(bar);

    { pg8::Gemm g{XN, WinT, M, DIN, D, D}; pg8::StaticOrder S; S.init(M, DIN, G, bx); pg8::EpiZ E{Z, LB, ZX};
      pg8::gemm_phase<pg8::EpiZ, pg8::StaticOrder, true, true>(L + RING_OFF, g, S, E); }
    xcd_barrier(bar);

    if (bx < 64) {
        const int b = bx >> 3, h = bx & 7;
        hgrn_chunked(L, Z, ZX, b, h, out + O_SP + (size_t)bx * 8192, OA, hgrn_norm_g, tid);
    } else {
        for (int it = bx - 64; it < 512 + 1024 + 128; it += G - 64) {
            if (it < 512) { const int b = it >> 6, n = (it >> 2) & 15, g = it & 3; gmlp_prompt_item(L, Z, b * 2048 + n * 128, g, gmlp_ln_g, gmlp_ln_b, w_s, b_s, OB, tid); }
            else if (it < 1536) { const int i2 = it - 512, sb = i2 >> 3, h = i2 & 7;
                hgrn_recurrent(L, Z, MP + 4 * sb, 4, h, state_hgrn + (size_t)i2 * 8192, out + O_SS + (size_t)i2 * 8192, OA, hgrn_norm_g, tid); }
            else gmlp_sample_item(L, Z, it - 1536, gmlp_ln_g, gmlp_ln_b, w_s, b_s, OB, out + O_VS, tid);
        }
    }
    xcd_barrier(bar);

    { pg8::Gemm g{OA, WpaT, M, D, 512, 512}; pg8::StaticOrder S; S.init(M, D, G, bx); pg8::EpiGateF32 E{HF, Z, ZGA};
      pg8::gemm_phase<pg8::EpiGateF32, pg8::StaticOrder, true, true>(L + RING_OFF, g, S, E); }
    xcd_barrier(bar);
    { pg8::Gemm g{OB, WpbT, M, D, 512, 512}; pg8::StaticOrder S; S.init(M, D, G, bx); pg8::EpiComb E{H, HF, Z, ZGB};
      pg8::gemm_phase<pg8::EpiComb, pg8::StaticOrder, true, true>(L + RING_OFF, g, S, E); }
    xcd_barrier(bar);
    { pg8::Gemm g{H, WoT, M, D, D, D}; pg8::StaticOrder S; S.init(M, D, G, bx); pg8::EpiF32 E{Y, D};
      pg8::gemm_phase<pg8::EpiF32, pg8::StaticOrder, true, true>(L + RING_OFF, g, S, E); }
    xcd_barrier(bar);
    {
        const int gw = bx * NWAVES + wave, NGW = G * NWAVES;
        for (int m = gw; m < M; m += NGW) {
            const float* xr = (m < MP) ? x_prompt + (size_t)m * D : x_sample + (size_t)(m - MP) * D;
            const GAS f32x4* yr = (const GAS f32x4*)(Y + (size_t)m * D) + lane; const GAS f32x4* xv = (const GAS f32x4*)xr + lane;
            f32x4 y[4]; float s = 0.f;
#pragma unroll
            for (int j = 0; j < 4; ++j) { y[j] = yr[64 * j]; s += (y[j].x * y[j].x + y[j].y * y[j].y) + (y[j].z * y[j].z + y[j].w * y[j].w); }
            const float r = 1.0f / sqrtf(wave_sum(s) * (1.f / D) + EPS); float s2 = 0.f;
            GAS f32x4* x1r = (GAS f32x4*)(X1 + (size_t)m * D) + lane;
#pragma unroll
            for (int j = 0; j < 4; ++j) { const f32x4 gg = ((const GAS f32x4*)mix_post_g)[lane + 64 * j]; const f32x4 xx = xv[64 * j];
                y[j].x = xx.x + y[j].x * r * gg.x; y[j].y = xx.y + y[j].y * r * gg.y; y[j].z = xx.z + y[j].z * r * gg.z; y[j].w = xx.w + y[j].w * r * gg.w;
                x1r[64 * j] = y[j]; s2 += (y[j].x * y[j].x + y[j].y * y[j].y) + (y[j].z * y[j].z + y[j].w * y[j].w); }
            const float r2 = 1.0f / sqrtf(wave_sum(s2) * (1.f / D) + EPS);
            GAS v2u* o8 = (GAS v2u*)(XN + (size_t)m * D) + lane;
#pragma unroll
            for (int j = 0; j < 4; ++j) { const f32x4 gg = ((const GAS f32x4*)ffn_pre_g)[lane + 64 * j]; v2u o; o.x = pk2(y[j].x * r2 * gg.x, y[j].y * r2 * gg.y); o.y = pk2(y[j].z * r2 * gg.z, y[j].w * r2 * gg.w); o8[64 * j] = o; }
        }
    }
    xcd_barrier(bar);
    { pg8::Gemm g{XN, WupT, M, FF2, D, D}; pg8::StaticOrder S; S.init(M, FF2, G, bx); pg8::EpiBf16<0> E{UP, FF2, nullptr, 0, 0, 1.f};
      pg8::gemm_phase<pg8::EpiBf16<0>, pg8::StaticOrder, true, true>(L + RING_OFF, g, S, E); }
    xcd_barrier(bar);
    for (int it = bx; it < (M / 16) * (FF / 8) / NT; it += G) { const int idx = it * NT + tid; conv_gate_item(UP, cache_conv, conv_w, conv_b, GG, out + O_CP, out + O_CS, idx / (FF / 8), idx % (FF / 8)); }
    xcd_barrier(bar);
    { pg8::Gemm g{GG, WdnT, M, D, FF, FF}; pg8::StaticOrder S; S.init(M, D, G, bx); pg8::EpiF32 E{Y, D};
      pg8::gemm_phase<pg8::EpiF32, pg8::StaticOrder, true, true>(L + RING_OFF, g, S, E); }
    xcd_barrier(bar);
    {
        const int gw = bx * NWAVES + wave, NGW = G * NWAVES;
        const bool bad = xb_ld((unsigned*)(ws + WS_CTL) + CW_BAR + XB_TMO) != 0u;
        for (int m = gw; m < M; m += NGW) {
            const GAS f32x4* yr = (const GAS f32x4*)(Y + (size_t)m * D) + lane; GAS f32x4* x1r = (GAS f32x4*)(X1 + (size_t)m * D) + lane;
            f32x4 y[4]; float s = 0.f;
#pragma unroll
            for (int j = 0; j < 4; ++j) { y[j] = yr[64 * j]; s += (y[j].x * y[j].x + y[j].y * y[j].y) + (y[j].z * y[j].z + y[j].w * y[j].w); }
            float r = 1.0f / sqrtf(wave_sum(s) * (1.f / D) + EPS); if (bad) r = __builtin_nanf("");
#pragma unroll
            for (int j = 0; j < 4; ++j) { const f32x4 gg = ((const GAS f32x4*)ffn_post_g)[lane + 64 * j]; f32x4 xx = x1r[64 * j];
                xx.x += y[j].x * r * gg.x; xx.y += y[j].y * r * gg.y; xx.z += y[j].z * r * gg.z; xx.w += y[j].w * r * gg.w; x1r[64 * j] = xx; }
        }
    }
}

extern "C" void kernel_launch(void* const* d_in, const int* in_sizes, int n_in, void* d_out, int out_size, void* d_ws, size_t ws_size, hipStream_t stream) {
    static int grid = 0;
    if (grid == 0) {
        if (n_in != 22 || (size_t)out_size != O_END || ws_size < WS_END) { fprintf(stderr, "kernel_launch: unexpected shapes (n_in %d out %d ws %zu)\n", n_in, out_size, ws_size); grid = -1; return; }
        int dev = 0, cus = 0, per_cu = 0;
        if (hipGetDevice(&dev) != hipSuccess || hipDeviceGetAttribute(&cus, hipDeviceAttributeMultiprocessorCount, dev) != hipSuccess) { grid = -1; return; }
        if (hipFuncSetAttribute((const void*)mk_fwd, hipFuncAttributeMaxDynamicSharedMemorySize, LDS_BYTES) != hipSuccess) { fprintf(stderr, "kernel_launch: hipFuncSetAttribute failed\n"); grid = -1; return; }
        if (hipOccupancyMaxActiveBlocksPerMultiprocessor(&per_cu, (const void*)mk_fwd, NWAVES * 64, LDS_BYTES) != hipSuccess || per_cu < 1) { fprintf(stderr, "kernel_launch: occupancy query says %d blocks per CU\n", per_cu); (void)hipGetLastError(); grid = -1; return; }
        grid = cus;
        if (grid != 256) { fprintf(stderr, "kernel_launch: built for 256 CUs, found %d\n", cus); grid = -1; return; }
    }
    if (grid < 0) return;
    (void)hipMemsetAsync((char*)d_ws + WS_CTL, 0, CTL_ZERO_BYTES, stream);
    Args a{};
    for (int i = 0; i < 22; ++i) a.in[i] = (const float*)d_in[i];
    a.out = (float*)d_out; a.ws = (unsigned char*)d_ws;
    hipLaunchKernelGGL(mk_fwd, dim3(grid), dim3(NWAVES * 64), LDS_BYTES, stream, a);
}
```

```cpp
#include <hip/hip_runtime.h>
#include <cstdio>
#include <cstdint>
namespace pg8 {
#define PG8_LAS __attribute__((address_space(3)))
typedef unsigned short bf16_t;
typedef short bf16x8 __attribute__((ext_vector_type(8)));
typedef float f32x4 __attribute__((ext_vector_type(4)));
typedef unsigned u32x4 __attribute__((ext_vector_type(4)));
constexpr int BM = 256, BK = 64, HALF = 128, HTB = HALF * BK * 2  , STAGE_BYTES = 8 * HTB, NXCD = 8, WGM = 8;

__host__ __device__ __forceinline__ int lds_byte(int r, int c) { const int st = (r >> 4) * 2 + (c >> 5), rr = r & 15, cc = c & 31, ob = rr * 64 + cc * 2; return st * 1024 + (ob ^ (((ob >> 9) & 1) << 5)); }
__host__ __device__ __forceinline__ void stage_rc(int b, int& R, int& C) { const int st = b / 1024, sb = b % 1024, swz = sb ^ (((sb >> 9) & 1) << 5); R = (st >> 1) * 16 + swz / 64; C = (st & 1) * 32 + (swz % 64) / 2; }
__host__ __device__ __forceinline__ int perm32(int rho) { const int n = rho >> 4, i = rho & 15; return 8 * (i >> 2) + 4 * n + (i & 3); }

struct Unit { int pm, pn; };
struct Gemm { const bf16_t* A; const bf16_t* Bt; int M, N, K, lda; };

struct StaticOrder {
    int nM, nN, nwg, G, c;
    __host__ __device__ void init(int M, int N, int G_, int c_) { nM = M / BM; nN = N / BM; nwg = nM * nN; G = G_; c = c_; }
    __host__ __device__ bool next(int i, Unit& u) const {
        const long L = (long)i * G + c; if (L >= nwg) return false;
        int wgid = (int)L; { const int q = nwg / NXCD, r = nwg % NXCD, xcd = wgid % NXCD, off = wgid / NXCD; wgid = (xcd < r ? xcd * (q + 1) : r * (q + 1) + (xcd - r) * q) + off; }
        const int nig = WGM * nN, gid = wgid / nig, fm = gid * WGM, gsz = (nM - fm) < WGM ? (nM - fm) : WGM;
        u.pm = fm + ((wgid % nig) % gsz); u.pn = (wgid % nig) / gsz; return true;
    }
    __device__ __forceinline__ void a_ready(const Unit&) const {}
    __device__ __forceinline__ void done(const Unit&) const {}
};

typedef __bf16 bf16x2_t __attribute__((ext_vector_type(2)));
typedef float f32x2_t __attribute__((ext_vector_type(2)));
__device__ __forceinline__ unsigned cvt_pk_bf16(float lo, float hi) { const f32x2_t v = {lo, hi}; const bf16x2_t b = __builtin_convertvector(v, bf16x2_t); return __builtin_bit_cast(unsigned, b); }
typedef float f32x2 __attribute__((ext_vector_type(2)));
__device__ __forceinline__ f32x2 gelu_pk(f32x2 v) {
    const f32x2 av = __builtin_elementwise_abs(v), d = av * 0.2316418882f + 1.0f;
    f32x2 t; t.x = __builtin_amdgcn_rcpf(d.x); t.y = __builtin_amdgcn_rcpf(d.y);
    f32x2 q = t * 0.5307027145f + (-0.7265760135f); q = q * t + 0.7107068705f; q = q * t + (-0.142248368f); q = q * t + 0.127414796f; q = q * t;
    const f32x2 s = (v * v) * (-0.72134752044f);
    f32x2 e; e.x = __builtin_amdgcn_exp2f(s.x); e.y = __builtin_amdgcn_exp2f(s.y);
    const f32x2 m = v * (q * e), r = v - m;
    f32x2 o; o.x = v.x < 0.f ? m.x : r.x; o.y = v.y < 0.f ? m.y : r.y; return o;
}

template <int ACT  > struct EpiBf16 {
    static constexpr bool PERM = true, AFTER_DRAIN = false; static_assert(ACT == 0 || ACT == 1, "EpiBf16: ACT is 0 (none) or 1 (gelu_pk)");
    bf16_t* O; int ldc; const float* bias; int split_cols; size_t split_stride; float scale0;
    __device__ __forceinline__ void operator()(const f32x4 (&acc)[2][2][4][2], const Unit& u, int wr, int wc, int fr, int fq) const {
        const int row0 = u.pm * BM + wr * 64 + fr; int colt = u.pn * BM; bf16_t* base = O;
        float sc = 1.f; if (split_cols) { const int t = colt / split_cols; base += (size_t)t * split_stride; colt -= t * split_cols; if (t == 0) sc = scale0; }
        const int col0 = colt + wc * 32 + 8 * fq, bcol0 = u.pn * BM + wc * 32 + 8 * fq;
        f32x4 bv[2][2];
#pragma unroll
        for (int bj = 0; bj < 2; ++bj)
#pragma unroll
            for (int n = 0; n < 2; ++n) bv[bj][n] = bias ? *(const f32x4*)(bias + bcol0 + bj * HALF + 4 * n) : (f32x4){0.f, 0.f, 0.f, 0.f};
#pragma unroll
        for (int ai = 0; ai < 2; ++ai)
#pragma unroll
            for (int m = 0; m < 4; ++m) { bf16_t* rowp = base + (size_t)(row0 + ai * HALF + m * 16) * ldc + col0;
#pragma unroll
                for (int bj = 0; bj < 2; ++bj) { f32x4 v0 = acc[ai][bj][m][0] + bv[bj][0], v1 = acc[ai][bj][m][1] + bv[bj][1];
                    if (ACT == 1) { f32x2 a = gelu_pk((f32x2){v0[0], v0[1]}), b = gelu_pk((f32x2){v0[2], v0[3]}), c = gelu_pk((f32x2){v1[0], v1[1]}), d = gelu_pk((f32x2){v1[2], v1[3]});
                        v0 = (f32x4){a.x, a.y, b.x, b.y}; v1 = (f32x4){c.x, c.y, d.x, d.y}; }
                    v0 = v0 * sc; v1 = v1 * sc; u32x4 w; w.x = cvt_pk_bf16(v0[0], v0[1]); w.y = cvt_pk_bf16(v0[2], v0[3]); w.z = cvt_pk_bf16(v1[0], v1[1]); w.w = cvt_pk_bf16(v1[2], v1[3]);
                    *(u32x4*)(rowp + bj * HALF) = w; } }
    }
};

template <class Epi, class Sched, bool ALIGN_EPI = false, bool SP2 = false>
__device__ __forceinline__ void gemm_phase(PG8_LAS unsigned char* lds, const Gemm g, const Sched& S, const Epi& E) {
    const int tid = threadIdx.x, wid = __builtin_amdgcn_readfirstlane(tid >> 6), lane = tid & 63, wr = wid >> 2, wc = wid & 3, fr = lane & 15, fq = lane >> 4;
    const int K = g.K, nt = K / BK;
    unsigned voffA[2], voffB[2];
#pragma unroll
    for (int i = 0; i < 2; ++i) { int R, C; stage_rc(tid * 16 + i * 8192, R, C); const int Rb = Epi::PERM ? ((R & ~31) + perm32(R & 31)) : R;
        voffA[i] = (unsigned)(R * g.lda + C) * 2u; voffB[i] = (unsigned)(Rb * K + C) * 2u; }
    const size_t kstep = (size_t)(BK * 2);
    const size_t hstepA = (size_t)HALF * g.lda * 2, hstepB = (size_t)HALF * K * 2;
    const size_t tstepA = 2 * hstepA, tstepB = 2 * hstepB;
    const unsigned ldsw = (unsigned)wid * 1024u;
    const int aoff = lds_byte(wr * 64 + fr, fq * 8), boff = lds_byte(wc * 32 + fr, fq * 8);
#define PG8_SA(b, h) (((b) * 2 + (h)) * HTB)
#define PG8_SB(b, h) ((4 + (b) * 2 + (h)) * HTB)
#define PG8_STAGE(bufoff, gbase, voff) do { _Pragma("unroll") for (int _i = 0; _i < 2; ++_i) \
        __builtin_amdgcn_global_load_lds((const unsigned*)((const char*)(gbase) + (voff)[_i]), (PG8_LAS unsigned*)(lds + (bufoff) + ldsw + _i * 8192), 16, 0, 0); } while (0)
#define PG8_LDA(dst, b, h) do { _Pragma("unroll") for (int m = 0; m < 4; ++m) _Pragma("unroll") for (int k = 0; k < 2; ++k) dst[m][k] = *(const PG8_LAS bf16x8*)(lds + PG8_SA(b, h) + aoff + m * 2048 + k * 1024); } while (0)
#define PG8_LDB(dst, b, h) do { _Pragma("unroll") for (int n = 0; n < 2; ++n) _Pragma("unroll") for (int k = 0; k < 2; ++k) dst[n][k] = *(const PG8_LAS bf16x8*)(lds + PG8_SB(b, h) + boff + n * 2048 + k * 1024); } while (0)
#define PG8_MMA(ai, bj, At, Bt) do { __builtin_amdgcn_s_setprio(1); _Pragma("unroll") for (int m = 0; m < 4; ++m) _Pragma("unroll") for (int n = 0; n < 2; ++n) _Pragma("unroll") for (int k = 0; k < 2; ++k) \
        acc[ai][bj][m][n] = __builtin_amdgcn_mfma_f32_16x16x32_bf16(Bt[n][k], At[m][k], acc[ai][bj][m][n], 0, 0, 0); __builtin_amdgcn_s_setprio(0); } while (0)
#define PG8_WAIT_V(n) asm volatile("s_waitcnt vmcnt(" #n ")" ::: "memory")
#define PG8_WAIT_L(n) asm volatile("s_waitcnt lgkmcnt(" #n ")" ::: "memory")
#define PG8_BAR __builtin_amdgcn_s_barrier()
#define PG8_SCHED __builtin_amdgcn_sched_barrier(0)
    Unit cur, nxt; int ui = 0;
    if (!S.next(0, cur)) return;
    f32x4 acc[2][2][4][2];
#pragma unroll
    for (int a = 0; a < 2; ++a)
#pragma unroll
        for (int b = 0; b < 2; ++b)
#pragma unroll
            for (int m = 0; m < 4; ++m)
#pragma unroll
                for (int n = 0; n < 2; ++n) acc[a][b][m][n] = (f32x4){0.f, 0.f, 0.f, 0.f};
    bf16x8 At[4][2], B0[2][2], B1[2][2];
    const char* cA = (const char*)g.A + (size_t)cur.pm * tstepA; const char* cB = (const char*)g.Bt + (size_t)cur.pn * tstepB;
    S.a_ready(cur);
    if constexpr (SP2) {
        PG8_STAGE(PG8_SB(0, 0), cB, voffB); PG8_STAGE(PG8_SB(0, 1), cB + hstepB, voffB); PG8_STAGE(PG8_SA(0, 0), cA, voffA); PG8_STAGE(PG8_SA(0, 1), cA + hstepA, voffA);
        if (wr == 1) PG8_BAR;
        PG8_WAIT_V(2); PG8_BAR;
        PG8_STAGE(PG8_SB(1, 0), cB + kstep, voffB); PG8_STAGE(PG8_SA(1, 0), cA + kstep, voffA); PG8_STAGE(PG8_SB(1, 1), cB + hstepB + kstep, voffB);
        PG8_WAIT_V(6); PG8_BAR;
    } else {
        PG8_STAGE(PG8_SB(0, 0), cB, voffB); PG8_STAGE(PG8_SA(0, 0), cA, voffA); PG8_STAGE(PG8_SB(0, 1), cB + hstepB, voffB); PG8_STAGE(PG8_SA(0, 1), cA + hstepA, voffA);
        if (wr == 1) PG8_BAR;
        PG8_WAIT_V(4); PG8_BAR;
        PG8_STAGE(PG8_SB(1, 0), cB + kstep, voffB); PG8_STAGE(PG8_SA(1, 0), cA + kstep, voffA); PG8_STAGE(PG8_SB(1, 1), cB + hstepB + kstep, voffB);
        PG8_WAIT_V(6); PG8_BAR;
    }
    for (;;) {
        const bool has_next = S.next(ui + 1, nxt);
        const char* nA = has_next ? (const char*)g.A + (size_t)nxt.pm * tstepA : cA; const char* nB = has_next ? (const char*)g.Bt + (size_t)nxt.pn * tstepB : cB;
        for (int t = 0; t < nt; t += 2) {
            const bool last = (t == nt - 2);
            const char* a1 = cA + (size_t)(t + 1) * kstep;
            const char* a2 = last ? nA : cA + (size_t)(t + 2) * kstep; const char* b2 = last ? nB : cB + (size_t)(t + 2) * kstep;
            const char* a3 = a2 + kstep; const char* b3 = b2 + kstep;
            if (last && has_next) S.a_ready(nxt);
            if constexpr (SP2) {
            PG8_LDB(B0, 0, 0); PG8_LDB(B1, 0, 1); PG8_SCHED; PG8_LDA(At, 0, 0); PG8_STAGE(PG8_SA(1, 1), a1 + hstepA, voffA);
            PG8_WAIT_V(8); PG8_WAIT_L(0); PG8_BAR; PG8_MMA(0, 0, At, B0); PG8_MMA(0, 1, At, B1); PG8_BAR; PG8_SCHED;
            PG8_LDA(At, 0, 1); PG8_STAGE(PG8_SB(0, 0), b2, voffB); PG8_STAGE(PG8_SB(0, 1), b2 + hstepB, voffB); PG8_STAGE(PG8_SA(0, 0), a2, voffA);
            PG8_WAIT_V(8); PG8_WAIT_L(0); PG8_BAR; PG8_MMA(1, 0, At, B0); PG8_MMA(1, 1, At, B1); PG8_BAR; PG8_SCHED;
            PG8_LDB(B0, 1, 0); PG8_LDB(B1, 1, 1); PG8_SCHED; PG8_LDA(At, 1, 0); PG8_STAGE(PG8_SA(0, 1), a2 + hstepA, voffA);
            PG8_WAIT_V(8); PG8_WAIT_L(0); PG8_BAR; PG8_MMA(0, 0, At, B0); PG8_MMA(0, 1, At, B1); PG8_BAR; PG8_SCHED;
            PG8_LDA(At, 1, 1); PG8_STAGE(PG8_SB(1, 0), b3, voffB); PG8_STAGE(PG8_SB(1, 1), b3 + hstepB, voffB); PG8_STAGE(PG8_SA(1, 0), a3, voffA);
            PG8_WAIT_V(8); PG8_WAIT_L(0); PG8_BAR; PG8_MMA(1, 0, At, B0); PG8_MMA(1, 1, At, B1); PG8_BAR; PG8_SCHED;
            } else {
            PG8_LDB(B0, 0, 0); PG8_SCHED; PG8_LDA(At, 0, 0); PG8_STAGE(PG8_SA(1, 1), a1 + hstepA, voffA);
            PG8_WAIT_L(8); PG8_BAR; PG8_WAIT_L(0); PG8_MMA(0, 0, At, B0); PG8_BAR; PG8_SCHED;
            PG8_LDB(B1, 0, 1); PG8_STAGE(PG8_SB(0, 0), b2, voffB);
            PG8_BAR; PG8_WAIT_L(0); PG8_MMA(0, 1, At, B1); PG8_BAR;
            PG8_LDA(At, 0, 1); PG8_STAGE(PG8_SA(0, 0), a2, voffA);
            PG8_BAR; PG8_WAIT_L(0); PG8_MMA(1, 0, At, B0); PG8_BAR; PG8_SCHED;
            PG8_STAGE(PG8_SB(0, 1), b2 + hstepB, voffB);
            PG8_WAIT_V(6); PG8_BAR; PG8_MMA(1, 1, At, B1); PG8_BAR;
            PG8_LDB(B0, 1, 0); PG8_SCHED; PG8_LDA(At, 1, 0); PG8_STAGE(PG8_SA(0, 1), a2 + hstepA, voffA);
            PG8_WAIT_L(8); PG8_BAR; PG8_WAIT_L(0); PG8_MMA(0, 0, At, B0); PG8_BAR; PG8_SCHED;
            PG8_LDB(B1, 1, 1); PG8_STAGE(PG8_SB(1, 0), b3, voffB);
            PG8_BAR; PG8_WAIT_L(0); PG8_MMA(0, 1, At, B1); PG8_BAR;
            PG8_LDA(At, 1, 1); PG8_STAGE(PG8_SA(1, 0), a3, voffA);
            PG8_BAR; PG8_WAIT_L(0); PG8_MMA(1, 0, At, B0); PG8_BAR; PG8_SCHED;
            PG8_STAGE(PG8_SB(1, 1), b3 + hstepB, voffB);
            PG8_WAIT_V(6); PG8_BAR; PG8_MMA(1, 1, At, B1); PG8_BAR;
            }
        }
        if constexpr (ALIGN_EPI) { if (wr == 0) PG8_BAR; }
        if constexpr (!Epi::AFTER_DRAIN) { E(acc, cur, wr, wc, fr, fq); S.done(cur); }
        if (!has_next) break;
#pragma unroll
        for (int a = 0; a < 2; ++a)
#pragma unroll
            for (int b = 0; b < 2; ++b)
#pragma unroll
                for (int m = 0; m < 4; ++m)
#pragma unroll
                    for (int n = 0; n < 2; ++n) acc[a][b][m][n] = (f32x4){0.f, 0.f, 0.f, 0.f};
        cur = nxt; cA = nA; cB = nB; ++ui;
        if constexpr (ALIGN_EPI) { if (wr == 1) PG8_BAR; }
    }
    PG8_WAIT_V(0);
    if constexpr (!ALIGN_EPI) { if (wr == 0) PG8_BAR; }
    PG8_BAR;
    if constexpr (Epi::AFTER_DRAIN) { E.fused(acc, cur, wr, wc, fr, fq, lds, wid, lane); S.done(cur); }
#undef PG8_SA
#undef PG8_SB
#undef PG8_STAGE
#undef PG8_LDA
#undef PG8_LDB
#undef PG8_MMA
#undef PG8_WAIT_V
#undef PG8_WAIT_L
#undef PG8_BAR
#undef PG8_SCHED
}
struct EpiF32 {
    static constexpr bool PERM = false, AFTER_DRAIN = false;
    float* C; int ldc;
    __device__ __forceinline__ void operator()(const f32x4 (&acc)[2][2][4][2], const Unit& u, int wr, int wc, int fr, int fq) const {
        const int row0 = u.pm * BM + wr * 64 + fr, col0 = u.pn * BM + wc * 32 + 4 * fq;
#pragma unroll
        for (int ai = 0; ai < 2; ++ai)
#pragma unroll
            for (int m = 0; m < 4; ++m) { float* rowp = C + (size_t)(row0 + ai * HALF + m * 16) * ldc + col0;
#pragma unroll
                for (int bj = 0; bj < 2; ++bj)
#pragma unroll
                    for (int n = 0; n < 2; ++n) *(f32x4*)(rowp + bj * HALF + n * 16) = acc[ai][bj][m][n]; }
    }
};
__device__ __forceinline__ float bf_lo(unsigned w) { return __uint_as_float(w << 16); }
__device__ __forceinline__ float bf_hi(unsigned w) { return __uint_as_float(w & 0xffff0000u); }
__device__ __forceinline__ float sigm(float x) { return __builtin_amdgcn_rcpf(1.0f + __builtin_amdgcn_exp2f(-1.4426950408889634f * x)); }
template <int MODE> __device__ __forceinline__ float zact(float x, float lb) {
    if (MODE == 0) return x * sigm(x);
    if (MODE == 1) { const float f = lb + (1.0f - lb) * sigm(x); return 0.6931471805599453f * __builtin_amdgcn_logf(f); }
    if (MODE == 2) return x;
    if (MODE == 3) return x * sigm(1.5957691216057308f * (x + 0.044715f * x * x * x));
    return sigm(x);
}
template <int N> __device__ __forceinline__ float row_shr(float v) {
    return __builtin_bit_cast(float, __builtin_amdgcn_update_dpp(0, __builtin_bit_cast(int, v), 0x110 + N, 0xf, 0xf, true));
}
struct EpiZ {
    static constexpr bool PERM = true, AFTER_DRAIN = false;
    bf16_t* Z; const float* lb; bf16_t* ZX;
    template <int MODE> __device__ __forceinline__ void run(const f32x4 (&acc)[2][2][4][2], const Unit& u, int wr, int wc, int fr, int fq) const {
        const int row0 = u.pm * BM + wr * 64 + fr, col0 = u.pn * BM + wc * 32 + 8 * fq;
        f32x4 lv[2][2];
#pragma unroll
        for (int bj = 0; bj < 2; ++bj)
#pragma unroll
            for (int n = 0; n < 2; ++n) lv[bj][n] = (MODE == 1) ? *(const f32x4*)(lb + (col0 - 1024) + bj * HALF + 4 * n) : (f32x4){0.f, 0.f, 0.f, 0.f};
#pragma unroll
        for (int ai = 0; ai < 2; ++ai)
#pragma unroll
            for (int m = 0; m < 4; ++m) { bf16_t* rowp = Z + (size_t)(row0 + ai * HALF + m * 16) * 6144 + col0;
#pragma unroll
                for (int bj = 0; bj < 2; ++bj) { const f32x4 a = acc[ai][bj][m][0], b = acc[ai][bj][m][1]; const f32x4 l0 = lv[bj][0], l1 = lv[bj][1];
                    u32x4 w; w.x = cvt_pk_bf16(zact<MODE>(a[0], l0[0]), zact<MODE>(a[1], l0[1])); w.y = cvt_pk_bf16(zact<MODE>(a[2], l0[2]), zact<MODE>(a[3], l0[3]));
                    w.z = cvt_pk_bf16(zact<MODE>(b[0], l1[0]), zact<MODE>(b[1], l1[1])); w.w = cvt_pk_bf16(zact<MODE>(b[2], l1[2]), zact<MODE>(b[3], l1[3]));
                    *(u32x4*)(rowp + bj * HALF) = w; } }
    }
    __device__ __forceinline__ void run_hgrn(const f32x4 (&acc)[2][2][4][2], const Unit& u, int wr, int wc, int fr, int fq) const {
        typedef unsigned u32x2 __attribute__((ext_vector_type(2)));
        const int row0 = u.pm * BM + wr * 64 + fr, col0 = u.pn * BM + wc * 32 + 8 * fq, kc0 = col0 - 1024;
#pragma unroll
        for (int ai = 0; ai < 2; ++ai)
#pragma unroll
            for (int bj = 0; bj < 2; ++bj)
#pragma unroll
                for (int n = 0; n < 2; ++n) { const f32x4 l4 = *(const f32x4*)(lb + kc0 + bj * HALF + 4 * n);
                    unsigned wE[4][2], wT[4][2], wH[4][2];
#pragma unroll
                    for (int e2 = 0; e2 < 2; ++e2) { float Ev[4][2], Tv[4][2], Hv[4][2];
#pragma unroll
                        for (int ee = 0; ee < 2; ++ee) { const int e = 2 * e2 + ee; const float lbv = l4[e]; float lfv[4], kkv[4];
#pragma unroll
                            for (int m = 0; m < 4; ++m) { const float x = acc[ai][bj][m][n][e]; const float s = sigm(x); const float f = lbv + (1.0f - lbv) * s;
                                lfv[m] = __builtin_amdgcn_logf(f); kkv[m] = (1.0f - lbv) * (1.0f - s); }
                            float run = 0.f, bc[4];
#pragma unroll
                            for (int m = 0; m < 4; ++m) { float v = lfv[m]; v += row_shr<1>(v); v += row_shr<2>(v); v += row_shr<4>(v); v += row_shr<8>(v);
                                const float tot = __shfl(v, 15, 16); bc[m] = v + run; run += tot; }
                            const float eL = __builtin_amdgcn_exp2f(run);
#pragma unroll
                            for (int m = 0; m < 4; ++m) { const float kt = kkv[m] * __builtin_amdgcn_exp2f(fminf(-bc[m], 120.f));
                                Ev[m][ee] = __builtin_amdgcn_exp2f(bc[m]); Tv[m][ee] = kt; Hv[m][ee] = kt * eL; } }
#pragma unroll
                        for (int m = 0; m < 4; ++m) { wE[m][e2] = cvt_pk_bf16(Ev[m][0], Ev[m][1]); wT[m][e2] = cvt_pk_bf16(Tv[m][0], Tv[m][1]); wH[m][e2] = cvt_pk_bf16(Hv[m][0], Hv[m][1]); } }
#pragma unroll
                    for (int m = 0; m < 4; ++m) { const size_t r = (size_t)(row0 + ai * HALF + m * 16);
                        *(u32x2*)(Z + r * 6144 + col0 + bj * HALF + 4 * n) = (u32x2){wE[m][0], wE[m][1]};
                        *(u32x2*)(ZX + r * 2048 + kc0 + bj * HALF + 4 * n) = (u32x2){wT[m][0], wT[m][1]};
                        *(u32x2*)(ZX + r * 2048 + 1024 + kc0 + bj * HALF + 4 * n) = (u32x2){wH[m][0], wH[m][1]}; }
                    asm volatile("" ::: "memory");
                }
    }
    __device__ __forceinline__ void operator()(const f32x4 (&acc)[2][2][4][2], const Unit& u, int wr, int wc, int fr, int fq) const {
        const int pn = u.pn;
        if (pn < 4) run<0>(acc, u, wr, wc, fr, fq);
        else if (pn < 8) { if (u.pm < 64) run_hgrn(acc, u, wr, wc, fr, fq); else run<1>(acc, u, wr, wc, fr, fq); }
        else if (pn < 10) run<2>(acc, u, wr, wc, fr, fq);
        else if (pn < 12) run<0>(acc, u, wr, wc, fr, fq);
        else if (pn < 16) run<3>(acc, u, wr, wc, fr, fq);
        else run<4>(acc, u, wr, wc, fr, fq);
    }
};
struct EpiGateF32 {
    static constexpr bool PERM = true, AFTER_DRAIN = false;
    float* C; const bf16_t* Z; int gcol;
    __device__ __forceinline__ void operator()(const f32x4 (&acc)[2][2][4][2], const Unit& u, int wr, int wc, int fr, int fq) const {
        const int row0 = u.pm * BM + wr * 64 + fr, col0 = u.pn * BM + wc * 32 + 8 * fq;
#pragma unroll
        for (int ai = 0; ai < 2; ++ai)
#pragma unroll
            for (int m = 0; m < 4; ++m) { const size_t r = (size_t)(row0 + ai * HALF + m * 16);
#pragma unroll
                for (int bj = 0; bj < 2; ++bj) { const u32x4 gw = *(const u32x4*)(Z + r * 6144 + gcol + col0 + bj * HALF);
                    const f32x4 a = acc[ai][bj][m][0], b = acc[ai][bj][m][1];
                    f32x4 o0, o1; o0[0] = a[0] * bf_lo(gw.x); o0[1] = a[1] * bf_hi(gw.x); o0[2] = a[2] * bf_lo(gw.y); o0[3] = a[3] * bf_hi(gw.y);
                    o1[0] = b[0] * bf_lo(gw.z); o1[1] = b[1] * bf_hi(gw.z); o1[2] = b[2] * bf_lo(gw.w); o1[3] = b[3] * bf_hi(gw.w);
                    float* p = C + r * 1024 + col0 + bj * HALF; *(f32x4*)p = o0; *(f32x4*)(p + 4) = o1; } }
    }
};
struct EpiComb {
    static constexpr bool PERM = true, AFTER_DRAIN = false;
    bf16_t* H; const float* Hf; const bf16_t* Z; int gcol;
    __device__ __forceinline__ void operator()(const f32x4 (&acc)[2][2][4][2], const Unit& u, int wr, int wc, int fr, int fq) const {
        const int row0 = u.pm * BM + wr * 64 + fr, col0 = u.pn * BM + wc * 32 + 8 * fq;
#pragma unroll
        for (int ai = 0; ai < 2; ++ai)
#pragma unroll
            for (int m = 0; m < 4; ++m) { const size_t r = (size_t)(row0 + ai * HALF + m * 16);
#pragma unroll
                for (int bj = 0; bj < 2; ++bj) { const u32x4 gw = *(const u32x4*)(Z + r * 6144 + gcol + col0 + bj * HALF);
                    const float* hp = Hf + r * 1024 + col0 + bj * HALF; const f32x4 h0 = *(const f32x4*)hp, h1 = *(const f32x4*)(hp + 4);
                    const f32x4 a = acc[ai][bj][m][0], b = acc[ai][bj][m][1];
                    u32x4 w; w.x = cvt_pk_bf16(h0[0] + a[0] * bf_lo(gw.x), h0[1] + a[1] * bf_hi(gw.x)); w.y = cvt_pk_bf16(h0[2] + a[2] * bf_lo(gw.y), h0[3] + a[3] * bf_hi(gw.y));
                    w.z = cvt_pk_bf16(h1[0] + b[0] * bf_lo(gw.z), h1[1] + b[1] * bf_hi(gw.z)); w.w = cvt_pk_bf16(h1[2] + b[2] * bf_lo(gw.w), h1[3] + b[3] * bf_hi(gw.w));
                    *(u32x4*)(H + r * 1024 + col0 + bj * HALF) = w; } }
    }
};
}
constexpr int NWAVES = 8, NT = 512;
constexpr int MP = 16384, MS = 512, M = MP + MS;
constexpr int D = 1024, DIN = 6144, FF = 2816, FF2 = 5632;
constexpr int ZQ = 0, ZF = 1024, ZI = 2048, ZOG = 2560, ZU = 3072, ZV = 3584, ZGA = 4096, ZGB = 5120;
constexpr float EPS = 1e-6f;
constexpr size_t O_YP = 0, O_YS = 16777216, O_SP = 17301504, O_SS = 17825792, O_CP = 26214400, O_CS = 26304512, O_VS = 27746304, O_END = 28008448;
constexpr size_t MiB = 1u << 20, KiB = 1u << 10;
constexpr size_t WS_CTL = 0, CTL_ZERO_BYTES = 1 * MiB;
constexpr size_t WS_WIN = 1 * MiB, WS_WPA = 13 * MiB, WS_WPB = 14 * MiB, WS_WO = 15 * MiB, WS_WUP = 17 * MiB, WS_WDN = 28 * MiB;
constexpr size_t WS_LB = 33 * MiB + 512 * KiB;
constexpr size_t WS_WSB = 33 * MiB + 576 * KiB;
constexpr size_t WS_XN = 34 * MiB;
constexpr size_t WS_Z = 67 * MiB;
constexpr size_t WS_OA = 265 * MiB, WS_OB = 281 * MiB + 512 * KiB;
constexpr size_t WS_HF = 298 * MiB;
constexpr size_t WS_H = 364 * MiB;
constexpr size_t WS_Y = 67 * MiB;
constexpr size_t WS_UP = 133 * MiB;
constexpr size_t WS_G = 314 * MiB + 512 * KiB;
constexpr size_t WS_END = 406 * MiB;
constexpr int CW_BAR = 4096;

constexpr int RING_OFF = 0, RING_BYTES = 131072;
constexpr int LDSCTL_OFF = RING_BYTES, MISC_OFF = LDSCTL_OFF + 320;
constexpr int AUX_OFF = RING_BYTES + 1024;
constexpr int LDS_BYTES = 147456;

#define GAS __attribute__((address_space(1)))
#define LAS __attribute__((address_space(3)))
typedef unsigned short bf16;
typedef unsigned v4u __attribute__((ext_vector_type(4)));
typedef unsigned v2u __attribute__((ext_vector_type(2)));
typedef float f32x4 __attribute__((ext_vector_type(4)));
#define LDS_WAIT() asm volatile("s_waitcnt lgkmcnt(0)" ::: "memory")
__device__ __forceinline__ unsigned f2bf(float f) { unsigned u = __builtin_bit_cast(unsigned, f); return (u + 0x7fffu + ((u >> 16) & 1u)) >> 16; }
__device__ __forceinline__ unsigned pk2(float lo, float hi) { return f2bf(lo) | (f2bf(hi) << 16); }
__device__ __forceinline__ float bf2f(unsigned short h) { return __uint_as_float(((unsigned)h) << 16); }
__device__ __forceinline__ float bflo(unsigned w) { return __uint_as_float(w << 16); }
__device__ __forceinline__ float bfhi(unsigned w) { return __uint_as_float(w & 0xffff0000u); }
__device__ __forceinline__ float wave_sum(float v) {
#pragma unroll
    for (int o = 1; o < 64; o <<= 1) v += __shfl_xor(v, o);
    return v;
}

#define XB_TMO      128
#define XB_XCNT(j)  (256  + 64 * (j))
#define XB_XSUB(j)  (1280 + 64 * (j))
#define XB_XGEN(j)  (2304 + 64 * (j))
#define XB_TOP      3328
#define XB_TOPGEN   3392
#define XCD_BAR_WORDS 3456
#define XB_SPIN_CAP (1u << 18)
__device__ __forceinline__ unsigned xb_ld(unsigned* p)              { return __hip_atomic_load(p, __ATOMIC_RELAXED, __HIP_MEMORY_SCOPE_AGENT); }
__device__ __forceinline__ unsigned xb_add(unsigned* p, unsigned v) { return __hip_atomic_fetch_add(p, v, __ATOMIC_RELAXED, __HIP_MEMORY_SCOPE_AGENT); }
__device__ __forceinline__ unsigned xb_xcc_id() { return (unsigned)__builtin_amdgcn_s_getreg((3 << 11) | 20) & 0xFu; }
#define XB_SPIN(cond, bar) do { unsigned _sp = 0; while (cond) { __builtin_amdgcn_s_sleep(1); \
    if ((++_sp & 255u) == 0u) { if (xb_ld(&(bar)[XB_TMO])) break; if (_sp > XB_SPIN_CAP) { atomicAdd(&(bar)[XB_TMO], 1u); break; } } } } while (0)
struct XcdBarrier { unsigned* bar; unsigned x; volatile LAS unsigned* st; };
__device__ __forceinline__ XcdBarrier xcd_barrier_post(unsigned* bar, volatile LAS unsigned* st) {
    XcdBarrier b; b.bar = bar; b.x = xb_xcc_id(); b.st = st;
    if (threadIdx.x == 0) (void)xb_add(&bar[XB_XCNT(b.x)], 1u);
    return b;
}
__device__ __forceinline__ void xcd_barrier_complete(unsigned* bar, unsigned x, unsigned& nloc, unsigned& nx) {
    const unsigned G = gridDim.x * gridDim.y * gridDim.z;
    unsigned sum, cnt, mine, sp = 0u;
    for (;;) {
        sum = 0u; cnt = 0u; mine = 0u;
#pragma unroll
        for (unsigned j = 0; j < 16; ++j) { const unsigned c = xb_ld(&bar[XB_XCNT(j)]); sum += c; cnt += (c > 0u) ? 1u : 0u; mine = (j == x) ? c : mine; }
        if (sum == G) break;
        __builtin_amdgcn_s_sleep(1);
        if ((++sp & 255u) == 0u) { if (xb_ld(&bar[XB_TMO])) break; if (sp > XB_SPIN_CAP) { atomicAdd(&bar[XB_TMO], 1u); break; } }
    }
    nloc = mine > 0u ? mine : 1u; nx = cnt > 0u ? cnt : 1u;
}
__device__ __forceinline__ void xcd_barrier(const XcdBarrier& b) {
    asm volatile("s_waitcnt vmcnt(0)" ::: "memory");
    __syncthreads();
    if (threadIdx.x == 0) {
        unsigned* bar = b.bar;
        __builtin_amdgcn_s_waitcnt(0);
        unsigned nloc = b.st[0], nx = b.st[1];
        if (nloc == 0u) { xcd_barrier_complete(bar, b.x, nloc, nx); b.st[0] = nloc; b.st[1] = nx; }
        const unsigned old = xb_add(&bar[XB_XSUB(b.x)], 1u);
        const unsigned gen = old / nloc;
        if (old + 1u == (gen + 1u) * nloc) {
            __builtin_amdgcn_fence(__ATOMIC_RELEASE, "agent");
            asm volatile("s_waitcnt vmcnt(0)" ::: "memory");
            const unsigned og = xb_add(&bar[XB_TOP], 1u);
            const unsigned tg = og / nx;
            if (og + 1u == (tg + 1u) * nx) xb_add(&bar[XB_TOPGEN], 1u);
            else XB_SPIN(xb_ld(&bar[XB_TOPGEN]) == tg, bar);
            __builtin_amdgcn_fence(__ATOMIC_ACQUIRE, "agent");
            xb_add(&bar[XB_XGEN(b.x)], 1u);
            asm volatile("s_waitcnt vmcnt(0)" ::: "memory");
        } else {
            XB_SPIN(xb_ld(&bar[XB_XGEN(b.x)]) == gen, bar);
            __builtin_amdgcn_fence(__ATOMIC_ACQUIRE, "agent");
            asm volatile("s_waitcnt vmcnt(0)" ::: "memory");
        }
    }
    __syncthreads();
}

__device__ __forceinline__ void p0_transpose_item(const float* W, int N, bf16* WT, int ldwt, int koff, LAS float* scr, int item, int lane) {
    const int nblk = N / 32, kb = item / nblk, nb = item % nblk, k0 = 64 * kb, n0 = 32 * nb;
#pragma unroll 8
    for (int i = 0; i < 32; ++i) { const int kk = 2 * i + (lane >> 5); scr[kk * 33 + (lane & 31)] = W[(size_t)(k0 + kk) * N + n0 + (lane & 31)]; }
    LDS_WAIT(); asm volatile("" ::: "memory");
    const int c = lane & 7;
#pragma unroll
    for (int j = 0; j < 4; ++j) { const int n = (lane >> 3) + 8 * j; const LAS float* s = scr + (8 * c) * 33 + n;
        v4u o; o.x = pk2(s[0 * 33], s[1 * 33]); o.y = pk2(s[2 * 33], s[3 * 33]); o.z = pk2(s[4 * 33], s[5 * 33]); o.w = pk2(s[6 * 33], s[7 * 33]);
        *(GAS v4u*)(WT + (size_t)(n0 + n) * ldwt + koff + k0 + 8 * c) = o; }
    LDS_WAIT(); asm volatile("" ::: "memory");
}
__device__ __forceinline__ void rms_row_to_bf16(const float* xrow, const float* g, bf16* orow, int lane) {
    const GAS f32x4* xr = (const GAS f32x4*)xrow + lane; const GAS f32x4* gr = (const GAS f32x4*)g + lane;
    f32x4 v[4]; float s = 0.f;
#pragma unroll
    for (int j = 0; j < 4; ++j) { v[j] = xr[64 * j]; s += (v[j].x * v[j].x + v[j].y * v[j].y) + (v[j].z * v[j].z + v[j].w * v[j].w); }
    const float r = 1.0f / sqrtf(wave_sum(s) * (1.f / D) + EPS);
    GAS v2u* o8 = (GAS v2u*)orow + lane;
#pragma unroll
    for (int j = 0; j < 4; ++j) { const f32x4 gg = gr[64 * j]; v2u o; o.x = pk2(v[j].x * r * gg.x, v[j].y * r * gg.y); o.y = pk2(v[j].z * r * gg.z, v[j].w * r * gg.w); o8[64 * j] = o; }
}
constexpr int HG_TB = 16;
__device__ __forceinline__ void hgrn_recurrent(LAS unsigned char* lds, const bf16* Z, int row0, int T, int h, const float* S0, float* Sout, bf16* OA, const float* ng, int tid) {
    LAS float* Lq = (LAS float*)lds;
    LAS float* Lf = Lq + HG_TB * 128;
    LAS float* Li = Lf + HG_TB * 128;
    LAS float* Lo = Li + HG_TB * 64;
    const int lane = tid & 63, kg = tid >> 6;
    float S[16];
#pragma unroll
    for (int j = 0; j < 16; ++j) S[j] = S0 ? S0[(size_t)(16 * kg + j) * 64 + lane] : 0.f;
    const float gn = ng[lane];
    for (int t0 = 0; t0 < T; t0 += HG_TB) {
        const int nb = (T - t0) < HG_TB ? (T - t0) : HG_TB;
        for (int idx = tid; idx < nb * 128; idx += NT) { const int t = idx >> 7, k = idx & 127; const bf16* zr = Z + (size_t)(row0 + t0 + t) * DIN;
            Lq[idx] = bf2f(zr[ZQ + h * 128 + k]); Lf[idx] = __expf(bf2f(zr[ZF + h * 128 + k])); }
        for (int idx = tid; idx < nb * 64; idx += NT) { const int t = idx >> 6, v = idx & 63; Li[idx] = bf2f(Z[(size_t)(row0 + t0 + t) * DIN + ZI + h * 64 + v]); }
        __syncthreads();
        for (int t = 0; t < nb; ++t) {
            const float iv = Li[t * 64 + lane]; float o = 0.f;
#pragma unroll
            for (int jj = 0; jj < 4; ++jj) { const f32x4 f4 = *(const LAS f32x4*)(Lf + t * 128 + 16 * kg + 4 * jj), q4 = *(const LAS f32x4*)(Lq + t * 128 + 16 * kg + 4 * jj);
#pragma unroll
                for (int e = 0; e < 4; ++e) { const float f = f4[e]; S[4 * jj + e] = f * S[4 * jj + e] + (1.0f - f) * iv; o += q4[e] * S[4 * jj + e]; } }
            Lo[(t * 8 + kg) * 64 + lane] = o;
        }
        __syncthreads();
        for (int t = kg; t < nb; t += 8) {
            float o = 0.f;
#pragma unroll
            for (int w = 0; w < 8; ++w) o += Lo[(t * 8 + w) * 64 + lane];
            const float r = 1.0f / sqrtf(wave_sum(o * o) * (1.f / 64.f) + EPS);
            const size_t row = (size_t)(row0 + t0 + t);
            const float gs = bf2f(Z[row * DIN + ZOG + h * 64 + lane]);
            OA[row * 512 + h * 64 + lane] = (bf16)f2bf(o * r * gn * gs);
        }
    }
    if (Sout) {
#pragma unroll
        for (int j = 0; j < 16; ++j) Sout[(size_t)(16 * kg + j) * 64 + lane] = S[j];
    }
    __syncthreads();
}

__device__ __forceinline__ void gmlp_prompt_item(LAS unsigned char* lds, const bf16* Z, int r0, int g, const float* lng, const float* lnb, const float* ws, const float* bs, bf16* OB, int tid) {
    LAS float* VN = (LAS float*)lds;
    LAS float* WT = VN + 128 * 128;
    LAS float* ST = (LAS float*)(lds + AUX_OFF);
    const int lane = tid & 63, wave = tid >> 6;
    for (int rr = 0; rr < 16; ++rr) { const int row = 16 * wave + rr; const v4u w = *(const GAS v4u*)(Z + (size_t)(r0 + row) * DIN + ZV + 8 * lane);
        const float a0 = bflo(w.x), a1 = bfhi(w.x), a2 = bflo(w.y), a3 = bfhi(w.y), a4 = bflo(w.z), a5 = bfhi(w.z), a6 = bflo(w.w), a7 = bfhi(w.w);
        const float s = wave_sum(((a0 + a1) + (a2 + a3)) + ((a4 + a5) + (a6 + a7)));
        const float mean = s * (1.f / 512.f);
        const float d0 = a0 - mean, d1 = a1 - mean, d2 = a2 - mean, d3 = a3 - mean, d4 = a4 - mean, d5 = a5 - mean, d6 = a6 - mean, d7 = a7 - mean;
        const float q = wave_sum(((d0 * d0 + d1 * d1) + (d2 * d2 + d3 * d3)) + ((d4 * d4 + d5 * d5) + (d6 * d6 + d7 * d7)));
        if (lane == 0) { ST[2 * row] = mean; ST[2 * row + 1] = 1.0f / sqrtf(q * (1.f / 512.f) + EPS); } }
    const float* wg = ws + (size_t)g * 128 * 128;
    for (int idx = tid; idx < 128 * 32; idx += NT) { const int t = idx >> 5, s4 = (idx & 31) * 4; const f32x4 w = *(const GAS f32x4*)(wg + t * 128 + s4);
#pragma unroll
        for (int e = 0; e < 4; ++e) WT[(s4 + e) * 128 + t] = (s4 + e <= t) ? w[e] : 0.f; }
    __syncthreads();
    for (int idx = tid; idx < 128 * 16; idx += NT) { const int row = idx >> 4, oc = idx & 15; const v4u w = *(const GAS v4u*)(Z + (size_t)(r0 + row) * DIN + ZV + 128 * g + 8 * oc);
        const float mean = ST[2 * row], rstd = ST[2 * row + 1]; const float* gp = lng + 128 * g + 8 * oc; const float* bp = lnb + 128 * g + 8 * oc;
        f32x4 o0, o1; o0[0] = (bflo(w.x) - mean) * rstd * gp[0] + bp[0]; o0[1] = (bfhi(w.x) - mean) * rstd * gp[1] + bp[1]; o0[2] = (bflo(w.y) - mean) * rstd * gp[2] + bp[2]; o0[3] = (bfhi(w.y) - mean) * rstd * gp[3] + bp[3];
        o1[0] = (bflo(w.z) - mean) * rstd * gp[4] + bp[4]; o1[1] = (bfhi(w.z) - mean) * rstd * gp[5] + bp[5]; o1[2] = (bflo(w.w) - mean) * rstd * gp[6] + bp[6]; o1[3] = (bfhi(w.w) - mean) * rstd * gp[7] + bp[7];
        *(LAS f32x4*)(VN + row * 128 + 8 * oc) = o0; *(LAS f32x4*)(VN + row * 128 + 8 * oc + 4) = o1; }
    __syncthreads();
    const int c = tid & 127, tq = tid >> 7;
    float acc[32];
#pragma unroll
    for (int j = 0; j < 32; ++j) acc[j] = 0.f;
    const int smax = 32 * tq + 32;
    for (int s = 0; s < smax; ++s) { const float vn = VN[s * 128 + c]; const LAS float* wr_ = WT + s * 128 + 32 * tq;
#pragma unroll
        for (int j4 = 0; j4 < 8; ++j4) { const f32x4 w = *(const LAS f32x4*)(wr_ + 4 * j4);
#pragma unroll
            for (int e = 0; e < 4; ++e) acc[4 * j4 + e] += w[e] * vn; } }
    const float* bsg = bs + g * 128;
#pragma unroll
    for (int j = 0; j < 32; ++j) { const int t = 32 * tq + j; const size_t row = (size_t)(r0 + t);
        const float gu = bf2f(Z[row * DIN + ZU + 128 * g + c]);
        OB[row * 512 + 128 * g + c] = (bf16)f2bf(gu * (acc[j] + bsg[t])); }
    __syncthreads();
}

__device__ __forceinline__ void gmlp_sample_item(LAS unsigned char* lds, const bf16* Z, int sb, const float* lng, const float* lnb, const float* ws, const float* bs, bf16* OB, float* vs_out, int tid) {
    LAS float* VN = (LAS float*)lds;
    const int lane = tid & 63, wave = tid >> 6; const int r0 = MP + 4 * sb;
    if (wave < 4) { const int row = wave; const v4u w = *(const GAS v4u*)(Z + (size_t)(r0 + row) * DIN + ZV + 8 * lane);
        float a[8] = {bflo(w.x), bfhi(w.x), bflo(w.y), bfhi(w.y), bflo(w.z), bfhi(w.z), bflo(w.w), bfhi(w.w)};
        const float s = wave_sum(((a[0] + a[1]) + (a[2] + a[3])) + ((a[4] + a[5]) + (a[6] + a[7]))); const float mean = s * (1.f / 512.f); float q = 0.f;
#pragma unroll
        for (int e = 0; e < 8; ++e) { a[e] -= mean; q += a[e] * a[e]; }
        const float rstd = 1.0f / sqrtf(wave_sum(q) * (1.f / 512.f) + EPS);
#pragma unroll
        for (int e = 0; e < 8; ++e) { const float vn = a[e] * rstd * lng[8 * lane + e] + lnb[8 * lane + e]; VN[row * 512 + 8 * lane + e] = vn; vs_out[(size_t)(4 * sb + row) * 512 + 8 * lane + e] = vn; } }
    __syncthreads();
    for (int idx = tid; idx < 4 * 512; idx += NT) { const int t = idx >> 9, c = idx & 511, g = c >> 7; float s = bs[g * 128 + t];
        for (int q = 0; q <= t; ++q) s += ws[(size_t)g * 16384 + t * 128 + q] * VN[q * 512 + c];
        const size_t row = (size_t)(r0 + t); const float gu = bf2f(Z[row * DIN + ZU + c]);
        OB[row * 512 + c] = (bf16)f2bf(gu * s); }
    __syncthreads();
}

__device__ __forceinline__ void conv_gate_item(const bf16* UP, const float* cache, const float* cw, const float* cb, bf16* G, float* cp, float* cs, int rb, int oc) {
    const int j0 = 8 * oc; const int r0 = 16 * rb; const bool sample = r0 >= MP;
    float w0g[8], w1g[8], w2g[8], bg[8], w0v[8], w1v[8], w2v[8], bv[8];
#pragma unroll
    for (int e = 0; e < 8; ++e) { w0g[e] = cw[j0 + e]; w1g[e] = cw[FF2 + j0 + e]; w2g[e] = cw[2 * FF2 + j0 + e]; bg[e] = cb[j0 + e];
        w0v[e] = cw[FF + j0 + e]; w1v[e] = cw[FF2 + FF + j0 + e]; w2v[e] = cw[2 * FF2 + FF + j0 + e]; bv[e] = cb[FF + j0 + e]; }
    float g2[8], g1[8], v2[8], v1[8];
    if (!sample) {
        if ((r0 & 2047) == 0) {
#pragma unroll
            for (int e = 0; e < 8; ++e) { g2[e] = 0.f; g1[e] = 0.f; v2[e] = 0.f; v1[e] = 0.f; }
        } else {
            const v4u a = *(const GAS v4u*)(UP + (size_t)(r0 - 2) * FF2 + j0), b = *(const GAS v4u*)(UP + (size_t)(r0 - 1) * FF2 + j0);
            const v4u c = *(const GAS v4u*)(UP + (size_t)(r0 - 2) * FF2 + FF + j0), d = *(const GAS v4u*)(UP + (size_t)(r0 - 1) * FF2 + FF + j0);
            g2[0] = bflo(a.x); g2[1] = bfhi(a.x); g2[2] = bflo(a.y); g2[3] = bfhi(a.y); g2[4] = bflo(a.z); g2[5] = bfhi(a.z); g2[6] = bflo(a.w); g2[7] = bfhi(a.w);
            g1[0] = bflo(b.x); g1[1] = bfhi(b.x); g1[2] = bflo(b.y); g1[3] = bfhi(b.y); g1[4] = bflo(b.z); g1[5] = bfhi(b.z); g1[6] = bflo(b.w); g1[7] = bfhi(b.w);
            v2[0] = bflo(c.x); v2[1] = bfhi(c.x); v2[2] = bflo(c.y); v2[3] = bfhi(c.y); v2[4] = bflo(c.z); v2[5] = bfhi(c.z); v2[6] = bflo(c.w); v2[7] = bfhi(c.w);
            v1[0] = bflo(d.x); v1[1] = bfhi(d.x); v1[2] = bflo(d.y); v1[3] = bfhi(d.y); v1[4] = bflo(d.z); v1[5] = bfhi(d.z); v1[6] = bflo(d.w); v1[7] = bfhi(d.w);
        }
    }
#pragma unroll 4
    for (int i = 0; i < 16; ++i) {
        const int r = r0 + i;
        if (sample && (i & 3) == 0) { const int sb = (r - MP) >> 2; const float* c0 = cache + (size_t)sb * 2 * FF2;
#pragma unroll
            for (int e = 0; e < 8; ++e) { g2[e] = c0[j0 + e]; g1[e] = c0[FF2 + j0 + e]; v2[e] = c0[FF + j0 + e]; v1[e] = c0[FF2 + FF + j0 + e]; } }
        const v4u a = *(const GAS v4u*)(UP + (size_t)r * FF2 + j0), c = *(const GAS v4u*)(UP + (size_t)r * FF2 + FF + j0);
        float g0[8] = {bflo(a.x), bfhi(a.x), bflo(a.y), bfhi(a.y), bflo(a.z), bfhi(a.z), bflo(a.w), bfhi(a.w)};
        float v0[8] = {bflo(c.x), bfhi(c.x), bflo(c.y), bfhi(c.y), bflo(c.z), bfhi(c.z), bflo(c.w), bfhi(c.w)};
        float o[8];
#pragma unroll
        for (int e = 0; e < 8; ++e) { const float cg = bg[e] + w0g[e] * g2[e] + w1g[e] * g1[e] + w2g[e] * g0[e]; const float cv = bv[e] + w0v[e] * v2[e] + w1v[e] * v1[e] + w2v[e] * v0[e];
            const float ge = cg * pg8::sigm(1.5957691216057308f * (cg + 0.044715f * cg * cg * cg)); o[e] = ge * cv; }
        v4u ow; ow.x = pk2(o[0], o[1]); ow.y = pk2(o[2], o[3]); ow.z = pk2(o[4], o[5]); ow.w = pk2(o[6], o[7]);
        *(GAS v4u*)(G + (size_t)r * FF + j0) = ow;
        if (!sample) { const int t = r & 2047; if (t >= 2046) { float* dst = cp + ((size_t)(r >> 11) * 2 + (t - 2046)) * FF2;
#pragma unroll
                for (int e = 0; e < 8; ++e) { dst[j0 + e] = g0[e]; dst[FF + j0 + e] = v0[e]; } } }
        else { const int t = (r - MP) & 3; if (t >= 2) { float* dst = cs + ((size_t)((r - MP) >> 2) * 2 + (t - 2)) * FF2;
#pragma unroll
                for (int e = 0; e < 8; ++e) { dst[j0 + e] = g0[e]; dst[FF + j0 + e] = v0[e]; } } }
#pragma unroll
        for (int e = 0; e < 8; ++e) { g2[e] = g1[e]; g1[e] = g0[e]; v2[e] = v1[e]; v1[e] = v0[e]; }
    }
}
typedef short bf16x8v __attribute__((ext_vector_type(8)));
typedef short s16x4 __attribute__((ext_vector_type(4)));
constexpr int HC_PQ = 272, HC_PI = 144;
constexpr int HC_Q0 = 0, HC_KH0 = 17408, HC_I0 = 34816, HC_P0 = 44032, HC_D0 = 53248, HC_BUF = 53760;
constexpr int HC_KT = 2 * HC_BUF, HC_SSQ = HC_KT + 17408, HC_END = HC_SSQ + 1024;
static_assert(HC_END <= RING_BYTES, "HGRN LDS map");
#define HC_BAR() do { asm volatile("s_waitcnt lgkmcnt(0)" ::: "memory"); __builtin_amdgcn_s_barrier(); asm volatile("" ::: "memory"); } while (0)
__device__ __forceinline__ unsigned mul_bf2(unsigned a, unsigned b) { return pg8::cvt_pk_bf16(bflo(a) * bflo(b), bfhi(a) * bfhi(b)); }

struct HcRegs { v4u q[4], e[4], kt[4], kh[4], iv[2]; };
__device__ __forceinline__ void hc_load(HcRegs& R, const bf16* Z, const bf16* ZX, int grow0, int h, int ptid) {
#pragma unroll
    for (int j = 0; j < 4; ++j) { const int id = ptid + 256 * j, row = id >> 4, pc = id & 15; const size_t gr = (size_t)(grow0 + row);
        R.q[j] = *(const GAS v4u*)(Z + gr * DIN + ZQ + 128 * h + 8 * pc); R.e[j] = *(const GAS v4u*)(Z + gr * DIN + ZF + 128 * h + 8 * pc);
        R.kt[j] = *(const GAS v4u*)(ZX + gr * 2048 + 128 * h + 8 * pc); R.kh[j] = *(const GAS v4u*)(ZX + gr * 2048 + 1024 + 128 * h + 8 * pc); }
#pragma unroll
    for (int j = 0; j < 2; ++j) { const int id = ptid + 256 * j, row = id >> 3, pc = id & 7; R.iv[j] = *(const GAS v4u*)(Z + (size_t)(grow0 + row) * DIN + ZI + 64 * h + 8 * pc); }
}
__device__ __forceinline__ void hc_write(const HcRegs& R, LAS unsigned char* lds, LAS unsigned char* Bx, int ptid) {
#pragma unroll
    for (int j = 0; j < 4; ++j) { const int id = ptid + 256 * j, row = id >> 4, pc = id & 15;
        v4u qt; qt.x = mul_bf2(R.q[j].x, R.e[j].x); qt.y = mul_bf2(R.q[j].y, R.e[j].y); qt.z = mul_bf2(R.q[j].z, R.e[j].z); qt.w = mul_bf2(R.q[j].w, R.e[j].w);
        *(LAS v4u*)(Bx + HC_Q0 + row * HC_PQ + pc * 16) = qt;
        *(LAS v4u*)(lds + HC_KT + row * HC_PQ + pc * 16) = R.kt[j];
        *(LAS v4u*)(Bx + HC_KH0 + row * HC_PQ + pc * 16) = R.kh[j];
        if (row == 63) { LAS f32x4* dp = (LAS f32x4*)(Bx + HC_D0 + pc * 32);
            dp[0] = (f32x4){bflo(R.e[j].x), bfhi(R.e[j].x), bflo(R.e[j].y), bfhi(R.e[j].y)}; dp[1] = (f32x4){bflo(R.e[j].z), bfhi(R.e[j].z), bflo(R.e[j].w), bfhi(R.e[j].w)}; } }
#pragma unroll
    for (int j = 0; j < 2; ++j) { const int id = ptid + 256 * j, row = id >> 3, pc = id & 7; *(LAS v4u*)(Bx + HC_I0 + row * HC_PI + pc * 16) = R.iv[j]; }
}
__device__ __forceinline__ void hc_pcomp(LAS unsigned char* lds, LAS unsigned char* Bx, int pw, int c, int g) {
    const int ti = pw, t = 16 * ti + c;
#pragma unroll
    for (int si = 0; si < 4; ++si) { f32x4 acc = {0.f, 0.f, 0.f, 0.f};
        if (si <= ti) {
#pragma unroll
            for (int k4 = 0; k4 < 4; ++k4) { const bf16x8v a = *(const LAS bf16x8v*)(lds + HC_KT + (16 * si + c) * HC_PQ + (32 * k4 + 8 * g) * 2);
                const bf16x8v bq = *(const LAS bf16x8v*)(Bx + HC_Q0 + (16 * ti + c) * HC_PQ + (32 * k4 + 8 * g) * 2);
                acc = __builtin_amdgcn_mfma_f32_16x16x32_bf16(a, bq, acc, 0, 0, 0); } }
        const int s0 = 16 * si + 4 * g;
        v2u w; w.x = pg8::cvt_pk_bf16(s0 <= t ? acc[0] : 0.f, s0 + 1 <= t ? acc[1] : 0.f); w.y = pg8::cvt_pk_bf16(s0 + 2 <= t ? acc[2] : 0.f, s0 + 3 <= t ? acc[3] : 0.f);
        *(LAS v2u*)(Bx + HC_P0 + t * HC_PI + s0 * 2) = w; }
}
__device__ __forceinline__ bf16x8v hc_tr8(const LAS unsigned char* p, int rowpitch4) {
    const s16x4 v0 = __builtin_amdgcn_ds_read_tr16_b64_v4i16((LAS s16x4*)p), v1 = __builtin_amdgcn_ds_read_tr16_b64_v4i16((LAS s16x4*)(p + rowpitch4));
    return __builtin_shufflevector(v0, v1, 0, 1, 2, 3, 4, 5, 6, 7);
}
struct HcCons { f32x4 S[8]; f32x4 O[4]; float gs[16]; };
__device__ __forceinline__ void hc_main(HcCons& K, LAS unsigned char* lds, LAS unsigned char* Bx, int w, int c, int g, int q, int p, const bf16* Z, int grow0, int h) {
    const int vs = 16 * w;
    { const bf16* zc = Z + (size_t)grow0 * DIN + ZOG + 64 * h; const unsigned lo = (unsigned)(4 * g) * DIN + vs + c;
#pragma unroll
      for (int mt = 0; mt < 4; ++mt)
#pragma unroll
        for (int r = 0; r < 4; ++r) K.gs[4 * mt + r] = bf2f(zc[lo + (unsigned)(16 * mt + r) * DIN]); }
    bf16x8v bI[2];
#pragma unroll
    for (int ks = 0; ks < 2; ++ks) bI[ks] = hc_tr8(Bx + HC_I0 + (32 * ks + 8 * g + q) * HC_PI + (vs + 4 * p) * 2, 4 * HC_PI);
#pragma unroll
    for (int mt = 0; mt < 4; ++mt) { K.O[mt] = (f32x4){0.f, 0.f, 0.f, 0.f};
#pragma unroll
        for (int ks = 0; ks < 2; ++ks) { const bf16x8v a = *(const LAS bf16x8v*)(Bx + HC_P0 + (16 * mt + c) * HC_PI + (32 * ks + 8 * g) * 2);
            K.O[mt] = __builtin_amdgcn_mfma_f32_16x16x32_bf16(a, bI[ks], K.O[mt], 0, 0, 0); } }
#pragma unroll
    for (int k4 = 0; k4 < 4; ++k4) {
        v4u sb; sb.x = pg8::cvt_pk_bf16(K.S[2 * k4][0], K.S[2 * k4][1]); sb.y = pg8::cvt_pk_bf16(K.S[2 * k4][2], K.S[2 * k4][3]);
        sb.z = pg8::cvt_pk_bf16(K.S[2 * k4 + 1][0], K.S[2 * k4 + 1][1]); sb.w = pg8::cvt_pk_bf16(K.S[2 * k4 + 1][2], K.S[2 * k4 + 1][3]);
        const bf16x8v bS = __builtin_bit_cast(bf16x8v, sb);
#pragma unroll
        for (int mt = 0; mt < 4; ++mt) { const LAS unsigned char* qp = Bx + HC_Q0 + (16 * mt + c) * HC_PQ + (32 * k4 + 4 * g) * 2;
            const v2u a0 = *(const LAS v2u*)qp, a1 = *(const LAS v2u*)(qp + 32);
            const bf16x8v a = __builtin_bit_cast(bf16x8v, (v4u){a0.x, a0.y, a1.x, a1.y});
            K.O[mt] = __builtin_amdgcn_mfma_f32_16x16x32_bf16(a, bS, K.O[mt], 0, 0, 0); } }
#pragma unroll
    for (int kt = 0; kt < 8; ++kt) { const f32x4 d4 = *(const LAS f32x4*)(Bx + HC_D0 + (16 * kt + 4 * g) * 4); K.S[kt] = K.S[kt] * d4;
#pragma unroll
        for (int ks = 0; ks < 2; ++ks) { const bf16x8v a = hc_tr8(Bx + HC_KH0 + (32 * ks + 8 * g + q) * HC_PQ + (16 * kt + 4 * p) * 2, 4 * HC_PQ);
            K.S[kt] = __builtin_amdgcn_mfma_f32_16x16x32_bf16(a, bI[ks], K.S[kt], 0, 0, 0); } }
    float sq[16];
#pragma unroll
    for (int mt = 0; mt < 4; ++mt)
#pragma unroll
        for (int r = 0; r < 4; ++r) { float s = K.O[mt][r] * K.O[mt][r]; s += pg8::row_shr<1>(s); s += pg8::row_shr<2>(s); s += pg8::row_shr<4>(s); s += pg8::row_shr<8>(s); sq[4 * mt + r] = s; }
    if (c == 15) { LAS float* ssq = (LAS float*)(lds + HC_SSQ);
#pragma unroll
        for (int mt = 0; mt < 4; ++mt)
#pragma unroll
            for (int r = 0; r < 4; ++r) ssq[(16 * mt + 4 * g + r) * 4 + w] = sq[4 * mt + r]; }
}
__device__ __forceinline__ void hc_epi(const HcCons& K, LAS unsigned char* lds, int w, int c, int g, int grow0, int h, bf16* OA, float gn) {
    const LAS f32x4* ssq = (const LAS f32x4*)(lds + HC_SSQ); const int vs = 16 * w;
    bf16* oc = OA + (size_t)grow0 * 512 + 64 * h; const unsigned lo = (unsigned)(4 * g) * 512 + vs + c;
#pragma unroll
    for (int mt = 0; mt < 4; ++mt)
#pragma unroll
        for (int r = 0; r < 4; ++r) { const f32x4 p4 = ssq[16 * mt + 4 * g + r]; const float ss = (p4[0] + p4[1]) + (p4[2] + p4[3]);
            const float rn = __builtin_amdgcn_rsqf(ss * (1.f / 64.f) + EPS);
            oc[lo + (unsigned)(16 * mt + r) * 512] = (bf16)f2bf(K.O[mt][r] * rn * gn * K.gs[4 * mt + r]); }
}
__device__ __forceinline__ void hgrn_chunked(LAS unsigned char* lds, const bf16* Z, const bf16* ZX, int b, int h, float* Sout, bf16* OA, const float* ng, int tid) {
    const int lane = tid & 63, wave = __builtin_amdgcn_readfirstlane(tid >> 6);
    const int c = lane & 15, g = lane >> 4, q = (lane & 15) >> 2, p = lane & 3;
    const int rowbase = b * 2048; constexpr int NCH = 32;
    if (wave >= 4) {
        const int ptid = tid - 256, pw = wave - 4;
        HcRegs R;
        hc_load(R, Z, ZX, rowbase, h, ptid);
        hc_write(R, lds, lds, ptid);
        hc_load(R, Z, ZX, rowbase + 64, h, ptid);
        HC_BAR();
        hc_pcomp(lds, lds, pw, c, g);
        HC_BAR();
        for (int ch = 0; ch < NCH; ++ch) {
            LAS unsigned char* Bn = lds + ((ch + 1) & 1) * HC_BUF;
            if (ch + 1 < NCH) { hc_write(R, lds, Bn, ptid); if (ch + 2 < NCH) hc_load(R, Z, ZX, rowbase + 64 * (ch + 2), h, ptid); }
            HC_BAR();
            if (ch + 1 < NCH) hc_pcomp(lds, Bn, pw, c, g);
            HC_BAR();
        }
    } else {
        const int w = wave; const float gn = ng[16 * w + c];
        HcCons K;
#pragma unroll
        for (int kt = 0; kt < 8; ++kt) K.S[kt] = (f32x4){0.f, 0.f, 0.f, 0.f};
        HC_BAR();
        HC_BAR();
        for (int ch = 0; ch < NCH; ++ch) {
            LAS unsigned char* Bc = lds + (ch & 1) * HC_BUF;
            hc_main(K, lds, Bc, w, c, g, q, p, Z, rowbase + 64 * ch, h);
            HC_BAR();
            hc_epi(K, lds, w, c, g, rowbase + 64 * ch, h, OA, gn);
            HC_BAR();
        }
#pragma unroll
        for (int kt = 0; kt < 8; ++kt)
#pragma unroll
            for (int r = 0; r < 4; ++r) Sout[(size_t)(16 * kt + 4 * g + r) * 64 + 16 * w + c] = K.S[kt][r];
    }
    __syncthreads();
}

__device__ __forceinline__ void hgrn_sample_wave(LAS unsigned char* wl, const bf16* Z, int sb, int h, const float* S0, float* Sout, bf16* OA, const float* ng, int lane) {
    LAS float* Lq = (LAS float*)wl; LAS float* Lf = Lq + 512;
    const int row0 = MP + 4 * sb;
    float S[128];
#pragma unroll
    for (int k = 0; k < 128; ++k) S[k] = S0[(size_t)k * 64 + lane];
    float iv[4], gs[4];
#pragma unroll
    for (int t = 0; t < 4; ++t) { const bf16* zr = Z + (size_t)(row0 + t) * DIN;
        Lq[t * 128 + lane] = bf2f(zr[ZQ + 128 * h + lane]); Lq[t * 128 + 64 + lane] = bf2f(zr[ZQ + 128 * h + 64 + lane]);
        Lf[t * 128 + lane] = __expf(bf2f(zr[ZF + 128 * h + lane])); Lf[t * 128 + 64 + lane] = __expf(bf2f(zr[ZF + 128 * h + 64 + lane]));
        iv[t] = bf2f(zr[ZI + 64 * h + lane]); gs[t] = bf2f(zr[ZOG + 64 * h + lane]); }
    LDS_WAIT(); asm volatile("" ::: "memory");
    float o[4] = {0.f, 0.f, 0.f, 0.f};
#pragma unroll
    for (int k4 = 0; k4 < 32; ++k4) {
#pragma unroll
        for (int t = 0; t < 4; ++t) { const f32x4 f4 = *(const LAS f32x4*)(Lf + t * 128 + 4 * k4), q4 = *(const LAS f32x4*)(Lq + t * 128 + 4 * k4);
#pragma unroll
            for (int e = 0; e < 4; ++e) { const float f = f4[e]; S[4 * k4 + e] = f * S[4 * k4 + e] + (1.0f - f) * iv[t]; o[t] += q4[e] * S[4 * k4 + e]; } } }
    const float gn = ng[lane];
#pragma unroll
    for (int t = 0; t < 4; ++t) { const float r = 1.0f / sqrtf(wave_sum(o[t] * o[t]) * (1.f / 64.f) + EPS);
        OA[(size_t)(row0 + t) * 512 + 64 * h + lane] = (bf16)f2bf(o[t] * r * gn * gs[t]); }
#pragma unroll
    for (int k = 0; k < 128; ++k) Sout[(size_t)k * 64 + lane] = S[k];
    LDS_WAIT(); asm volatile("" ::: "memory");
}
constexpr int GM_P = 272, GM_VN = 0, GM_W = 34816;
__device__ __forceinline__ void gmlp_prompt_bng(LAS unsigned char* lds, const bf16* Z, int r0, int g, const float* lng, const float* lnb, const bf16* WSB, const float* bs, bf16* OB, int tid) {
    const int lane = tid & 63, w = __builtin_amdgcn_readfirstlane(tid >> 6);
    const int c = lane & 15, g4 = lane >> 4, q = (lane & 15) >> 2, p = lane & 3;
    const int prow = tid >> 4, pc = tid & 15;
    float mean[4], rstd[4];
    {
        v4u vr[16];
#pragma unroll
        for (int j = 0; j < 16; ++j) vr[j] = *(const GAS v4u*)(Z + (size_t)(r0 + prow + 32 * (j >> 2)) * DIN + ZV + 128 * (j & 3) + 8 * pc);
#pragma unroll
        for (int jr = 0; jr < 4; ++jr) { float s = 0.f, qq = 0.f;
#pragma unroll
            for (int gq = 0; gq < 4; ++gq) { const v4u x = vr[4 * jr + gq];
                const float a0 = bflo(x.x), a1 = bfhi(x.x), a2 = bflo(x.y), a3 = bfhi(x.y), a4 = bflo(x.z), a5 = bfhi(x.z), a6 = bflo(x.w), a7 = bfhi(x.w);
                s += ((a0 + a1) + (a2 + a3)) + ((a4 + a5) + (a6 + a7)); qq += ((a0 * a0 + a1 * a1) + (a2 * a2 + a3 * a3)) + ((a4 * a4 + a5 * a5) + (a6 * a6 + a7 * a7)); }
            s += __shfl_xor(s, 1); qq += __shfl_xor(qq, 1); s += __shfl_xor(s, 2); qq += __shfl_xor(qq, 2); s += __shfl_xor(s, 4); qq += __shfl_xor(qq, 4); s += __shfl_xor(s, 8); qq += __shfl_xor(qq, 8);
            mean[jr] = s * (1.f / 512.f); const float var = qq * (1.f / 512.f) - mean[jr] * mean[jr]; rstd[jr] = 1.0f / sqrtf(fmaxf(var, 0.f) + EPS); }
    }
    asm volatile("" ::: "memory");
    {
        const f32x4 ga = *(const GAS f32x4*)(lng + 128 * g + 8 * pc), gb = *(const GAS f32x4*)(lng + 128 * g + 8 * pc + 4);
        const f32x4 ba = *(const GAS f32x4*)(lnb + 128 * g + 8 * pc), bb = *(const GAS f32x4*)(lnb + 128 * g + 8 * pc + 4);
        v4u xg[4];
#pragma unroll
        for (int jr = 0; jr < 4; ++jr) xg[jr] = *(const GAS v4u*)(Z + (size_t)(r0 + prow + 32 * jr) * DIN + ZV + 128 * g + 8 * pc);
#pragma unroll
        for (int jr = 0; jr < 4; ++jr) { const v4u x = xg[jr]; const float m_ = mean[jr], r_ = rstd[jr];
            v4u o; o.x = pg8::cvt_pk_bf16((bflo(x.x) - m_) * r_ * ga[0] + ba[0], (bfhi(x.x) - m_) * r_ * ga[1] + ba[1]); o.y = pg8::cvt_pk_bf16((bflo(x.y) - m_) * r_ * ga[2] + ba[2], (bfhi(x.y) - m_) * r_ * ga[3] + ba[3]);
            o.z = pg8::cvt_pk_bf16((bflo(x.z) - m_) * r_ * gb[0] + bb[0], (bfhi(x.z) - m_) * r_ * gb[1] + bb[1]); o.w = pg8::cvt_pk_bf16((bflo(x.w) - m_) * r_ * gb[2] + bb[2], (bfhi(x.w) - m_) * r_ * gb[3] + bb[3]);
            *(LAS v4u*)(lds + GM_VN + (prow + 32 * jr) * GM_P + pc * 16) = o; }
#pragma unroll
        for (int j2 = 0; j2 < 4; ++j2) { const int id = tid + 512 * j2, t = id >> 4, wp = id & 15;
            *(LAS v4u*)(lds + GM_W + t * GM_P + wp * 16) = *(const GAS v4u*)(WSB + (size_t)g * 16384 + t * 128 + 8 * wp); }
    }
    const size_t orow = (size_t)(r0 + 16 * w + c);
    v2u gu[8];
#pragma unroll
    for (int ct = 0; ct < 8; ++ct) gu[ct] = *(const GAS v2u*)(Z + orow * DIN + ZU + 128 * g + 16 * ct + 4 * g4);
    const float bsv = bs[g * 128 + 16 * w + c];
    __syncthreads();
    const int nks = (16 * w + 15) / 32 + 1;
    f32x4 acc[8];
#pragma unroll
    for (int ct = 0; ct < 8; ++ct) acc[ct] = (f32x4){0.f, 0.f, 0.f, 0.f};
    for (int ks = 0; ks < nks; ++ks) {
        const bf16x8v bW = *(const LAS bf16x8v*)(lds + GM_W + (16 * w + c) * GM_P + (32 * ks + 8 * g4) * 2);
#pragma unroll
        for (int ct = 0; ct < 8; ++ct) { const bf16x8v aV = hc_tr8(lds + GM_VN + (32 * ks + 8 * g4 + q) * GM_P + (16 * ct + 4 * p) * 2, 4 * GM_P);
            acc[ct] = __builtin_amdgcn_mfma_f32_16x16x32_bf16(aV, bW, acc[ct], 0, 0, 0); } }
#pragma unroll
    for (int ct = 0; ct < 8; ++ct) { v2u o; o.x = pg8::cvt_pk_bf16(bflo(gu[ct].x) * (acc[ct][0] + bsv), bfhi(gu[ct].x) * (acc[ct][1] + bsv)); o.y = pg8::cvt_pk_bf16(bflo(gu[ct].y) * (acc[ct][2] + bsv), bfhi(gu[ct].y) * (acc[ct][3] + bsv));
        *(GAS v2u*)(OB + orow * 512 + 128 * g + 16 * ct + 4 * g4) = o; }
    __syncthreads();
}
struct Args { const float* in[22]; float* out; unsigned char* ws; };
__global__ void __launch_bounds__(NWAVES * 64, 2) mk_fwd(Args args) {
    extern __shared__ __attribute__((aligned(16))) unsigned char lds[];
    LAS unsigned char* L = (LAS unsigned char*)lds;
    volatile LAS unsigned* MISC = (volatile LAS unsigned*)(L + MISC_OFF);
    const int tid = threadIdx.x, lane = tid & 63, wave = __builtin_amdgcn_readfirstlane(tid >> 6);
    const int G = gridDim.x, bx = blockIdx.x;
    const int vcu = (G % 8 == 0) ? (bx % 8) * (G / 8) + bx / 8 : bx;
    unsigned char* ws = args.ws;
    for (int u = tid; u < (LDS_BYTES - LDSCTL_OFF) / 4; u += NT) ((LAS unsigned*)(L + LDSCTL_OFF))[u] = 0u;
    __syncthreads();
    XcdBarrier bar = xcd_barrier_post((unsigned*)(ws + WS_CTL) + CW_BAR, MISC + 8);

    const float* x_prompt = args.in[0]; const float* x_sample = args.in[1]; const float* state_hgrn = args.in[2]; const float* cache_conv = args.in[3];
    const float* lb_param = args.in[4]; const float* mix_pre_g = args.in[5]; const float* w_in = args.in[6]; const float* hgrn_norm_g = args.in[7];
    const float* gmlp_ln_g = args.in[8]; const float* gmlp_ln_b = args.in[9]; const float* w_s = args.in[10]; const float* b_s = args.in[11];
    const float* w_pa = args.in[12]; const float* w_pb = args.in[13]; const float* w_o = args.in[14]; const float* mix_post_g = args.in[15];
    const float* ffn_pre_g = args.in[16]; const float* w_up = args.in[17]; const float* conv_w = args.in[18]; const float* conv_b = args.in[19];
    const float* w_down = args.in[20]; const float* ffn_post_g = args.in[21];
    float* out = args.out;
    bf16* WinT = (bf16*)(ws + WS_WIN); bf16* WpaT = (bf16*)(ws + WS_WPA); bf16* WpbT = (bf16*)(ws + WS_WPB); bf16* WoT = (bf16*)(ws + WS_WO);
    bf16* WupT = (bf16*)(ws + WS_WUP); bf16* WdnT = (bf16*)(ws + WS_WDN); float* LB = (float*)(ws + WS_LB); bf16* WSB = (bf16*)(ws + WS_WSB);
    bf16* XN = (bf16*)(ws + WS_XN); bf16* Z = (bf16*)(ws + WS_Z); bf16* OA = (bf16*)(ws + WS_OA); bf16* OB = (bf16*)(ws + WS_OB);
    float* HF = (float*)(ws + WS_HF); bf16* H = (bf16*)(ws + WS_H); float* Y = (float*)(ws + WS_Y); bf16* UP = (bf16*)(ws + WS_UP); bf16* GG = (bf16*)(ws + WS_G);
    bf16* ZX = (bf16*)out;
    float* X1 = out;

    {
        LAS float* scr = (LAS float*)(L + RING_OFF + wave * 16384);
        const int gw = vcu * NWAVES + wave, NGW = G * NWAVES;
        constexpr int I_IN = (D / 64) * (DIN / 32), I_PA = (512 / 64) * (D / 32), I_O = (D / 64) * (D / 32), I_UP = (D / 64) * (FF2 / 32), I_DN = (FF / 64) * (D / 32);
        constexpr int NITEMS = I_IN + 2 * I_PA + I_O + I_UP + I_DN;
        for (int it = gw; it < NITEMS; it += NGW) {
            int r = it;
            if (r < I_IN) { p0_transpose_item(w_in, DIN, WinT, D, 0, scr, r, lane); continue; } r -= I_IN;
            if (r < I_PA) { p0_transpose_item(w_pa, D, WpaT, 512, 0, scr, r, lane); continue; } r -= I_PA;
            if (r < I_PA) { p0_transpose_item(w_pb, D, WpbT, 512, 0, scr, r, lane); continue; } r -= I_PA;
            if (r < I_O) { p0_transpose_item(w_o, D, WoT, D, 0, scr, r, lane); continue; } r -= I_O;
            if (r < I_UP) { p0_transpose_item(w_up, FF2, WupT, D, 0, scr, r, lane); continue; } r -= I_UP;
            p0_transpose_item(w_down, D, WdnT, FF, 0, scr, r, lane);
        }
        for (int m = gw; m < M; m += NGW) { const float* xr = (m < MP) ? x_prompt + (size_t)m * D : x_sample + (size_t)(m - MP) * D; rms_row_to_bf16(xr, mix_pre_g, XN + (size_t)m * D, lane); }
        if (bx >= 8 && bx < 24) for (int i = (bx - 8) * 4096 + tid; i < (bx - 7) * 4096; i += NT) { const int t = (i >> 7) & 127, s_ = i & 127; WSB[i] = (bf16)f2bf(s_ <= t ? w_s[i] : 0.f); }
        if (bx == 0) for (int k = tid; k < 1024; k += NT) LB[k] = 1.0f / (1.0f + __expf(lb_param[1024 + k] - lb_param[k]));
    }
    xcd_barrier(bar);

    { pg8::Gemm g{XN, WinT, M, DIN, D, D}; pg8::StaticOrder S; S.init(M, DIN, G, bx); pg8::EpiZ E{Z, LB, ZX};
      pg8::gemm_phase<pg8::EpiZ, pg8::StaticOrder, true, true>(L + RING_OFF, g, S, E); }
    xcd_barrier(bar);

    if (bx < 64) {
        const int b = bx >> 3, h = bx & 7;
        hgrn_chunked(L, Z, ZX, b, h, out + O_SP + (size_t)bx * 8192, OA, hgrn_norm_g, tid);
    } else {
        { const int wi = (bx - 64) * NWAVES + wave; if (wi < 1024) { const int sb = wi >> 3, h = wi & 7;
            hgrn_sample_wave(L + wave * 4096, Z, sb, h, state_hgrn + (size_t)wi * 8192, out + O_SS + (size_t)wi * 8192, OA, hgrn_norm_g, lane); } }
        __syncthreads();
        for (int it = bx - 64; it < 512 + 128; it += G - 64) {
            if (it < 512) { const int b = it >> 6, n = (it >> 2) & 15, g = it & 3; gmlp_prompt_bng(L, Z, b * 2048 + n * 128, g, gmlp_ln_g, gmlp_ln_b, WSB, b_s, OB, tid); }
            else gmlp_sample_item(L, Z, it - 512, gmlp_ln_g, gmlp_ln_b, w_s, b_s, OB, out + O_VS, tid);
        }
    }
    xcd_barrier(bar);

    { pg8::Gemm g{OA, WpaT, M, D, 512, 512}; pg8::StaticOrder S; S.init(M, D, G, bx); pg8::EpiGateF32 E{HF, Z, ZGA};
      pg8::gemm_phase<pg8::EpiGateF32, pg8::StaticOrder, true, true>(L + RING_OFF, g, S, E); }
    xcd_barrier(bar);
    { pg8::Gemm g{OB, WpbT, M, D, 512, 512}; pg8::StaticOrder S; S.init(M, D, G, bx); pg8::EpiComb E{H, HF, Z, ZGB};
      pg8::gemm_phase<pg8::EpiComb, pg8::StaticOrder, true, true>(L + RING_OFF, g, S, E); }
    xcd_barrier(bar);
    { pg8::Gemm g{H, WoT, M, D, D, D}; pg8::StaticOrder S; S.init(M, D, G, bx); pg8::EpiF32 E{Y, D};
      pg8::gemm_phase<pg8::EpiF32, pg8::StaticOrder, true, true>(L + RING_OFF, g, S, E); }
    xcd_barrier(bar);
    {
        const int gw = bx * NWAVES + wave, NGW = G * NWAVES;
        for (int m = gw; m < M; m += NGW) {
            const float* xr = (m < MP) ? x_prompt + (size_t)m * D : x_sample + (size_t)(m - MP) * D;
            const GAS f32x4* yr = (const GAS f32x4*)(Y + (size_t)m * D) + lane; const GAS f32x4* xv = (const GAS f32x4*)xr + lane;
            f32x4 y[4]; float s = 0.f;
#pragma unroll
            for (int j = 0; j < 4; ++j) { y[j] = yr[64 * j]; s += (y[j].x * y[j].x + y[j].y * y[j].y) + (y[j].z * y[j].z + y[j].w * y[j].w); }
            const float r = 1.0f / sqrtf(wave_sum(s) * (1.f / D) + EPS); float s2 = 0.f;
            GAS f32x4* x1r = (GAS f32x4*)(X1 + (size_t)m * D) + lane;
#pragma unroll
            for (int j = 0; j < 4; ++j) { const f32x4 gg = ((const GAS f32x4*)mix_post_g)[lane + 64 * j]; const f32x4 xx = xv[64 * j];
                y[j].x = xx.x + y[j].x * r * gg.x; y[j].y = xx.y + y[j].y * r * gg.y; y[j].z = xx.z + y[j].z * r * gg.z; y[j].w = xx.w + y[j].w * r * gg.w;
                x1r[64 * j] = y[j]; s2 += (y[j].x * y[j].x + y[j].y * y[j].y) + (y[j].z * y[j].z + y[j].w * y[j].w); }
            const float r2 = 1.0f / sqrtf(wave_sum(s2) * (1.f / D) + EPS);
            GAS v2u* o8 = (GAS v2u*)(XN + (size_t)m * D) + lane;
#pragma unroll
            for (int j = 0; j < 4; ++j) { const f32x4 gg = ((const GAS f32x4*)ffn_pre_g)[lane + 64 * j]; v2u o; o.x = pk2(y[j].x * r2 * gg.x, y[j].y * r2 * gg.y); o.y = pk2(y[j].z * r2 * gg.z, y[j].w * r2 * gg.w); o8[64 * j] = o; }
        }
    }
    xcd_barrier(bar);
    { pg8::Gemm g{XN, WupT, M, FF2, D, D}; pg8::StaticOrder S; S.init(M, FF2, G, bx); pg8::EpiBf16<0> E{UP, FF2, nullptr, 0, 0, 1.f};
      pg8::gemm_phase<pg8::EpiBf16<0>, pg8::StaticOrder, true, true>(L + RING_OFF, g, S, E); }
    xcd_barrier(bar);
    for (int it = bx; it < (M / 16) * (FF / 8) / NT; it += G) { const int idx = it * NT + tid; conv_gate_item(UP, cache_conv, conv_w, conv_b, GG, out + O_CP, out + O_CS, idx / (FF / 8), idx % (FF / 8)); }
    xcd_barrier(bar);
    { pg8::Gemm g{GG, WdnT, M, D, FF, FF}; pg8::StaticOrder S; S.init(M, D, G, bx); pg8::EpiF32 E{Y, D};
      pg8::gemm_phase<pg8::EpiF32, pg8::StaticOrder, true, true>(L + RING_OFF, g, S, E); }
    xcd_barrier(bar);
    {
        const int gw = bx * NWAVES + wave, NGW = G * NWAVES;
        const bool bad = xb_ld((unsigned*)(ws + WS_CTL) + CW_BAR + XB_TMO) != 0u;
        for (int m = gw; m < M; m += NGW) {
            const GAS f32x4* yr = (const GAS f32x4*)(Y + (size_t)m * D) + lane; GAS f32x4* x1r = (GAS f32x4*)(X1 + (size_t)m * D) + lane;
            f32x4 y[4]; float s = 0.f;
#pragma unroll
            for (int j = 0; j < 4; ++j) { y[j] = yr[64 * j]; s += (y[j].x * y[j].x + y[j].y * y[j].y) + (y[j].z * y[j].z + y[j].w * y[j].w); }
            float r = 1.0f / sqrtf(wave_sum(s) * (1.f / D) + EPS); if (bad) r = __builtin_nanf("");
#pragma unroll
            for (int j = 0; j < 4; ++j) { const f32x4 gg = ((const GAS f32x4*)ffn_post_g)[lane + 64 * j]; f32x4 xx = x1r[64 * j];
                xx.x += y[j].x * r * gg.x; xx.y += y[j].y * r * gg.y; xx.z += y[j].z * r * gg.z; xx.w += y[j].w * r * gg.w; x1r[64 * j] = xx; }
        }
    }
}

extern "C" void kernel_launch(void* const* d_in, const int* in_sizes, int n_in, void* d_out, int out_size, void* d_ws, size_t ws_size, hipStream_t stream) {
    static int grid = 0;
    if (grid == 0) {
        if (n_in != 22 || (size_t)out_size != O_END || ws_size < WS_END) { fprintf(stderr, "kernel_launch: unexpected shapes (n_in %d out %d ws %zu)\n", n_in, out_size, ws_size); grid = -1; return; }
        int dev = 0, cus = 0, per_cu = 0;
        if (hipGetDevice(&dev) != hipSuccess || hipDeviceGetAttribute(&cus, hipDeviceAttributeMultiprocessorCount, dev) != hipSuccess) { grid = -1; return; }
        if (hipFuncSetAttribute((const void*)mk_fwd, hipFuncAttributeMaxDynamicSharedMemorySize, LDS_BYTES) != hipSuccess) { fprintf(stderr, "kernel_launch: hipFuncSetAttribute failed\n"); grid = -1; return; }
        if (hipOccupancyMaxActiveBlocksPerMultiprocessor(&per_cu, (const void*)mk_fwd, NWAVES * 64, LDS_BYTES) != hipSuccess || per_cu < 1) { fprintf(stderr, "kernel_launch: occupancy query says %d blocks per CU\n", per_cu); (void)hipGetLastError(); grid = -1; return; }
        grid = cus;
        if (grid != 256) { fprintf(stderr, "kernel_launch: built for 256 CUs, found %d\n", cus); grid = -1; return; }
    }
    if (grid < 0) return;
    (void)hipMemsetAsync((char*)d_ws + WS_CTL, 0, CTL_ZERO_BYTES, stream);
    Args a{};
    for (int i = 0; i < 22; ++i) a.in[i] = (const float*)d_in[i];
    a.out = (float*)d_out; a.ws = (unsigned char*)d_ws;
    hipLaunchKernelGGL(mk_fwd, dim3(grid), dim3(NWAVES * 64), LDS_BYTES, stream, a);
}
```

```cpp
#include <hip/hip_runtime.h>
#include <cstdio>
#include <cstdint>
namespace pg8 {
#define PG8_LAS __attribute__((address_space(3)))
typedef unsigned short bf16_t;
typedef short bf16x8 __attribute__((ext_vector_type(8)));
typedef float f32x4 __attribute__((ext_vector_type(4)));
typedef unsigned u32x4 __attribute__((ext_vector_type(4)));
constexpr int BM = 256, BK = 64, HALF = 128, HTB = HALF * BK * 2  , STAGE_BYTES = 8 * HTB, NXCD = 8, WGM = 8;

__host__ __device__ __forceinline__ int lds_byte(int r, int c) { const int st = (r >> 4) * 2 + (c >> 5), rr = r & 15, cc = c & 31, ob = rr * 64 + cc * 2; return st * 1024 + (ob ^ (((ob >> 9) & 1) << 5)); }
__host__ __device__ __forceinline__ void stage_rc(int b, int& R, int& C) { const int st = b / 1024, sb = b % 1024, swz = sb ^ (((sb >> 9) & 1) << 5); R = (st >> 1) * 16 + swz / 64; C = (st & 1) * 32 + (swz % 64) / 2; }
__host__ __device__ __forceinline__ int perm32(int rho) { const int n = rho >> 4, i = rho & 15; return 8 * (i >> 2) + 4 * n + (i & 3); }

struct Unit { int pm, pn, ks; };
struct Gemm { const bf16_t* A; const bf16_t* Bt; int M, N, K, lda, ldb, ksl; };

struct StaticOrder {
    int nM, nN, nwg, G, c;
    __host__ __device__ void init(int M, int N, int G_, int c_) { nM = M / BM; nN = N / BM; nwg = nM * nN; G = G_; c = c_; }
    __host__ __device__ bool next(int i, Unit& u) const {
        const long L = (long)i * G + c; if (L >= nwg) return false;
        int wgid = (int)L; { const int q = nwg / NXCD, r = nwg % NXCD, xcd = wgid % NXCD, off = wgid / NXCD; wgid = (xcd < r ? xcd * (q + 1) : r * (q + 1) + (xcd - r) * q) + off; }
        const int nig = WGM * nN, gid = wgid / nig, fm = gid * WGM, gsz = (nM - fm) < WGM ? (nM - fm) : WGM;
        u.pm = fm + ((wgid % nig) % gsz); u.pn = (wgid % nig) / gsz; u.ks = 0; return true;
    }
    __device__ __forceinline__ void a_ready(const Unit&) const {}
    __device__ __forceinline__ void done(const Unit&) const {}
};

typedef __bf16 bf16x2_t __attribute__((ext_vector_type(2)));
typedef float f32x2_t __attribute__((ext_vector_type(2)));
__device__ __forceinline__ unsigned cvt_pk_bf16(float lo, float hi) { const f32x2_t v = {lo, hi}; const bf16x2_t b = __builtin_convertvector(v, bf16x2_t); return __builtin_bit_cast(unsigned, b); }
typedef float f32x2 __attribute__((ext_vector_type(2)));
__device__ __forceinline__ f32x2 gelu_pk(f32x2 v) {
    const f32x2 av = __builtin_elementwise_abs(v), d = av * 0.2316418882f + 1.0f;
    f32x2 t; t.x = __builtin_amdgcn_rcpf(d.x); t.y = __builtin_amdgcn_rcpf(d.y);
    f32x2 q = t * 0.5307027145f + (-0.7265760135f); q = q * t + 0.7107068705f; q = q * t + (-0.142248368f); q = q * t + 0.127414796f; q = q * t;
    const f32x2 s = (v * v) * (-0.72134752044f);
    f32x2 e; e.x = __builtin_amdgcn_exp2f(s.x); e.y = __builtin_amdgcn_exp2f(s.y);
    const f32x2 m = v * (q * e), r = v - m;
    f32x2 o; o.x = v.x < 0.f ? m.x : r.x; o.y = v.y < 0.f ? m.y : r.y; return o;
}

template <int ACT  > struct EpiBf16 {
    static constexpr bool PERM = true, AFTER_DRAIN = false; static_assert(ACT == 0 || ACT == 1, "EpiBf16: ACT is 0 (none) or 1 (gelu_pk)");
    bf16_t* O; int ldc; const float* bias; int split_cols; size_t split_stride; float scale0;
    __device__ __forceinline__ void operator()(const f32x4 (&acc)[2][2][4][2], const Unit& u, int wr, int wc, int fr, int fq) const {
        const int row0 = u.pm * BM + wr * 64 + fr; int colt = u.pn * BM; bf16_t* base = O;
        float sc = 1.f; if (split_cols) { const int t = colt / split_cols; base += (size_t)t * split_stride; colt -= t * split_cols; if (t == 0) sc = scale0; }
        const int col0 = colt + wc * 32 + 8 * fq, bcol0 = u.pn * BM + wc * 32 + 8 * fq;
        f32x4 bv[2][2];
#pragma unroll
        for (int bj = 0; bj < 2; ++bj)
#pragma unroll
            for (int n = 0; n < 2; ++n) bv[bj][n] = bias ? *(const f32x4*)(bias + bcol0 + bj * HALF + 4 * n) : (f32x4){0.f, 0.f, 0.f, 0.f};
#pragma unroll
        for (int ai = 0; ai < 2; ++ai)
#pragma unroll
            for (int m = 0; m < 4; ++m) { bf16_t* rowp = base + (size_t)(row0 + ai * HALF + m * 16) * ldc + col0;
#pragma unroll
                for (int bj = 0; bj < 2; ++bj) { f32x4 v0 = acc[ai][bj][m][0] + bv[bj][0], v1 = acc[ai][bj][m][1] + bv[bj][1];
                    if (ACT == 1) { f32x2 a = gelu_pk((f32x2){v0[0], v0[1]}), b = gelu_pk((f32x2){v0[2], v0[3]}), c = gelu_pk((f32x2){v1[0], v1[1]}), d = gelu_pk((f32x2){v1[2], v1[3]});
                        v0 = (f32x4){a.x, a.y, b.x, b.y}; v1 = (f32x4){c.x, c.y, d.x, d.y}; }
                    v0 = v0 * sc; v1 = v1 * sc; u32x4 w; w.x = cvt_pk_bf16(v0[0], v0[1]); w.y = cvt_pk_bf16(v0[2], v0[3]); w.z = cvt_pk_bf16(v1[0], v1[1]); w.w = cvt_pk_bf16(v1[2], v1[3]);
                    *(u32x4*)(rowp + bj * HALF) = w; } }
    }
};

template <class Epi, class Sched, bool ALIGN_EPI = false, bool SP2 = false>
__device__ __forceinline__ void gemm_phase(PG8_LAS unsigned char* lds, const Gemm g, const Sched& S, const Epi& E) {
    const int tid = threadIdx.x, wid = __builtin_amdgcn_readfirstlane(tid >> 6), lane = tid & 63, wr = wid >> 2, wc = wid & 3, fr = lane & 15, fq = lane >> 4;
    const int K = g.K, nt = K / BK;
    unsigned voffA[2], voffB[2];
#pragma unroll
    for (int i = 0; i < 2; ++i) { int R, C; stage_rc(tid * 16 + i * 8192, R, C); const int Rb = Epi::PERM ? ((R & ~31) + perm32(R & 31)) : R;
        voffA[i] = (unsigned)(R * g.lda + C) * 2u; voffB[i] = (unsigned)(Rb * g.ldb + C) * 2u; }
    const size_t kstep = (size_t)(BK * 2);
    const size_t hstepA = (size_t)HALF * g.lda * 2, hstepB = (size_t)HALF * g.ldb * 2;
    const size_t tstepA = 2 * hstepA, tstepB = 2 * hstepB;
    const unsigned ldsw = (unsigned)wid * 1024u;
    const int aoff = lds_byte(wr * 64 + fr, fq * 8), boff = lds_byte(wc * 32 + fr, fq * 8);
#define PG8_SA(b, h) (((b) * 2 + (h)) * HTB)
#define PG8_SB(b, h) ((4 + (b) * 2 + (h)) * HTB)
#define PG8_STAGE(bufoff, gbase, voff) do { _Pragma("unroll") for (int _i = 0; _i < 2; ++_i) \
        __builtin_amdgcn_global_load_lds((const unsigned*)((const char*)(gbase) + (voff)[_i]), (PG8_LAS unsigned*)(lds + (bufoff) + ldsw + _i * 8192), 16, 0, 0); } while (0)
#define PG8_LDA(dst, b, h) do { _Pragma("unroll") for (int m = 0; m < 4; ++m) _Pragma("unroll") for (int k = 0; k < 2; ++k) dst[m][k] = *(const PG8_LAS bf16x8*)(lds + PG8_SA(b, h) + aoff + m * 2048 + k * 1024); } while (0)
#define PG8_LDB(dst, b, h) do { _Pragma("unroll") for (int n = 0; n < 2; ++n) _Pragma("unroll") for (int k = 0; k < 2; ++k) dst[n][k] = *(const PG8_LAS bf16x8*)(lds + PG8_SB(b, h) + boff + n * 2048 + k * 1024); } while (0)
#define PG8_MMA(ai, bj, At, Bt) do { __builtin_amdgcn_s_setprio(1); _Pragma("unroll") for (int m = 0; m < 4; ++m) _Pragma("unroll") for (int n = 0; n < 2; ++n) _Pragma("unroll") for (int k = 0; k < 2; ++k) \
        acc[ai][bj][m][n] = __builtin_amdgcn_mfma_f32_16x16x32_bf16(Bt[n][k], At[m][k], acc[ai][bj][m][n], 0, 0, 0); __builtin_amdgcn_s_setprio(0); } while (0)
#define PG8_WAIT_V(n) asm volatile("s_waitcnt vmcnt(" #n ")" ::: "memory")
#define PG8_WAIT_L(n) asm volatile("s_waitcnt lgkmcnt(" #n ")" ::: "memory")
#define PG8_BAR __builtin_amdgcn_s_barrier()
#define PG8_SCHED __builtin_amdgcn_sched_barrier(0)
    Unit cur, nxt; int ui = 0;
    if (!S.next(0, cur)) return;
    f32x4 acc[2][2][4][2];
#pragma unroll
    for (int a = 0; a < 2; ++a)
#pragma unroll
        for (int b = 0; b < 2; ++b)
#pragma unroll
            for (int m = 0; m < 4; ++m)
#pragma unroll
                for (int n = 0; n < 2; ++n) acc[a][b][m][n] = (f32x4){0.f, 0.f, 0.f, 0.f};
    bf16x8 At[4][2], B0[2][2], B1[2][2];
    const char* cA = (const char*)g.A + (size_t)cur.pm * tstepA + (size_t)cur.ks * g.ksl; const char* cB = (const char*)g.Bt + (size_t)cur.pn * tstepB + (size_t)cur.ks * g.ksl;
    S.a_ready(cur);
    if constexpr (SP2) {
        PG8_STAGE(PG8_SB(0, 0), cB, voffB); PG8_STAGE(PG8_SB(0, 1), cB + hstepB, voffB); PG8_STAGE(PG8_SA(0, 0), cA, voffA); PG8_STAGE(PG8_SA(0, 1), cA + hstepA, voffA);
        if (wr == 1) PG8_BAR;
        PG8_WAIT_V(2); PG8_BAR;
        PG8_STAGE(PG8_SB(1, 0), cB + kstep, voffB); PG8_STAGE(PG8_SA(1, 0), cA + kstep, voffA); PG8_STAGE(PG8_SB(1, 1), cB + hstepB + kstep, voffB);
        PG8_WAIT_V(6); PG8_BAR;
    } else {
        PG8_STAGE(PG8_SB(0, 0), cB, voffB); PG8_STAGE(PG8_SA(0, 0), cA, voffA); PG8_STAGE(PG8_SB(0, 1), cB + hstepB, voffB); PG8_STAGE(PG8_SA(0, 1), cA + hstepA, voffA);
        if (wr == 1) PG8_BAR;
        PG8_WAIT_V(4); PG8_BAR;
        PG8_STAGE(PG8_SB(1, 0), cB + kstep, voffB); PG8_STAGE(PG8_SA(1, 0), cA + kstep, voffA); PG8_STAGE(PG8_SB(1, 1), cB + hstepB + kstep, voffB);
        PG8_WAIT_V(6); PG8_BAR;
    }
    for (;;) {
        const bool has_next = S.next(ui + 1, nxt);
        const char* nA = has_next ? (const char*)g.A + (size_t)nxt.pm * tstepA + (size_t)nxt.ks * g.ksl : cA; const char* nB = has_next ? (const char*)g.Bt + (size_t)nxt.pn * tstepB + (size_t)nxt.ks * g.ksl : cB;
        for (int t = 0; t < nt; t += 2) {
            const bool last = (t == nt - 2);
            const char* a1 = cA + (size_t)(t + 1) * kstep;
            const char* a2 = last ? nA : cA + (size_t)(t + 2) * kstep; const char* b2 = last ? nB : cB + (size_t)(t + 2) * kstep;
            const char* a3 = a2 + kstep; const char* b3 = b2 + kstep;
            if (last && has_next) S.a_ready(nxt);
            if constexpr (SP2) {
            PG8_LDB(B0, 0, 0); PG8_LDB(B1, 0, 1); PG8_SCHED; PG8_LDA(At, 0, 0); PG8_STAGE(PG8_SA(1, 1), a1 + hstepA, voffA);
            PG8_WAIT_V(8); PG8_WAIT_L(0); PG8_BAR; PG8_MMA(0, 0, At, B0); PG8_MMA(0, 1, At, B1); PG8_BAR; PG8_SCHED;
            PG8_LDA(At, 0, 1); PG8_STAGE(PG8_SB(0, 0), b2, voffB); PG8_STAGE(PG8_SB(0, 1), b2 + hstepB, voffB); PG8_STAGE(PG8_SA(0, 0), a2, voffA);
            PG8_WAIT_V(8); PG8_WAIT_L(0); PG8_BAR; PG8_MMA(1, 0, At, B0); PG8_MMA(1, 1, At, B1); PG8_BAR; PG8_SCHED;
            PG8_LDB(B0, 1, 0); PG8_LDB(B1, 1, 1); PG8_SCHED; PG8_LDA(At, 1, 0); PG8_STAGE(PG8_SA(0, 1), a2 + hstepA, voffA);
            PG8_WAIT_V(8); PG8_WAIT_L(0); PG8_BAR; PG8_MMA(0, 0, At, B0); PG8_MMA(0, 1, At, B1); PG8_BAR; PG8_SCHED;
            PG8_LDA(At, 1, 1); PG8_STAGE(PG8_SB(1, 0), b3, voffB); PG8_STAGE(PG8_SB(1, 1), b3 + hstepB, voffB); PG8_STAGE(PG8_SA(1, 0), a3, voffA);
            PG8_WAIT_V(8); PG8_WAIT_L(0); PG8_BAR; PG8_MMA(1, 0, At, B0); PG8_MMA(1, 1, At, B1); PG8_BAR; PG8_SCHED;
            } else {
            PG8_LDB(B0, 0, 0); PG8_SCHED; PG8_LDA(At, 0, 0); PG8_STAGE(PG8_SA(1, 1), a1 + hstepA, voffA);
            PG8_WAIT_L(8); PG8_BAR; PG8_WAIT_L(0); PG8_MMA(0, 0, At, B0); PG8_BAR; PG8_SCHED;
            PG8_LDB(B1, 0, 1); PG8_STAGE(PG8_SB(0, 0), b2, voffB);
            PG8_BAR; PG8_WAIT_L(0); PG8_MMA(0, 1, At, B1); PG8_BAR;
            PG8_LDA(At, 0, 1); PG8_STAGE(PG8_SA(0, 0), a2, voffA);
            PG8_BAR; PG8_WAIT_L(0); PG8_MMA(1, 0, At, B0); PG8_BAR; PG8_SCHED;
            PG8_STAGE(PG8_SB(0, 1), b2 + hstepB, voffB);
            PG8_WAIT_V(6); PG8_BAR; PG8_MMA(1, 1, At, B1); PG8_BAR;
            PG8_LDB(B0, 1, 0); PG8_SCHED; PG8_LDA(At, 1, 0); PG8_STAGE(PG8_SA(0, 1), a2 + hstepA, voffA);
            PG8_WAIT_L(8); PG8_BAR; PG8_WAIT_L(0); PG8_MMA(0, 0, At, B0); PG8_BAR; PG8_SCHED;
            PG8_LDB(B1, 1, 1); PG8_STAGE(PG8_SB(1, 0), b3, voffB);
            PG8_BAR; PG8_WAIT_L(0); PG8_MMA(0, 1, At, B1); PG8_BAR;
            PG8_LDA(At, 1, 1); PG8_STAGE(PG8_SA(1, 0), a3, voffA);
            PG8_BAR; PG8_WAIT_L(0); PG8_MMA(1, 0, At, B0); PG8_BAR; PG8_SCHED;
            PG8_STAGE(PG8_SB(1, 1), b3 + hstepB, voffB);
            PG8_WAIT_V(6); PG8_BAR; PG8_MMA(1, 1, At, B1); PG8_BAR;
            }
        }
        if constexpr (ALIGN_EPI) { if (wr == 0) PG8_BAR; }
        if constexpr (!Epi::AFTER_DRAIN) { E(acc, cur, wr, wc, fr, fq); S.done(cur); }
        if (!has_next) break;
#pragma unroll
        for (int a = 0; a < 2; ++a)
#pragma unroll
            for (int b = 0; b < 2; ++b)
#pragma unroll
                for (int m = 0; m < 4; ++m)
#pragma unroll
                    for (int n = 0; n < 2; ++n) acc[a][b][m][n] = (f32x4){0.f, 0.f, 0.f, 0.f};
        cur = nxt; cA = nA; cB = nB; ++ui;
        if constexpr (ALIGN_EPI) { if (wr == 1) PG8_BAR; }
    }
    PG8_WAIT_V(0);
    if constexpr (!ALIGN_EPI) { if (wr == 0) PG8_BAR; }
    PG8_BAR;
    if constexpr (Epi::AFTER_DRAIN) { E.fused(acc, cur, wr, wc, fr, fq, lds, wid, lane); S.done(cur); }
#undef PG8_SA
#undef PG8_SB
#undef PG8_STAGE
#undef PG8_LDA
#undef PG8_LDB
#undef PG8_MMA
#undef PG8_WAIT_V
#undef PG8_WAIT_L
#undef PG8_BAR
#undef PG8_SCHED
}
struct EpiF32 {
    static constexpr bool PERM = false, AFTER_DRAIN = false;
    float* C; int ldc;
    __device__ __forceinline__ void operator()(const f32x4 (&acc)[2][2][4][2], const Unit& u, int wr, int wc, int fr, int fq) const {
        const int row0 = u.pm * BM + wr * 64 + fr, col0 = u.pn * BM + wc * 32 + 4 * fq;
#pragma unroll
        for (int ai = 0; ai < 2; ++ai)
#pragma unroll
            for (int m = 0; m < 4; ++m) { float* rowp = C + (size_t)(row0 + ai * HALF + m * 16) * ldc + col0;
#pragma unroll
                for (int bj = 0; bj < 2; ++bj)
#pragma unroll
                    for (int n = 0; n < 2; ++n) *(f32x4*)(rowp + bj * HALF + n * 16) = acc[ai][bj][m][n]; }
    }
};
__device__ __forceinline__ float bf_lo(unsigned w) { return __uint_as_float(w << 16); }
__device__ __forceinline__ float bf_hi(unsigned w) { return __uint_as_float(w & 0xffff0000u); }
__device__ __forceinline__ float sigm(float x) { return __builtin_amdgcn_rcpf(1.0f + __builtin_amdgcn_exp2f(-1.4426950408889634f * x)); }
template <int MODE> __device__ __forceinline__ float zact(float x, float lb) {
    if (MODE == 0) return x * sigm(x);
    if (MODE == 1) { const float f = lb + (1.0f - lb) * sigm(x); return 0.6931471805599453f * __builtin_amdgcn_logf(f); }
    if (MODE == 2) return x;
    if (MODE == 3) return x * sigm(1.5957691216057308f * (x + 0.044715f * x * x * x));
    return sigm(x);
}
template <int N> __device__ __forceinline__ float row_shr(float v) {
    return __builtin_bit_cast(float, __builtin_amdgcn_update_dpp(0, __builtin_bit_cast(int, v), 0x110 + N, 0xf, 0xf, true));
}
struct EpiZ {
    static constexpr bool PERM = true, AFTER_DRAIN = false;
    bf16_t* Z; const float* lb; bf16_t* ZX;
    template <int MODE> __device__ __forceinline__ void run(const f32x4 (&acc)[2][2][4][2], const Unit& u, int wr, int wc, int fr, int fq) const {
        const int row0 = u.pm * BM + wr * 64 + fr, col0 = u.pn * BM + wc * 32 + 8 * fq;
        f32x4 lv[2][2];
#pragma unroll
        for (int bj = 0; bj < 2; ++bj)
#pragma unroll
            for (int n = 0; n < 2; ++n) lv[bj][n] = (MODE == 1) ? *(const f32x4*)(lb + (col0 - 1024) + bj * HALF + 4 * n) : (f32x4){0.f, 0.f, 0.f, 0.f};
#pragma unroll
        for (int ai = 0; ai < 2; ++ai)
#pragma unroll
            for (int m = 0; m < 4; ++m) { bf16_t* rowp = Z + (size_t)(row0 + ai * HALF + m * 16) * 6144 + col0;
#pragma unroll
                for (int bj = 0; bj < 2; ++bj) { const f32x4 a = acc[ai][bj][m][0], b = acc[ai][bj][m][1]; const f32x4 l0 = lv[bj][0], l1 = lv[bj][1];
                    u32x4 w; w.x = cvt_pk_bf16(zact<MODE>(a[0], l0[0]), zact<MODE>(a[1], l0[1])); w.y = cvt_pk_bf16(zact<MODE>(a[2], l0[2]), zact<MODE>(a[3], l0[3]));
                    w.z = cvt_pk_bf16(zact<MODE>(b[0], l1[0]), zact<MODE>(b[1], l1[1])); w.w = cvt_pk_bf16(zact<MODE>(b[2], l1[2]), zact<MODE>(b[3], l1[3]));
                    *(u32x4*)(rowp + bj * HALF) = w; } }
    }
    __device__ __forceinline__ void run_hgrn(const f32x4 (&acc)[2][2][4][2], const Unit& u, int wr, int wc, int fr, int fq) const {
        typedef unsigned u32x2 __attribute__((ext_vector_type(2)));
        const int row0 = u.pm * BM + wr * 64 + fr, col0 = u.pn * BM + wc * 32 + 8 * fq, kc0 = col0 - 1024;
#pragma unroll
        for (int ai = 0; ai < 2; ++ai)
#pragma unroll
            for (int bj = 0; bj < 2; ++bj)
#pragma unroll
                for (int n = 0; n < 2; ++n) { const f32x4 l4 = *(const f32x4*)(lb + kc0 + bj * HALF + 4 * n);
                    unsigned wE[4][2], wT[4][2], wH[4][2];
#pragma unroll
                    for (int e2 = 0; e2 < 2; ++e2) { float Ev[4][2], Tv[4][2], Hv[4][2];
#pragma unroll
                        for (int ee = 0; ee < 2; ++ee) { const int e = 2 * e2 + ee; const float lbv = l4[e]; float lfv[4], kkv[4];
#pragma unroll
                            for (int m = 0; m < 4; ++m) { const float x = acc[ai][bj][m][n][e]; const float s = sigm(x); const float f = lbv + (1.0f - lbv) * s;
                                lfv[m] = __builtin_amdgcn_logf(f); kkv[m] = (1.0f - lbv) * (1.0f - s); }
                            float run = 0.f, bc[4];
#pragma unroll
                            for (int m = 0; m < 4; ++m) { float v = lfv[m]; v += row_shr<1>(v); v += row_shr<2>(v); v += row_shr<4>(v); v += row_shr<8>(v);
                                const float tot = __shfl(v, 15, 16); bc[m] = v + run; run += tot; }
                            const float eL = __builtin_amdgcn_exp2f(run);
#pragma unroll
                            for (int m = 0; m < 4; ++m) { const float kt = kkv[m] * __builtin_amdgcn_exp2f(fminf(-bc[m], 120.f));
                                Ev[m][ee] = __builtin_amdgcn_exp2f(bc[m]); Tv[m][ee] = kt; Hv[m][ee] = kt * eL; } }
#pragma unroll
                        for (int m = 0; m < 4; ++m) { wE[m][e2] = cvt_pk_bf16(Ev[m][0], Ev[m][1]); wT[m][e2] = cvt_pk_bf16(Tv[m][0], Tv[m][1]); wH[m][e2] = cvt_pk_bf16(Hv[m][0], Hv[m][1]); } }
#pragma unroll
                    for (int m = 0; m < 4; ++m) { const size_t r = (size_t)(row0 + ai * HALF + m * 16);
                        *(u32x2*)(Z + r * 6144 + col0 + bj * HALF + 4 * n) = (u32x2){wE[m][0], wE[m][1]};
                        *(u32x2*)(ZX + r * 2048 + kc0 + bj * HALF + 4 * n) = (u32x2){wT[m][0], wT[m][1]};
                        *(u32x2*)(ZX + r * 2048 + 1024 + kc0 + bj * HALF + 4 * n) = (u32x2){wH[m][0], wH[m][1]}; }
                    asm volatile("" ::: "memory");
                }
    }
    __device__ __forceinline__ void operator()(const f32x4 (&acc)[2][2][4][2], const Unit& u, int wr, int wc, int fr, int fq) const {
        const int pn = u.pn;
        if (pn < 4) run<0>(acc, u, wr, wc, fr, fq);
        else if (pn < 8) { if (u.pm < 64) run_hgrn(acc, u, wr, wc, fr, fq); else run<1>(acc, u, wr, wc, fr, fq); }
        else if (pn < 10) run<2>(acc, u, wr, wc, fr, fq);
        else if (pn < 12) run<0>(acc, u, wr, wc, fr, fq);
        else if (pn < 16) run<3>(acc, u, wr, wc, fr, fq);
        else run<4>(acc, u, wr, wc, fr, fq);
    }
};
struct EpiGateF32 {
    static constexpr bool PERM = true, AFTER_DRAIN = false;
    float* C; const bf16_t* Z; int gcol;
    __device__ __forceinline__ void operator()(const f32x4 (&acc)[2][2][4][2], const Unit& u, int wr, int wc, int fr, int fq) const {
        const int row0 = u.pm * BM + wr * 64 + fr, col0 = u.pn * BM + wc * 32 + 8 * fq;
#pragma unroll
        for (int ai = 0; ai < 2; ++ai)
#pragma unroll
            for (int m = 0; m < 4; ++m) { const size_t r = (size_t)(row0 + ai * HALF + m * 16);
#pragma unroll
                for (int bj = 0; bj < 2; ++bj) { const u32x4 gw = *(const u32x4*)(Z + r * 6144 + gcol + col0 + bj * HALF);
                    const f32x4 a = acc[ai][bj][m][0], b = acc[ai][bj][m][1];
                    f32x4 o0, o1; o0[0] = a[0] * bf_lo(gw.x); o0[1] = a[1] * bf_hi(gw.x); o0[2] = a[2] * bf_lo(gw.y); o0[3] = a[3] * bf_hi(gw.y);
                    o1[0] = b[0] * bf_lo(gw.z); o1[1] = b[1] * bf_hi(gw.z); o1[2] = b[2] * bf_lo(gw.w); o1[3] = b[3] * bf_hi(gw.w);
                    float* p = C + r * 1024 + col0 + bj * HALF; *(f32x4*)p = o0; *(f32x4*)(p + 4) = o1; } }
    }
};
struct EpiComb {
    static constexpr bool PERM = true, AFTER_DRAIN = false;
    bf16_t* H; const float* Hf; const bf16_t* Z; int gcol;
    __device__ __forceinline__ void operator()(const f32x4 (&acc)[2][2][4][2], const Unit& u, int wr, int wc, int fr, int fq) const {
        const int row0 = u.pm * BM + wr * 64 + fr, col0 = u.pn * BM + wc * 32 + 8 * fq;
#pragma unroll
        for (int ai = 0; ai < 2; ++ai)
#pragma unroll
            for (int m = 0; m < 4; ++m) { const size_t r = (size_t)(row0 + ai * HALF + m * 16);
#pragma unroll
                for (int bj = 0; bj < 2; ++bj) { const u32x4 gw = *(const u32x4*)(Z + r * 6144 + gcol + col0 + bj * HALF);
                    const float* hp = Hf + r * 1024 + col0 + bj * HALF; const f32x4 h0 = *(const f32x4*)hp, h1 = *(const f32x4*)(hp + 4);
                    const f32x4 a = acc[ai][bj][m][0], b = acc[ai][bj][m][1];
                    u32x4 w; w.x = cvt_pk_bf16(h0[0] + a[0] * bf_lo(gw.x), h0[1] + a[1] * bf_hi(gw.x)); w.y = cvt_pk_bf16(h0[2] + a[2] * bf_lo(gw.y), h0[3] + a[3] * bf_hi(gw.y));
                    w.z = cvt_pk_bf16(h1[0] + b[0] * bf_lo(gw.z), h1[1] + b[1] * bf_hi(gw.z)); w.w = cvt_pk_bf16(h1[2] + b[2] * bf_lo(gw.w), h1[3] + b[3] * bf_hi(gw.w));
                    *(u32x4*)(H + r * 1024 + col0 + bj * HALF) = w; } }
    }
};

struct SampleSplitOrder {
    int KS, c;
    __device__ __forceinline__ bool next(int i, Unit& u) const { if (i > 0 || c >= 8 * KS) return false; u.ks = c % KS; const int t = c / KS; u.pn = t & 3; u.pm = 64 + (t >> 2); return true; }
    __device__ __forceinline__ void a_ready(const Unit&) const {}
    __device__ __forceinline__ void done(const Unit&) const {}
};
struct EpiSlabF32 {
    static constexpr bool PERM = false, AFTER_DRAIN = false;
    float* S;
    __device__ __forceinline__ void operator()(const f32x4 (&acc)[2][2][4][2], const Unit& u, int wr, int wc, int fr, int fq) const {
        const int row0 = (u.pm - 64) * BM + wr * 64 + fr, col0 = u.pn * BM + wc * 32 + 4 * fq; float* base = S + (size_t)u.ks * 512 * 1024;
#pragma unroll
        for (int ai = 0; ai < 2; ++ai)
#pragma unroll
            for (int m = 0; m < 4; ++m) { float* rowp = base + (size_t)(row0 + ai * HALF + m * 16) * 1024 + col0;
#pragma unroll
                for (int bj = 0; bj < 2; ++bj)
#pragma unroll
                    for (int n = 0; n < 2; ++n) *(f32x4*)(rowp + bj * HALF + n * 16) = acc[ai][bj][m][n]; }
    }
};
}
constexpr int NWAVES = 8, NT = 512;
constexpr int MP = 16384, MS = 512, M = MP + MS;
constexpr int D = 1024, DIN = 6144, FF = 2816, FF2 = 5632;
constexpr int ZQ = 0, ZF = 1024, ZI = 2048, ZOG = 2560, ZU = 3072, ZV = 3584, ZGA = 4096, ZGB = 5120;
constexpr float EPS = 1e-6f;
constexpr size_t O_YP = 0, O_YS = 16777216, O_SP = 17301504, O_SS = 17825792, O_CP = 26214400, O_CS = 26304512, O_VS = 27746304, O_END = 28008448;
constexpr size_t MiB = 1u << 20, KiB = 1u << 10;
constexpr size_t WS_CTL = 0, CTL_ZERO_BYTES = 1 * MiB;
constexpr size_t WS_WIN = 1 * MiB, WS_WPA = 13 * MiB, WS_WPB = 14 * MiB, WS_WO = 15 * MiB, WS_WUP = 17 * MiB, WS_WDN = 28 * MiB;
constexpr size_t WS_LB = 33 * MiB + 512 * KiB;
constexpr size_t WS_WSB = 33 * MiB + 576 * KiB;
constexpr size_t WS_XN = 34 * MiB;
constexpr size_t WS_Z = 67 * MiB;
constexpr size_t WS_OA = 265 * MiB, WS_OB = 281 * MiB + 512 * KiB;
constexpr size_t WS_HF = 298 * MiB;
constexpr size_t WS_H = 364 * MiB;
constexpr size_t WS_Y = 67 * MiB;
constexpr size_t WS_UP = 133 * MiB;
constexpr size_t WS_G = 314 * MiB + 512 * KiB;
constexpr size_t WS_SLAB8 = 34 * MiB;
constexpr size_t WS_SLAB4 = 406 * MiB;
constexpr size_t WS_SLABA = 414 * MiB, WS_SLABB = 418 * MiB;
constexpr size_t WS_END = 422 * MiB;
constexpr int CW_CNT = 8192;
constexpr int CW_BAR = 4096;

constexpr int RING_OFF = 0, RING_BYTES = 131072;
constexpr int LDSCTL_OFF = RING_BYTES, MISC_OFF = LDSCTL_OFF + 320;
constexpr int AUX_OFF = RING_BYTES + 1024;
constexpr int LDS_BYTES = 147456;

#define GAS __attribute__((address_space(1)))
#define LAS __attribute__((address_space(3)))
typedef unsigned short bf16;
typedef unsigned v4u __attribute__((ext_vector_type(4)));
typedef unsigned v2u __attribute__((ext_vector_type(2)));
typedef float f32x4 __attribute__((ext_vector_type(4)));
#define LDS_WAIT() asm volatile("s_waitcnt lgkmcnt(0)" ::: "memory")
__device__ __forceinline__ unsigned f2bf(float f) { unsigned u = __builtin_bit_cast(unsigned, f); return (u + 0x7fffu + ((u >> 16) & 1u)) >> 16; }
__device__ __forceinline__ unsigned pk2(float lo, float hi) { return f2bf(lo) | (f2bf(hi) << 16); }
__device__ __forceinline__ float bf2f(unsigned short h) { return __uint_as_float(((unsigned)h) << 16); }
__device__ __forceinline__ float bflo(unsigned w) { return __uint_as_float(w << 16); }
__device__ __forceinline__ float bfhi(unsigned w) { return __uint_as_float(w & 0xffff0000u); }
__device__ __forceinline__ float wave_sum(float v) {
#pragma unroll
    for (int o = 1; o < 64; o <<= 1) v += __shfl_xor(v, o);
    return v;
}

#define XB_TMO      128
#define XB_XCNT(j)  (256  + 64 * (j))
#define XB_XSUB(j)  (1280 + 64 * (j))
#define XB_XGEN(j)  (2304 + 64 * (j))
#define XB_TOP      3328
#define XB_TOPGEN   3392
#define XCD_BAR_WORDS 3456
#define XB_SPIN_CAP (1u << 18)
__device__ __forceinline__ unsigned xb_ld(unsigned* p)              { return __hip_atomic_load(p, __ATOMIC_RELAXED, __HIP_MEMORY_SCOPE_AGENT); }
__device__ __forceinline__ unsigned xb_add(unsigned* p, unsigned v) { return __hip_atomic_fetch_add(p, v, __ATOMIC_RELAXED, __HIP_MEMORY_SCOPE_AGENT); }
__device__ __forceinline__ unsigned xb_xcc_id() { return (unsigned)__builtin_amdgcn_s_getreg((3 << 11) | 20) & 0xFu; }
#define XB_SPIN(cond, bar) do { unsigned _sp = 0; while (cond) { __builtin_amdgcn_s_sleep(1); \
    if ((++_sp & 255u) == 0u) { if (xb_ld(&(bar)[XB_TMO])) break; if (_sp > XB_SPIN_CAP) { atomicAdd(&(bar)[XB_TMO], 1u); break; } } } } while (0)
struct XcdBarrier { unsigned* bar; unsigned x; volatile LAS unsigned* st; };
__device__ __forceinline__ XcdBarrier xcd_barrier_post(unsigned* bar, volatile LAS unsigned* st) {
    XcdBarrier b; b.bar = bar; b.x = xb_xcc_id(); b.st = st;
    if (threadIdx.x == 0) (void)xb_add(&bar[XB_XCNT(b.x)], 1u);
    return b;
}
__device__ __forceinline__ void xcd_barrier_complete(unsigned* bar, unsigned x, unsigned& nloc, unsigned& nx) {
    const unsigned G = gridDim.x * gridDim.y * gridDim.z;
    unsigned sum, cnt, mine, sp = 0u;
    for (;;) {
        sum = 0u; cnt = 0u; mine = 0u;
#pragma unroll
        for (unsigned j = 0; j < 16; ++j) { const unsigned c = xb_ld(&bar[XB_XCNT(j)]); sum += c; cnt += (c > 0u) ? 1u : 0u; mine = (j == x) ? c : mine; }
        if (sum == G) break;
        __builtin_amdgcn_s_sleep(1);
        if ((++sp & 255u) == 0u) { if (xb_ld(&bar[XB_TMO])) break; if (sp > XB_SPIN_CAP) { atomicAdd(&bar[XB_TMO], 1u); break; } }
    }
    nloc = mine > 0u ? mine : 1u; nx = cnt > 0u ? cnt : 1u;
}
__device__ __forceinline__ void xcd_barrier(const XcdBarrier& b) {
    asm volatile("s_waitcnt vmcnt(0)" ::: "memory");
    __syncthreads();
    if (threadIdx.x == 0) {
        unsigned* bar = b.bar;
        __builtin_amdgcn_s_waitcnt(0);
        unsigned nloc = b.st[0], nx = b.st[1];
        if (nloc == 0u) { xcd_barrier_complete(bar, b.x, nloc, nx); b.st[0] = nloc; b.st[1] = nx; }
        const unsigned old = xb_add(&bar[XB_XSUB(b.x)], 1u);
        const unsigned gen = old / nloc;
        if (old + 1u == (gen + 1u) * nloc) {
            __builtin_amdgcn_fence(__ATOMIC_RELEASE, "agent");
            asm volatile("s_waitcnt vmcnt(0)" ::: "memory");
            const unsigned og = xb_add(&bar[XB_TOP], 1u);
            const unsigned tg = og / nx;
            if (og + 1u == (tg + 1u) * nx) xb_add(&bar[XB_TOPGEN], 1u);
            else XB_SPIN(xb_ld(&bar[XB_TOPGEN]) == tg, bar);
            __builtin_amdgcn_fence(__ATOMIC_ACQUIRE, "agent");
            xb_add(&bar[XB_XGEN(b.x)], 1u);
            asm volatile("s_waitcnt vmcnt(0)" ::: "memory");
        } else {
            XB_SPIN(xb_ld(&bar[XB_XGEN(b.x)]) == gen, bar);
            __builtin_amdgcn_fence(__ATOMIC_ACQUIRE, "agent");
            asm volatile("s_waitcnt vmcnt(0)" ::: "memory");
        }
    }
    __syncthreads();
}

__device__ __forceinline__ void publish_count(unsigned* cnt) {
    asm volatile("s_waitcnt vmcnt(0)" ::: "memory"); __syncthreads();
    if (threadIdx.x == 0) { __builtin_amdgcn_fence(__ATOMIC_RELEASE, "agent"); asm volatile("s_waitcnt vmcnt(0)" ::: "memory"); (void)xb_add(cnt, 1u); }
}
__device__ __forceinline__ void wait_count(unsigned* cnt, unsigned need, unsigned* tmo) {
    if (threadIdx.x < 64) { unsigned sp = 0;
        while ((unsigned)__builtin_amdgcn_readfirstlane(xb_ld(cnt)) < need) { __builtin_amdgcn_s_sleep(2); if (++sp > (1u << 20)) { if (threadIdx.x == 0) atomicAdd(tmo, 1u); break; } }
        __builtin_amdgcn_fence(__ATOMIC_ACQUIRE, "agent"); asm volatile("s_waitcnt vmcnt(0)" ::: "memory"); }
    __syncthreads();
}

__device__ __forceinline__ void p0_transpose_item(const float* W, int N, bf16* WT, int ldwt, int koff, LAS float* scr, int item, int lane) {
    const int nblk = N / 32, kb = item / nblk, nb = item % nblk, k0 = 64 * kb, n0 = 32 * nb;
#pragma unroll 8
    for (int i = 0; i < 32; ++i) { const int kk = 2 * i + (lane >> 5); scr[kk * 33 + (lane & 31)] = W[(size_t)(k0 + kk) * N + n0 + (lane & 31)]; }
    LDS_WAIT(); asm volatile("" ::: "memory");
    const int c = lane & 7;
#pragma unroll
    for (int j = 0; j < 4; ++j) { const int n = (lane >> 3) + 8 * j; const LAS float* s = scr + (8 * c) * 33 + n;
        v4u o; o.x = pk2(s[0 * 33], s[1 * 33]); o.y = pk2(s[2 * 33], s[3 * 33]); o.z = pk2(s[4 * 33], s[5 * 33]); o.w = pk2(s[6 * 33], s[7 * 33]);
        *(GAS v4u*)(WT + (size_t)(n0 + n) * ldwt + koff + k0 + 8 * c) = o; }
    LDS_WAIT(); asm volatile("" ::: "memory");
}
__device__ __forceinline__ void rms_row_to_bf16(const float* xrow, const float* g, bf16* orow, int lane) {
    const GAS f32x4* xr = (const GAS f32x4*)xrow + lane; const GAS f32x4* gr = (const GAS f32x4*)g + lane;
    f32x4 v[4]; float s = 0.f;
#pragma unroll
    for (int j = 0; j < 4; ++j) { v[j] = xr[64 * j]; s += (v[j].x * v[j].x + v[j].y * v[j].y) + (v[j].z * v[j].z + v[j].w * v[j].w); }
    const float r = 1.0f / sqrtf(wave_sum(s) * (1.f / D) + EPS);
    GAS v2u* o8 = (GAS v2u*)orow + lane;
#pragma unroll
    for (int j = 0; j < 4; ++j) { const f32x4 gg = gr[64 * j]; v2u o; o.x = pk2(v[j].x * r * gg.x, v[j].y * r * gg.y); o.y = pk2(v[j].z * r * gg.z, v[j].w * r * gg.w); o8[64 * j] = o; }
}
constexpr int HG_TB = 16;
__device__ __forceinline__ void hgrn_recurrent(LAS unsigned char* lds, const bf16* Z, int row0, int T, int h, const float* S0, float* Sout, bf16* OA, const float* ng, int tid) {
    LAS float* Lq = (LAS float*)lds;
    LAS float* Lf = Lq + HG_TB * 128;
    LAS float* Li = Lf + HG_TB * 128;
    LAS float* Lo = Li + HG_TB * 64;
    const int lane = tid & 63, kg = tid >> 6;
    float S[16];
#pragma unroll
    for (int j = 0; j < 16; ++j) S[j] = S0 ? S0[(size_t)(16 * kg + j) * 64 + lane] : 0.f;
    const float gn = ng[lane];
    for (int t0 = 0; t0 < T; t0 += HG_TB) {
        const int nb = (T - t0) < HG_TB ? (T - t0) : HG_TB;
        for (int idx = tid; idx < nb * 128; idx += NT) { const int t = idx >> 7, k = idx & 127; const bf16* zr = Z + (size_t)(row0 + t0 + t) * DIN;
            Lq[idx] = bf2f(zr[ZQ + h * 128 + k]); Lf[idx] = __expf(bf2f(zr[ZF + h * 128 + k])); }
        for (int idx = tid; idx < nb * 64; idx += NT) { const int t = idx >> 6, v = idx & 63; Li[idx] = bf2f(Z[(size_t)(row0 + t0 + t) * DIN + ZI + h * 64 + v]); }
        __syncthreads();
        for (int t = 0; t < nb; ++t) {
            const float iv = Li[t * 64 + lane]; float o = 0.f;
#pragma unroll
            for (int jj = 0; jj < 4; ++jj) { const f32x4 f4 = *(const LAS f32x4*)(Lf + t * 128 + 16 * kg + 4 * jj), q4 = *(const LAS f32x4*)(Lq + t * 128 + 16 * kg + 4 * jj);
#pragma unroll
                for (int e = 0; e < 4; ++e) { const float f = f4[e]; S[4 * jj + e] = f * S[4 * jj + e] + (1.0f - f) * iv; o += q4[e] * S[4 * jj + e]; } }
            Lo[(t * 8 + kg) * 64 + lane] = o;
        }
        __syncthreads();
        for (int t = kg; t < nb; t += 8) {
            float o = 0.f;
#pragma unroll
            for (int w = 0; w < 8; ++w) o += Lo[(t * 8 + w) * 64 + lane];
            const float r = 1.0f / sqrtf(wave_sum(o * o) * (1.f / 64.f) + EPS);
            const size_t row = (size_t)(row0 + t0 + t);
            const float gs = bf2f(Z[row * DIN + ZOG + h * 64 + lane]);
            OA[row * 512 + h * 64 + lane] = (bf16)f2bf(o * r * gn * gs);
        }
    }
    if (Sout) {
#pragma unroll
        for (int j = 0; j < 16; ++j) Sout[(size_t)(16 * kg + j) * 64 + lane] = S[j];
    }
    __syncthreads();
}

__device__ __forceinline__ void gmlp_prompt_item(LAS unsigned char* lds, const bf16* Z, int r0, int g, const float* lng, const float* lnb, const float* ws, const float* bs, bf16* OB, int tid) {
    LAS float* VN = (LAS float*)lds;
    LAS float* WT = VN + 128 * 128;
    LAS float* ST = (LAS float*)(lds + AUX_OFF);
    const int lane = tid & 63, wave = tid >> 6;
    for (int rr = 0; rr < 16; ++rr) { const int row = 16 * wave + rr; const v4u w = *(const GAS v4u*)(Z + (size_t)(r0 + row) * DIN + ZV + 8 * lane);
        const float a0 = bflo(w.x), a1 = bfhi(w.x), a2 = bflo(w.y), a3 = bfhi(w.y), a4 = bflo(w.z), a5 = bfhi(w.z), a6 = bflo(w.w), a7 = bfhi(w.w);
        const float s = wave_sum(((a0 + a1) + (a2 + a3)) + ((a4 + a5) + (a6 + a7)));
        const float mean = s * (1.f / 512.f);
        const float d0 = a0 - mean, d1 = a1 - mean, d2 = a2 - mean, d3 = a3 - mean, d4 = a4 - mean, d5 = a5 - mean, d6 = a6 - mean, d7 = a7 - mean;
        const float q = wave_sum(((d0 * d0 + d1 * d1) + (d2 * d2 + d3 * d3)) + ((d4 * d4 + d5 * d5) + (d6 * d6 + d7 * d7)));
        if (lane == 0) { ST[2 * row] = mean; ST[2 * row + 1] = 1.0f / sqrtf(q * (1.f / 512.f) + EPS); } }
    const float* wg = ws + (size_t)g * 128 * 128;
    for (int idx = tid; idx < 128 * 32; idx += NT) { const int t = idx >> 5, s4 = (idx & 31) * 4; const f32x4 w = *(const GAS f32x4*)(wg + t * 128 + s4);
#pragma unroll
        for (int e = 0; e < 4; ++e) WT[(s4 + e) * 128 + t] = (s4 + e <= t) ? w[e] : 0.f; }
    __syncthreads();
    for (int idx = tid; idx < 128 * 16; idx += NT) { const int row = idx >> 4, oc = idx & 15; const v4u w = *(const GAS v4u*)(Z + (size_t)(r0 + row) * DIN + ZV + 128 * g + 8 * oc);
        const float mean = ST[2 * row], rstd = ST[2 * row + 1]; const float* gp = lng + 128 * g + 8 * oc; const float* bp = lnb + 128 * g + 8 * oc;
        f32x4 o0, o1; o0[0] = (bflo(w.x) - mean) * rstd * gp[0] + bp[0]; o0[1] = (bfhi(w.x) - mean) * rstd * gp[1] + bp[1]; o0[2] = (bflo(w.y) - mean) * rstd * gp[2] + bp[2]; o0[3] = (bfhi(w.y) - mean) * rstd * gp[3] + bp[3];
        o1[0] = (bflo(w.z) - mean) * rstd * gp[4] + bp[4]; o1[1] = (bfhi(w.z) - mean) * rstd * gp[5] + bp[5]; o1[2] = (bflo(w.w) - mean) * rstd * gp[6] + bp[6]; o1[3] = (bfhi(w.w) - mean) * rstd * gp[7] + bp[7];
        *(LAS f32x4*)(VN + row * 128 + 8 * oc) = o0; *(LAS f32x4*)(VN + row * 128 + 8 * oc + 4) = o1; }
    __syncthreads();
    const int c = tid & 127, tq = tid >> 7;
    float acc[32];
#pragma unroll
    for (int j = 0; j < 32; ++j) acc[j] = 0.f;
    const int smax = 32 * tq + 32;
    for (int s = 0; s < smax; ++s) { const float vn = VN[s * 128 + c]; const LAS float* wr_ = WT + s * 128 + 32 * tq;
#pragma unroll
        for (int j4 = 0; j4 < 8; ++j4) { const f32x4 w = *(const LAS f32x4*)(wr_ + 4 * j4);
#pragma unroll
            for (int e = 0; e < 4; ++e) acc[4 * j4 + e] += w[e] * vn; } }
    const float* bsg = bs + g * 128;
#pragma unroll
    for (int j = 0; j < 32; ++j) { const int t = 32 * tq + j; const size_t row = (size_t)(r0 + t);
        const float gu = bf2f(Z[row * DIN + ZU + 128 * g + c]);
        OB[row * 512 + 128 * g + c] = (bf16)f2bf(gu * (acc[j] + bsg[t])); }
    __syncthreads();
}

__device__ __forceinline__ void gmlp_sample_item(LAS unsigned char* lds, const bf16* Z, int sb, const float* lng, const float* lnb, const float* ws, const float* bs, bf16* OB, float* vs_out, int tid) {
    LAS float* VN = (LAS float*)lds;
    const int lane = tid & 63, wave = tid >> 6; const int r0 = MP + 4 * sb;
    if (wave < 4) { const int row = wave; const v4u w = *(const GAS v4u*)(Z + (size_t)(r0 + row) * DIN + ZV + 8 * lane);
        float a[8] = {bflo(w.x), bfhi(w.x), bflo(w.y), bfhi(w.y), bflo(w.z), bfhi(w.z), bflo(w.w), bfhi(w.w)};
        const float s = wave_sum(((a[0] + a[1]) + (a[2] + a[3])) + ((a[4] + a[5]) + (a[6] + a[7]))); const float mean = s * (1.f / 512.f); float q = 0.f;
#pragma unroll
        for (int e = 0; e < 8; ++e) { a[e] -= mean; q += a[e] * a[e]; }
        const float rstd = 1.0f / sqrtf(wave_sum(q) * (1.f / 512.f) + EPS);
#pragma unroll
        for (int e = 0; e < 8; ++e) { const float vn = a[e] * rstd * lng[8 * lane + e] + lnb[8 * lane + e]; VN[row * 512 + 8 * lane + e] = vn; vs_out[(size_t)(4 * sb + row) * 512 + 8 * lane + e] = vn; } }
    __syncthreads();
    for (int idx = tid; idx < 4 * 512; idx += NT) { const int t = idx >> 9, c = idx & 511, g = c >> 7; float s = bs[g * 128 + t];
        for (int q = 0; q <= t; ++q) s += ws[(size_t)g * 16384 + t * 128 + q] * VN[q * 512 + c];
        const size_t row = (size_t)(r0 + t); const float gu = bf2f(Z[row * DIN + ZU + c]);
        OB[row * 512 + c] = (bf16)f2bf(gu * s); }
    __syncthreads();
}

__device__ __forceinline__ void conv_gate_item(const bf16* UP, const float* cache, const float* cw, const float* cb, bf16* G, float* cp, float* cs, int rb, int oc) {
    const int j0 = 8 * oc; const int r0 = 16 * rb; const bool sample = r0 >= MP;
    float w0g[8], w1g[8], w2g[8], bg[8], w0v[8], w1v[8], w2v[8], bv[8];
#pragma unroll
    for (int e = 0; e < 8; ++e) { w0g[e] = cw[j0 + e]; w1g[e] = cw[FF2 + j0 + e]; w2g[e] = cw[2 * FF2 + j0 + e]; bg[e] = cb[j0 + e];
        w0v[e] = cw[FF + j0 + e]; w1v[e] = cw[FF2 + FF + j0 + e]; w2v[e] = cw[2 * FF2 + FF + j0 + e]; bv[e] = cb[FF + j0 + e]; }
    float g2[8], g1[8], v2[8], v1[8];
    if (!sample) {
        if ((r0 & 2047) == 0) {
#pragma unroll
            for (int e = 0; e < 8; ++e) { g2[e] = 0.f; g1[e] = 0.f; v2[e] = 0.f; v1[e] = 0.f; }
        } else {
            const v4u a = *(const GAS v4u*)(UP + (size_t)(r0 - 2) * FF2 + j0), b = *(const GAS v4u*)(UP + (size_t)(r0 - 1) * FF2 + j0);
            const v4u c = *(const GAS v4u*)(UP + (size_t)(r0 - 2) * FF2 + FF + j0), d = *(const GAS v4u*)(UP + (size_t)(r0 - 1) * FF2 + FF + j0);
            g2[0] = bflo(a.x); g2[1] = bfhi(a.x); g2[2] = bflo(a.y); g2[3] = bfhi(a.y); g2[4] = bflo(a.z); g2[5] = bfhi(a.z); g2[6] = bflo(a.w); g2[7] = bfhi(a.w);
            g1[0] = bflo(b.x); g1[1] = bfhi(b.x); g1[2] = bflo(b.y); g1[3] = bfhi(b.y); g1[4] = bflo(b.z); g1[5] = bfhi(b.z); g1[6] = bflo(b.w); g1[7] = bfhi(b.w);
            v2[0] = bflo(c.x); v2[1] = bfhi(c.x); v2[2] = bflo(c.y); v2[3] = bfhi(c.y); v2[4] = bflo(c.z); v2[5] = bfhi(c.z); v2[6] = bflo(c.w); v2[7] = bfhi(c.w);
            v1[0] = bflo(d.x); v1[1] = bfhi(d.x); v1[2] = bflo(d.y); v1[3] = bfhi(d.y); v1[4] = bflo(d.z); v1[5] = bfhi(d.z); v1[6] = bflo(d.w); v1[7] = bfhi(d.w);
        }
    }
#pragma unroll 4
    for (int i = 0; i < 16; ++i) {
        const int r = r0 + i;
        if (sample && (i & 3) == 0) { const int sb = (r - MP) >> 2; const float* c0 = cache + (size_t)sb * 2 * FF2;
#pragma unroll
            for (int e = 0; e < 8; ++e) { g2[e] = c0[j0 + e]; g1[e] = c0[FF2 + j0 + e]; v2[e] = c0[FF + j0 + e]; v1[e] = c0[FF2 + FF + j0 + e]; } }
        const v4u a = *(const GAS v4u*)(UP + (size_t)r * FF2 + j0), c = *(const GAS v4u*)(UP + (size_t)r * FF2 + FF + j0);
        float g0[8] = {bflo(a.x), bfhi(a.x), bflo(a.y), bfhi(a.y), bflo(a.z), bfhi(a.z), bflo(a.w), bfhi(a.w)};
        float v0[8] = {bflo(c.x), bfhi(c.x), bflo(c.y), bfhi(c.y), bflo(c.z), bfhi(c.z), bflo(c.w), bfhi(c.w)};
        float o[8];
#pragma unroll
        for (int e = 0; e < 8; ++e) { const float cg = bg[e] + w0g[e] * g2[e] + w1g[e] * g1[e] + w2g[e] * g0[e]; const float cv = bv[e] + w0v[e] * v2[e] + w1v[e] * v1[e] + w2v[e] * v0[e];
            const float ge = cg * pg8::sigm(1.5957691216057308f * (cg + 0.044715f * cg * cg * cg)); o[e] = ge * cv; }
        v4u ow; ow.x = pk2(o[0], o[1]); ow.y = pk2(o[2], o[3]); ow.z = pk2(o[4], o[5]); ow.w = pk2(o[6], o[7]);
        *(GAS v4u*)(G + (size_t)r * FF + j0) = ow;
        if (!sample) { const int t = r & 2047; if (t >= 2046) { float* dst = cp + ((size_t)(r >> 11) * 2 + (t - 2046)) * FF2;
#pragma unroll
                for (int e = 0; e < 8; ++e) { dst[j0 + e] = g0[e]; dst[FF + j0 + e] = v0[e]; } } }
        else { const int t = (r - MP) & 3; if (t >= 2) { float* dst = cs + ((size_t)((r - MP) >> 2) * 2 + (t - 2)) * FF2;
#pragma unroll
                for (int e = 0; e < 8; ++e) { dst[j0 + e] = g0[e]; dst[FF + j0 + e] = v0[e]; } } }
#pragma unroll
        for (int e = 0; e < 8; ++e) { g2[e] = g1[e]; g1[e] = g0[e]; v2[e] = v1[e]; v1[e] = v0[e]; }
    }
}
typedef short bf16x8v __attribute__((ext_vector_type(8)));
typedef short s16x4 __attribute__((ext_vector_type(4)));
constexpr int HC_PQ = 272, HC_PI = 144;
constexpr int HC_Q0 = 0, HC_KH0 = 17408, HC_I0 = 34816, HC_P0 = 44032, HC_D0 = 53248, HC_BUF = 53760;
constexpr int HC_KT = 2 * HC_BUF, HC_SSQ = HC_KT + 17408, HC_END = HC_SSQ + 1024;
static_assert(HC_END <= RING_BYTES, "HGRN LDS map");
#define HC_BAR() do { asm volatile("s_waitcnt lgkmcnt(0)" ::: "memory"); __builtin_amdgcn_s_barrier(); asm volatile("" ::: "memory"); } while (0)
__device__ __forceinline__ unsigned mul_bf2(unsigned a, unsigned b) { return pg8::cvt_pk_bf16(bflo(a) * bflo(b), bfhi(a) * bfhi(b)); }

struct HcRegs { v4u q[4], e[4], kt[4], kh[4], iv[2]; };
__device__ __forceinline__ void hc_load(HcRegs& R, const bf16* Z, const bf16* ZX, int grow0, int h, int ptid) {
#pragma unroll
    for (int j = 0; j < 4; ++j) { const int id = ptid + 256 * j, row = id >> 4, pc = id & 15; const size_t gr = (size_t)(grow0 + row);
        R.q[j] = *(const GAS v4u*)(Z + gr * DIN + ZQ + 128 * h + 8 * pc); R.e[j] = *(const GAS v4u*)(Z + gr * DIN + ZF + 128 * h + 8 * pc);
        R.kt[j] = *(const GAS v4u*)(ZX + gr * 2048 + 128 * h + 8 * pc); R.kh[j] = *(const GAS v4u*)(ZX + gr * 2048 + 1024 + 128 * h + 8 * pc); }
#pragma unroll
    for (int j = 0; j < 2; ++j) { const int id = ptid + 256 * j, row = id >> 3, pc = id & 7; R.iv[j] = *(const GAS v4u*)(Z + (size_t)(grow0 + row) * DIN + ZI + 64 * h + 8 * pc); }
}
__device__ __forceinline__ void hc_write(const HcRegs& R, LAS unsigned char* lds, LAS unsigned char* Bx, int ptid) {
#pragma unroll
    for (int j = 0; j < 4; ++j) { const int id = ptid + 256 * j, row = id >> 4, pc = id & 15;
        v4u qt; qt.x = mul_bf2(R.q[j].x, R.e[j].x); qt.y = mul_bf2(R.q[j].y, R.e[j].y); qt.z = mul_bf2(R.q[j].z, R.e[j].z); qt.w = mul_bf2(R.q[j].w, R.e[j].w);
        *(LAS v4u*)(Bx + HC_Q0 + row * HC_PQ + pc * 16) = qt;
        *(LAS v4u*)(lds + HC_KT + row * HC_PQ + pc * 16) = R.kt[j];
        *(LAS v4u*)(Bx + HC_KH0 + row * HC_PQ + pc * 16) = R.kh[j];
        if (row == 63) { LAS f32x4* dp = (LAS f32x4*)(Bx + HC_D0 + pc * 32);
            dp[0] = (f32x4){bflo(R.e[j].x), bfhi(R.e[j].x), bflo(R.e[j].y), bfhi(R.e[j].y)}; dp[1] = (f32x4){bflo(R.e[j].z), bfhi(R.e[j].z), bflo(R.e[j].w), bfhi(R.e[j].w)}; } }
#pragma unroll
    for (int j = 0; j < 2; ++j) { const int id = ptid + 256 * j, row = id >> 3, pc = id & 7; *(LAS v4u*)(Bx + HC_I0 + row * HC_PI + pc * 16) = R.iv[j]; }
}
__device__ __forceinline__ void hc_pcomp(LAS unsigned char* lds, LAS unsigned char* Bx, int pw, int c, int g) {
    const int ti = pw, t = 16 * ti + c;
#pragma unroll
    for (int si = 0; si < 4; ++si) { f32x4 acc = {0.f, 0.f, 0.f, 0.f};
        if (si <= ti) {
#pragma unroll
            for (int k4 = 0; k4 < 4; ++k4) { const bf16x8v a = *(const LAS bf16x8v*)(lds + HC_KT + (16 * si + c) * HC_PQ + (32 * k4 + 8 * g) * 2);
                const bf16x8v bq = *(const LAS bf16x8v*)(Bx + HC_Q0 + (16 * ti + c) * HC_PQ + (32 * k4 + 8 * g) * 2);
                acc = __builtin_amdgcn_mfma_f32_16x16x32_bf16(a, bq, acc, 0, 0, 0); } }
        const int s0 = 16 * si + 4 * g;
        v2u w; w.x = pg8::cvt_pk_bf16(s0 <= t ? acc[0] : 0.f, s0 + 1 <= t ? acc[1] : 0.f); w.y = pg8::cvt_pk_bf16(s0 + 2 <= t ? acc[2] : 0.f, s0 + 3 <= t ? acc[3] : 0.f);
        *(LAS v2u*)(Bx + HC_P0 + t * HC_PI + s0 * 2) = w; }
}
__device__ __forceinline__ bf16x8v hc_tr8(const LAS unsigned char* p, int rowpitch4) {
    const s16x4 v0 = __builtin_amdgcn_ds_read_tr16_b64_v4i16((LAS s16x4*)p), v1 = __builtin_amdgcn_ds_read_tr16_b64_v4i16((LAS s16x4*)(p + rowpitch4));
    return __builtin_shufflevector(v0, v1, 0, 1, 2, 3, 4, 5, 6, 7);
}
struct HcCons { f32x4 S[8]; f32x4 O[4]; float gs[16]; };
__device__ __forceinline__ void hc_main(HcCons& K, LAS unsigned char* lds, LAS unsigned char* Bx, int w, int c, int g, int q, int p, const bf16* Z, int grow0, int h) {
    const int vs = 16 * w;
    { const bf16* zc = Z + (size_t)grow0 * DIN + ZOG + 64 * h; const unsigned lo = (unsigned)(4 * g) * DIN + vs + c;
#pragma unroll
      for (int mt = 0; mt < 4; ++mt)
#pragma unroll
        for (int r = 0; r < 4; ++r) K.gs[4 * mt + r] = bf2f(zc[lo + (unsigned)(16 * mt + r) * DIN]); }
    bf16x8v bI[2];
#pragma unroll
    for (int ks = 0; ks < 2; ++ks) bI[ks] = hc_tr8(Bx + HC_I0 + (32 * ks + 8 * g + q) * HC_PI + (vs + 4 * p) * 2, 4 * HC_PI);
#pragma unroll
    for (int mt = 0; mt < 4; ++mt) { K.O[mt] = (f32x4){0.f, 0.f, 0.f, 0.f};
#pragma unroll
        for (int ks = 0; ks < 2; ++ks) { const bf16x8v a = *(const LAS bf16x8v*)(Bx + HC_P0 + (16 * mt + c) * HC_PI + (32 * ks + 8 * g) * 2);
            K.O[mt] = __builtin_amdgcn_mfma_f32_16x16x32_bf16(a, bI[ks], K.O[mt], 0, 0, 0); } }
#pragma unroll
    for (int k4 = 0; k4 < 4; ++k4) {
        v4u sb; sb.x = pg8::cvt_pk_bf16(K.S[2 * k4][0], K.S[2 * k4][1]); sb.y = pg8::cvt_pk_bf16(K.S[2 * k4][2], K.S[2 * k4][3]);
        sb.z = pg8::cvt_pk_bf16(K.S[2 * k4 + 1][0], K.S[2 * k4 + 1][1]); sb.w = pg8::cvt_pk_bf16(K.S[2 * k4 + 1][2], K.S[2 * k4 + 1][3]);
        const bf16x8v bS = __builtin_bit_cast(bf16x8v, sb);
#pragma unroll
        for (int mt = 0; mt < 4; ++mt) { const LAS unsigned char* qp = Bx + HC_Q0 + (16 * mt + c) * HC_PQ + (32 * k4 + 4 * g) * 2;
            const v2u a0 = *(const LAS v2u*)qp, a1 = *(const LAS v2u*)(qp + 32);
            const bf16x8v a = __builtin_bit_cast(bf16x8v, (v4u){a0.x, a0.y, a1.x, a1.y});
            K.O[mt] = __builtin_amdgcn_mfma_f32_16x16x32_bf16(a, bS, K.O[mt], 0, 0, 0); } }
#pragma unroll
    for (int kt = 0; kt < 8; ++kt) { const f32x4 d4 = *(const LAS f32x4*)(Bx + HC_D0 + (16 * kt + 4 * g) * 4); K.S[kt] = K.S[kt] * d4;
#pragma unroll
        for (int ks = 0; ks < 2; ++ks) { const bf16x8v a = hc_tr8(Bx + HC_KH0 + (32 * ks + 8 * g + q) * HC_PQ + (16 * kt + 4 * p) * 2, 4 * HC_PQ);
            K.S[kt] = __builtin_amdgcn_mfma_f32_16x16x32_bf16(a, bI[ks], K.S[kt], 0, 0, 0); } }
    float sq[16];
#pragma unroll
    for (int mt = 0; mt < 4; ++mt)
#pragma unroll
        for (int r = 0; r < 4; ++r) { float s = K.O[mt][r] * K.O[mt][r]; s += pg8::row_shr<1>(s); s += pg8::row_shr<2>(s); s += pg8::row_shr<4>(s); s += pg8::row_shr<8>(s); sq[4 * mt + r] = s; }
    if (c == 15) { LAS float* ssq = (LAS float*)(lds + HC_SSQ);
#pragma unroll
        for (int mt = 0; mt < 4; ++mt)
#pragma unroll
            for (int r = 0; r < 4; ++r) ssq[(16 * mt + 4 * g + r) * 4 + w] = sq[4 * mt + r]; }
}
__device__ __forceinline__ void hc_epi(const HcCons& K, LAS unsigned char* lds, int w, int c, int g, int grow0, int h, bf16* OA, float gn) {
    const LAS f32x4* ssq = (const LAS f32x4*)(lds + HC_SSQ); const int vs = 16 * w;
    bf16* oc = OA + (size_t)grow0 * 512 + 64 * h; const unsigned lo = (unsigned)(4 * g) * 512 + vs + c;
#pragma unroll
    for (int mt = 0; mt < 4; ++mt)
#pragma unroll
        for (int r = 0; r < 4; ++r) { const f32x4 p4 = ssq[16 * mt + 4 * g + r]; const float ss = (p4[0] + p4[1]) + (p4[2] + p4[3]);
            const float rn = __builtin_amdgcn_rsqf(ss * (1.f / 64.f) + EPS);
            oc[lo + (unsigned)(16 * mt + r) * 512] = (bf16)f2bf(K.O[mt][r] * rn * gn * K.gs[4 * mt + r]); }
}
__device__ __forceinline__ void hgrn_chunked(LAS unsigned char* lds, const bf16* Z, const bf16* ZX, int b, int h, float* Sout, bf16* OA, const float* ng, int tid) {
    const int lane = tid & 63, wave = __builtin_amdgcn_readfirstlane(tid >> 6);
    const int c = lane & 15, g = lane >> 4, q = (lane & 15) >> 2, p = lane & 3;
    const int rowbase = b * 2048; constexpr int NCH = 32;
    if (wave >= 4) {
        const int ptid = tid - 256, pw = wave - 4;
        HcRegs R;
        hc_load(R, Z, ZX, rowbase, h, ptid);
        hc_write(R, lds, lds, ptid);
        hc_load(R, Z, ZX, rowbase + 64, h, ptid);
        HC_BAR();
        hc_pcomp(lds, lds, pw, c, g);
        HC_BAR();
        for (int ch = 0; ch < NCH; ++ch) {
            LAS unsigned char* Bn = lds + ((ch + 1) & 1) * HC_BUF;
            if (ch + 1 < NCH) { hc_write(R, lds, Bn, ptid); if (ch + 2 < NCH) hc_load(R, Z, ZX, rowbase + 64 * (ch + 2), h, ptid); }
            HC_BAR();
            if (ch + 1 < NCH) hc_pcomp(lds, Bn, pw, c, g);
            HC_BAR();
        }
    } else {
        const int w = wave; const float gn = ng[16 * w + c];
        HcCons K;
#pragma unroll
        for (int kt = 0; kt < 8; ++kt) K.S[kt] = (f32x4){0.f, 0.f, 0.f, 0.f};
        HC_BAR();
        HC_BAR();
        for (int ch = 0; ch < NCH; ++ch) {
            LAS unsigned char* Bc = lds + (ch & 1) * HC_BUF;
            hc_main(K, lds, Bc, w, c, g, q, p, Z, rowbase + 64 * ch, h);
            HC_BAR();
            hc_epi(K, lds, w, c, g, rowbase + 64 * ch, h, OA, gn);
            HC_BAR();
        }
#pragma unroll
        for (int kt = 0; kt < 8; ++kt)
#pragma unroll
            for (int r = 0; r < 4; ++r) Sout[(size_t)(16 * kt + 4 * g + r) * 64 + 16 * w + c] = K.S[kt][r];
    }
    __syncthreads();
}

__device__ __forceinline__ void hgrn_sample_wave(LAS unsigned char* wl, const bf16* Z, int sb, int h, const float* S0, float* Sout, bf16* OA, const float* ng, int lane) {
    LAS float* Lq = (LAS float*)wl; LAS float* Lf = Lq + 512;
    const int row0 = MP + 4 * sb;
    float S[128];
#pragma unroll
    for (int k = 0; k < 128; ++k) S[k] = S0[(size_t)k * 64 + lane];
    float iv[4], gs[4];
#pragma unroll
    for (int t = 0; t < 4; ++t) { const bf16* zr = Z + (size_t)(row0 + t) * DIN;
        Lq[t * 128 + lane] = bf2f(zr[ZQ + 128 * h + lane]); Lq[t * 128 + 64 + lane] = bf2f(zr[ZQ + 128 * h + 64 + lane]);
        Lf[t * 128 + lane] = __expf(bf2f(zr[ZF + 128 * h + lane])); Lf[t * 128 + 64 + lane] = __expf(bf2f(zr[ZF + 128 * h + 64 + lane]));
        iv[t] = bf2f(zr[ZI + 64 * h + lane]); gs[t] = bf2f(zr[ZOG + 64 * h + lane]); }
    LDS_WAIT(); asm volatile("" ::: "memory");
    float o[4] = {0.f, 0.f, 0.f, 0.f};
#pragma unroll
    for (int k4 = 0; k4 < 32; ++k4) {
#pragma unroll
        for (int t = 0; t < 4; ++t) { const f32x4 f4 = *(const LAS f32x4*)(Lf + t * 128 + 4 * k4), q4 = *(const LAS f32x4*)(Lq + t * 128 + 4 * k4);
#pragma unroll
            for (int e = 0; e < 4; ++e) { const float f = f4[e]; S[4 * k4 + e] = f * S[4 * k4 + e] + (1.0f - f) * iv[t]; o[t] += q4[e] * S[4 * k4 + e]; } } }
    const float gn = ng[lane];
#pragma unroll
    for (int t = 0; t < 4; ++t) { const float r = 1.0f / sqrtf(wave_sum(o[t] * o[t]) * (1.f / 64.f) + EPS);
        OA[(size_t)(row0 + t) * 512 + 64 * h + lane] = (bf16)f2bf(o[t] * r * gn * gs[t]); }
#pragma unroll
    for (int k = 0; k < 128; ++k) Sout[(size_t)k * 64 + lane] = S[k];
    LDS_WAIT(); asm volatile("" ::: "memory");
}
constexpr int GM_P = 272, GM_VN = 0, GM_W = 34816;
__device__ __forceinline__ void gmlp_prompt_bng(LAS unsigned char* lds, const bf16* Z, int r0, int g, const float* lng, const float* lnb, const bf16* WSB, const float* bs, bf16* OB, int tid) {
    const int lane = tid & 63, w = __builtin_amdgcn_readfirstlane(tid >> 6);
    const int c = lane & 15, g4 = lane >> 4, q = (lane & 15) >> 2, p = lane & 3;
    const int prow = tid >> 4, pc = tid & 15;
    float mean[4], rstd[4];
    {
        v4u vr[16];
#pragma unroll
        for (int j = 0; j < 16; ++j) vr[j] = *(const GAS v4u*)(Z + (size_t)(r0 + prow + 32 * (j >> 2)) * DIN + ZV + 128 * (j & 3) + 8 * pc);
#pragma unroll
        for (int jr = 0; jr < 4; ++jr) { float s = 0.f, qq = 0.f;
#pragma unroll
            for (int gq = 0; gq < 4; ++gq) { const v4u x = vr[4 * jr + gq];
                const float a0 = bflo(x.x), a1 = bfhi(x.x), a2 = bflo(x.y), a3 = bfhi(x.y), a4 = bflo(x.z), a5 = bfhi(x.z), a6 = bflo(x.w), a7 = bfhi(x.w);
                s += ((a0 + a1) + (a2 + a3)) + ((a4 + a5) + (a6 + a7)); qq += ((a0 * a0 + a1 * a1) + (a2 * a2 + a3 * a3)) + ((a4 * a4 + a5 * a5) + (a6 * a6 + a7 * a7)); }
            s += __shfl_xor(s, 1); qq += __shfl_xor(qq, 1); s += __shfl_xor(s, 2); qq += __shfl_xor(qq, 2); s += __shfl_xor(s, 4); qq += __shfl_xor(qq, 4); s += __shfl_xor(s, 8); qq += __shfl_xor(qq, 8);
            mean[jr] = s * (1.f / 512.f); const float var = qq * (1.f / 512.f) - mean[jr] * mean[jr]; rstd[jr] = 1.0f / sqrtf(fmaxf(var, 0.f) + EPS); }
    }
    asm volatile("" ::: "memory");
    {
        const f32x4 ga = *(const GAS f32x4*)(lng + 128 * g + 8 * pc), gb = *(const GAS f32x4*)(lng + 128 * g + 8 * pc + 4);
        const f32x4 ba = *(const GAS f32x4*)(lnb + 128 * g + 8 * pc), bb = *(const GAS f32x4*)(lnb + 128 * g + 8 * pc + 4);
        v4u xg[4];
#pragma unroll
        for (int jr = 0; jr < 4; ++jr) xg[jr] = *(const GAS v4u*)(Z + (size_t)(r0 + prow + 32 * jr) * DIN + ZV + 128 * g + 8 * pc);
#pragma unroll
        for (int jr = 0; jr < 4; ++jr) { const v4u x = xg[jr]; const float m_ = mean[jr], r_ = rstd[jr];
            v4u o; o.x = pg8::cvt_pk_bf16((bflo(x.x) - m_) * r_ * ga[0] + ba[0], (bfhi(x.x) - m_) * r_ * ga[1] + ba[1]); o.y = pg8::cvt_pk_bf16((bflo(x.y) - m_) * r_ * ga[2] + ba[2], (bfhi(x.y) - m_) * r_ * ga[3] + ba[3]);
            o.z = pg8::cvt_pk_bf16((bflo(x.z) - m_) * r_ * gb[0] + bb[0], (bfhi(x.z) - m_) * r_ * gb[1] + bb[1]); o.w = pg8::cvt_pk_bf16((bflo(x.w) - m_) * r_ * gb[2] + bb[2], (bfhi(x.w) - m_) * r_ * gb[3] + bb[3]);
            *(LAS v4u*)(lds + GM_VN + (prow + 32 * jr) * GM_P + pc * 16) = o; }
#pragma unroll
        for (int j2 = 0; j2 < 4; ++j2) { const int id = tid + 512 * j2, t = id >> 4, wp = id & 15;
            *(LAS v4u*)(lds + GM_W + t * GM_P + wp * 16) = *(const GAS v4u*)(WSB + (size_t)g * 16384 + t * 128 + 8 * wp); }
    }
    const size_t orow = (size_t)(r0 + 16 * w + c);
    v2u gu[8];
#pragma unroll
    for (int ct = 0; ct < 8; ++ct) gu[ct] = *(const GAS v2u*)(Z + orow * DIN + ZU + 128 * g + 16 * ct + 4 * g4);
    const float bsv = bs[g * 128 + 16 * w + c];
    __syncthreads();
    const int nks = (16 * w + 15) / 32 + 1;
    f32x4 acc[8];
#pragma unroll
    for (int ct = 0; ct < 8; ++ct) acc[ct] = (f32x4){0.f, 0.f, 0.f, 0.f};
    for (int ks = 0; ks < nks; ++ks) {
        const bf16x8v bW = *(const LAS bf16x8v*)(lds + GM_W + (16 * w + c) * GM_P + (32 * ks + 8 * g4) * 2);
#pragma unroll
        for (int ct = 0; ct < 8; ++ct) { const bf16x8v aV = hc_tr8(lds + GM_VN + (32 * ks + 8 * g4 + q) * GM_P + (16 * ct + 4 * p) * 2, 4 * GM_P);
            acc[ct] = __builtin_amdgcn_mfma_f32_16x16x32_bf16(aV, bW, acc[ct], 0, 0, 0); } }
#pragma unroll
    for (int ct = 0; ct < 8; ++ct) { v2u o; o.x = pg8::cvt_pk_bf16(bflo(gu[ct].x) * (acc[ct][0] + bsv), bfhi(gu[ct].x) * (acc[ct][1] + bsv)); o.y = pg8::cvt_pk_bf16(bflo(gu[ct].y) * (acc[ct][2] + bsv), bfhi(gu[ct].y) * (acc[ct][3] + bsv));
        *(GAS v2u*)(OB + orow * 512 + 128 * g + 16 * ct + 4 * g4) = o; }
    __syncthreads();
}
struct Args { const float* in[22]; float* out; unsigned char* ws; };
__global__ void __launch_bounds__(NWAVES * 64, 2) mk_fwd(Args args) {
    extern __shared__ __attribute__((aligned(16))) unsigned char lds[];
    LAS unsigned char* L = (LAS unsigned char*)lds;
    volatile LAS unsigned* MISC = (volatile LAS unsigned*)(L + MISC_OFF);
    const int tid = threadIdx.x, lane = tid & 63, wave = __builtin_amdgcn_readfirstlane(tid >> 6);
    const int G = gridDim.x, bx = blockIdx.x;
    const int vcu = (G % 8 == 0) ? (bx % 8) * (G / 8) + bx / 8 : bx;
    unsigned char* ws = args.ws;
    for (int u = tid; u < (LDS_BYTES - LDSCTL_OFF) / 4; u += NT) ((LAS unsigned*)(L + LDSCTL_OFF))[u] = 0u;
    __syncthreads();
    XcdBarrier bar = xcd_barrier_post((unsigned*)(ws + WS_CTL) + CW_BAR, MISC + 8);

    const float* x_prompt = args.in[0]; const float* x_sample = args.in[1]; const float* state_hgrn = args.in[2]; const float* cache_conv = args.in[3];
    const float* lb_param = args.in[4]; const float* mix_pre_g = args.in[5]; const float* w_in = args.in[6]; const float* hgrn_norm_g = args.in[7];
    const float* gmlp_ln_g = args.in[8]; const float* gmlp_ln_b = args.in[9]; const float* w_s = args.in[10]; const float* b_s = args.in[11];
    const float* w_pa = args.in[12]; const float* w_pb = args.in[13]; const float* w_o = args.in[14]; const float* mix_post_g = args.in[15];
    const float* ffn_pre_g = args.in[16]; const float* w_up = args.in[17]; const float* conv_w = args.in[18]; const float* conv_b = args.in[19];
    const float* w_down = args.in[20]; const float* ffn_post_g = args.in[21];
    float* out = args.out;
    bf16* WinT = (bf16*)(ws + WS_WIN); bf16* WpaT = (bf16*)(ws + WS_WPA); bf16* WpbT = (bf16*)(ws + WS_WPB); bf16* WoT = (bf16*)(ws + WS_WO);
    bf16* WupT = (bf16*)(ws + WS_WUP); bf16* WdnT = (bf16*)(ws + WS_WDN); float* LB = (float*)(ws + WS_LB); bf16* WSB = (bf16*)(ws + WS_WSB);
    bf16* XN = (bf16*)(ws + WS_XN); bf16* Z = (bf16*)(ws + WS_Z); bf16* OA = (bf16*)(ws + WS_OA); bf16* OB = (bf16*)(ws + WS_OB);
    float* HF = (float*)(ws + WS_HF); bf16* H = (bf16*)(ws + WS_H); float* Y = (float*)(ws + WS_Y); bf16* UP = (bf16*)(ws + WS_UP); bf16* GG = (bf16*)(ws + WS_G);
    float* SLAB8 = (float*)(ws + WS_SLAB8); float* SLAB4 = (float*)(ws + WS_SLAB4); float* SLABA = (float*)(ws + WS_SLABA); float* SLABB = (float*)(ws + WS_SLABB);
    bf16* ZX = (bf16*)out;
    int KSUB = 256; asm volatile("" : "+s"(KSUB));
    float* X1 = out;

    {
        LAS float* scr = (LAS float*)(L + RING_OFF + wave * 16384);
        const int gw = vcu * NWAVES + wave, NGW = G * NWAVES;
        constexpr int I_IN = (D / 64) * (DIN / 32), I_PA = (512 / 64) * (D / 32), I_O = (D / 64) * (D / 32), I_UP = (D / 64) * (FF2 / 32), I_DN = (FF / 64) * (D / 32);
        constexpr int NITEMS = I_IN + 2 * I_PA + I_O + I_UP + I_DN;
        for (int it = gw; it < NITEMS; it += NGW) {
            int r = it;
            if (r < I_IN) { p0_transpose_item(w_in, DIN, WinT, D, 0, scr, r, lane); continue; } r -= I_IN;
            if (r < I_PA) { p0_transpose_item(w_pa, D, WpaT, 512, 0, scr, r, lane); continue; } r -= I_PA;
            if (r < I_PA) { p0_transpose_item(w_pb, D, WpbT, 512, 0, scr, r, lane); continue; } r -= I_PA;
            if (r < I_O) { p0_transpose_item(w_o, D, WoT, D, 0, scr, r, lane); continue; } r -= I_O;
            if (r < I_UP) { p0_transpose_item(w_up, FF2, WupT, D, 0, scr, r, lane); continue; } r -= I_UP;
            p0_transpose_item(w_down, D, WdnT, FF, 0, scr, r, lane);
        }
        for (int m = gw; m < M; m += NGW) { const float* xr = (m < MP) ? x_prompt + (size_t)m * D : x_sample + (size_t)(m - MP) * D; rms_row_to_bf16(xr, mix_pre_g, XN + (size_t)m * D, lane); }
        if (bx >= 8 && bx < 24) for (int i = (bx - 8) * 4096 + tid; i < (bx - 7) * 4096; i += NT) { const int t = (i >> 7) & 127, s_ = i & 127; WSB[i] = (bf16)f2bf(s_ <= t ? w_s[i] : 0.f); }
        if (bx == 0) for (int k = tid; k < 1024; k += NT) LB[k] = 1.0f / (1.0f + __expf(lb_param[1024 + k] - lb_param[k]));
    }
    xcd_barrier(bar);

    { pg8::Gemm g{XN, WinT, M, DIN, D, D, D, 0}; pg8::StaticOrder S; S.init(M, DIN, G, bx); pg8::EpiZ E{Z, LB, ZX};
      pg8::gemm_phase<pg8::EpiZ, pg8::StaticOrder, true, true>(L + RING_OFF, g, S, E); }
    xcd_barrier(bar);

    if (bx < 64) {
        const int b = bx >> 3, h = bx & 7;
        hgrn_chunked(L, Z, ZX, b, h, out + O_SP + (size_t)bx * 8192, OA, hgrn_norm_g, tid);
    } else {
        { const int wi = (bx - 64) * NWAVES + wave; if (wi < 1024) { const int sb = wi >> 3, h = wi & 7;
            hgrn_sample_wave(L + wave * 4096, Z, sb, h, state_hgrn + (size_t)wi * 8192, out + O_SS + (size_t)wi * 8192, OA, hgrn_norm_g, lane); } }
        __syncthreads();
        for (int it = bx - 64; it < 512 + 128; it += G - 64) {
            if (it < 512) { const int b = it >> 6, n = (it >> 2) & 15, g = it & 3; gmlp_prompt_bng(L, Z, b * 2048 + n * 128, g, gmlp_ln_g, gmlp_ln_b, WSB, b_s, OB, tid); }
            else gmlp_sample_item(L, Z, it - 512, gmlp_ln_g, gmlp_ln_b, w_s, b_s, OB, out + O_VS, tid);
        }
    }
    xcd_barrier(bar);

    { pg8::Gemm g{OA, WpaT, MP, D, 512, 512, 512, 0}; pg8::StaticOrder S; S.init(MP, D, G, bx); pg8::EpiGateF32 E{HF, Z, ZGA};
      pg8::gemm_phase<pg8::EpiGateF32, pg8::StaticOrder, false, true>(L + RING_OFF, g, S, E); }
    { pg8::Gemm g{OA, WpaT, M, D, KSUB, 512, 512, 512}; pg8::SampleSplitOrder S{2, bx}; pg8::EpiSlabF32 E{SLABA};
      pg8::gemm_phase<pg8::EpiSlabF32, pg8::SampleSplitOrder, false, true>(L + RING_OFF, g, S, E); }
    xcd_barrier(bar);
    { pg8::Gemm g{OB, WpbT, MP, D, 512, 512, 512, 0}; pg8::StaticOrder S; S.init(MP, D, G, bx); pg8::EpiComb E{H, HF, Z, ZGB};
      pg8::gemm_phase<pg8::EpiComb, pg8::StaticOrder, false, true>(L + RING_OFF, g, S, E); }
    { pg8::Gemm g{OB, WpbT, M, D, KSUB, 512, 512, 512}; pg8::SampleSplitOrder S{2, bx}; pg8::EpiSlabF32 E{SLABB};
      pg8::gemm_phase<pg8::EpiSlabF32, pg8::SampleSplitOrder, false, true>(L + RING_OFF, g, S, E); }
    xcd_barrier(bar);
    {
        for (int r = bx * 2 + (wave >> 2); r < bx * 2 + 2; r += 2) { const int cidx = (wave & 3) * 256 + lane * 4; const size_t o = (size_t)r * 1024 + cidx;
            const f32x4 a0 = *(const GAS f32x4*)(SLABA + o), a1 = *(const GAS f32x4*)(SLABA + 512 * 1024 + o), b0 = *(const GAS f32x4*)(SLABB + o), b1 = *(const GAS f32x4*)(SLABB + 512 * 1024 + o);
            const v2u ga = *(const GAS v2u*)(Z + (size_t)(MP + r) * DIN + ZGA + cidx), gb = *(const GAS v2u*)(Z + (size_t)(MP + r) * DIN + ZGB + cidx);
            v2u hw; hw.x = pk2(bflo(ga.x) * (a0[0] + a1[0]) + bflo(gb.x) * (b0[0] + b1[0]), bfhi(ga.x) * (a0[1] + a1[1]) + bfhi(gb.x) * (b0[1] + b1[1]));
            hw.y = pk2(bflo(ga.y) * (a0[2] + a1[2]) + bflo(gb.y) * (b0[2] + b1[2]), bfhi(ga.y) * (a0[3] + a1[3]) + bfhi(gb.y) * (b0[3] + b1[3]));
            *(GAS v2u*)(H + (size_t)(MP + r) * D + cidx) = hw; }
        publish_count((unsigned*)(ws + WS_CTL) + CW_CNT);
    }
    { pg8::Gemm g{H, WoT, MP, D, D, D, D, 0}; pg8::StaticOrder S; S.init(MP, D, G, bx); pg8::EpiF32 E{Y, D};
      pg8::gemm_phase<pg8::EpiF32, pg8::StaticOrder, false, true>(L + RING_OFF, g, S, E); }
    wait_count((unsigned*)(ws + WS_CTL) + CW_CNT, (unsigned)G, (unsigned*)(ws + WS_CTL) + CW_BAR + XB_TMO);
    { pg8::Gemm g{H, WoT, M, D, KSUB, D, D, 512}; pg8::SampleSplitOrder S{4, bx}; pg8::EpiSlabF32 E{SLAB4};
      pg8::gemm_phase<pg8::EpiSlabF32, pg8::SampleSplitOrder, false, true>(L + RING_OFF, g, S, E); }
    xcd_barrier(bar);
    {
        const int gw = bx * NWAVES + wave, NGW = G * NWAVES;
        for (int m = gw; m < M; m += NGW) {
            const float* xr = (m < MP) ? x_prompt + (size_t)m * D : x_sample + (size_t)(m - MP) * D;
            const GAS f32x4* yr = (const GAS f32x4*)(Y + (size_t)m * D) + lane; const GAS f32x4* xv = (const GAS f32x4*)xr + lane;
            f32x4 y[4]; float s = 0.f;
#pragma unroll
            for (int j = 0; j < 4; ++j) { if (m < MP) y[j] = yr[64 * j]; else { const GAS f32x4* sp = (const GAS f32x4*)(SLAB4 + (size_t)(m - MP) * D) + lane + 64 * j; y[j] = (sp[0] + sp[512 * 256]) + (sp[2 * 512 * 256] + sp[3 * 512 * 256]); }
                s += (y[j].x * y[j].x + y[j].y * y[j].y) + (y[j].z * y[j].z + y[j].w * y[j].w); }
            const float r = 1.0f / sqrtf(wave_sum(s) * (1.f / D) + EPS); float s2 = 0.f;
            GAS f32x4* x1r = (GAS f32x4*)(X1 + (size_t)m * D) + lane;
#pragma unroll
            for (int j = 0; j < 4; ++j) { const f32x4 gg = ((const GAS f32x4*)mix_post_g)[lane + 64 * j]; const f32x4 xx = xv[64 * j];
                y[j].x = xx.x + y[j].x * r * gg.x; y[j].y = xx.y + y[j].y * r * gg.y; y[j].z = xx.z + y[j].z * r * gg.z; y[j].w = xx.w + y[j].w * r * gg.w;
                x1r[64 * j] = y[j]; s2 += (y[j].x * y[j].x + y[j].y * y[j].y) + (y[j].z * y[j].z + y[j].w * y[j].w); }
            const float r2 = 1.0f / sqrtf(wave_sum(s2) * (1.f / D) + EPS);
            GAS v2u* o8 = (GAS v2u*)(XN + (size_t)m * D) + lane;
#pragma unroll
            for (int j = 0; j < 4; ++j) { const f32x4 gg = ((const GAS f32x4*)ffn_pre_g)[lane + 64 * j]; v2u o; o.x = pk2(y[j].x * r2 * gg.x, y[j].y * r2 * gg.y); o.y = pk2(y[j].z * r2 * gg.z, y[j].w * r2 * gg.w); o8[64 * j] = o; }
        }
    }
    xcd_barrier(bar);
    { pg8::Gemm g{XN, WupT, M, FF2, D, D, D, 0}; pg8::StaticOrder S; S.init(M, FF2, G, bx); pg8::EpiBf16<0> E{UP, FF2, nullptr, 0, 0, 1.f};
      pg8::gemm_phase<pg8::EpiBf16<0>, pg8::StaticOrder, true, true>(L + RING_OFF, g, S, E); }
    xcd_barrier(bar);
    for (int it = bx; it < (M / 16) * (FF / 8) / NT; it += G) { const int idx = it * NT + tid; conv_gate_item(UP, cache_conv, conv_w, conv_b, GG, out + O_CP, out + O_CS, idx / (FF / 8), idx % (FF / 8)); }
    xcd_barrier(bar);
    { pg8::Gemm g{GG, WdnT, MP, D, FF, FF, FF, 0}; pg8::StaticOrder S; S.init(MP, D, G, bx); pg8::EpiF32 E{Y, D};
      pg8::gemm_phase<pg8::EpiF32, pg8::StaticOrder, false, true>(L + RING_OFF, g, S, E); }
    { pg8::Gemm g{GG, WdnT, M, D, KSUB, FF, FF, 512}; pg8::SampleSplitOrder S{11, bx}; pg8::EpiSlabF32 E{SLAB8};
      pg8::gemm_phase<pg8::EpiSlabF32, pg8::SampleSplitOrder, false, true>(L + RING_OFF, g, S, E); }
    xcd_barrier(bar);
    {
        const int gw = bx * NWAVES + wave, NGW = G * NWAVES;
        const bool bad = xb_ld((unsigned*)(ws + WS_CTL) + CW_BAR + XB_TMO) != 0u;
        for (int m = gw; m < M; m += NGW) {
            const GAS f32x4* yr = (const GAS f32x4*)(Y + (size_t)m * D) + lane; GAS f32x4* x1r = (GAS f32x4*)(X1 + (size_t)m * D) + lane;
            f32x4 y[4]; float s = 0.f;
#pragma unroll
            for (int j = 0; j < 4; ++j) { if (m < MP) y[j] = yr[64 * j]; else { const GAS f32x4* sp = (const GAS f32x4*)(SLAB8 + (size_t)(m - MP) * D) + lane + 64 * j; f32x4 a = sp[0];
#pragma unroll
                    for (int ks = 1; ks < 11; ++ks) a = a + sp[(size_t)ks * 512 * 256]; y[j] = a; }
                s += (y[j].x * y[j].x + y[j].y * y[j].y) + (y[j].z * y[j].z + y[j].w * y[j].w); }
            float r = 1.0f / sqrtf(wave_sum(s) * (1.f / D) + EPS); if (bad) r = __builtin_nanf("");
#pragma unroll
            for (int j = 0; j < 4; ++j) { const f32x4 gg = ((const GAS f32x4*)ffn_post_g)[lane + 64 * j]; f32x4 xx = x1r[64 * j];
                xx.x += y[j].x * r * gg.x; xx.y += y[j].y * r * gg.y; xx.z += y[j].z * r * gg.z; xx.w += y[j].w * r * gg.w; x1r[64 * j] = xx; }
        }
    }
}

extern "C" void kernel_launch(void* const* d_in, const int* in_sizes, int n_in, void* d_out, int out_size, void* d_ws, size_t ws_size, hipStream_t stream) {
    static int grid = 0;
    if (grid == 0) {
        if (n_in != 22 || (size_t)out_size != O_END || ws_size < WS_END) { fprintf(stderr, "kernel_launch: unexpected shapes (n_in %d out %d ws %zu)\n", n_in, out_size, ws_size); grid = -1; return; }
        int dev = 0, cus = 0, per_cu = 0;
        if (hipGetDevice(&dev) != hipSuccess || hipDeviceGetAttribute(&cus, hipDeviceAttributeMultiprocessorCount, dev) != hipSuccess) { grid = -1; return; }
        if (hipFuncSetAttribute((const void*)mk_fwd, hipFuncAttributeMaxDynamicSharedMemorySize, LDS_BYTES) != hipSuccess) { fprintf(stderr, "kernel_launch: hipFuncSetAttribute failed\n"); grid = -1; return; }
        if (hipOccupancyMaxActiveBlocksPerMultiprocessor(&per_cu, (const void*)mk_fwd, NWAVES * 64, LDS_BYTES) != hipSuccess || per_cu < 1) { fprintf(stderr, "kernel_launch: occupancy query says %d blocks per CU\n", per_cu); (void)hipGetLastError(); grid = -1; return; }
        grid = cus;
        if (grid != 256) { fprintf(stderr, "kernel_launch: built for 256 CUs, found %d\n", cus); grid = -1; return; }
    }
    if (grid < 0) return;
    (void)hipMemsetAsync((char*)d_ws + WS_CTL, 0, CTL_ZERO_BYTES, stream);
    Args a{};
    for (int i = 0; i < 22; ++i) a.in[i] = (const float*)d_in[i];
    a.out = (float*)d_out; a.ws = (unsigned char*)d_ws;
    hipLaunchKernelGGL(mk_fwd, dim3(grid), dim3(NWAVES * 64), LDS_BYTES, stream, a);
}
```

```cpp
#include <hip/hip_runtime.h>
#include <cstdio>
#include <cstdint>
namespace pg8 {
#define PG8_LAS __attribute__((address_space(3)))
typedef unsigned short bf16_t;
typedef short bf16x8 __attribute__((ext_vector_type(8)));
typedef float f32x4 __attribute__((ext_vector_type(4)));
typedef unsigned u32x4 __attribute__((ext_vector_type(4)));
constexpr int BM = 256, BK = 64, HALF = 128, HTB = HALF * BK * 2  , STAGE_BYTES = 8 * HTB, NXCD = 8, WGM = 8;

__host__ __device__ __forceinline__ int lds_byte(int r, int c) { const int st = (r >> 4) * 2 + (c >> 5), rr = r & 15, cc = c & 31, ob = rr * 64 + cc * 2; return st * 1024 + (ob ^ (((ob >> 9) & 1) << 5)); }
__host__ __device__ __forceinline__ void stage_rc(int b, int& R, int& C) { const int st = b / 1024, sb = b % 1024, swz = sb ^ (((sb >> 9) & 1) << 5); R = (st >> 1) * 16 + swz / 64; C = (st & 1) * 32 + (swz % 64) / 2; }
__host__ __device__ __forceinline__ int perm32(int rho) { const int n = rho >> 4, i = rho & 15; return 8 * (i >> 2) + 4 * n + (i & 3); }

struct Unit { int pm, pn, ks; };
struct Gemm { const bf16_t* A; const bf16_t* Bt; int M, N, K, lda, ldb, ksl; };

struct StaticOrder {
    int nM, nN, nwg, G, c;
    __host__ __device__ void init(int M, int N, int G_, int c_) { nM = M / BM; nN = N / BM; nwg = nM * nN; G = G_; c = c_; }
    __host__ __device__ bool next(int i, Unit& u) const {
        const long L = (long)i * G + c; if (L >= nwg) return false;
        int wgid = (int)L; { const int q = nwg / NXCD, r = nwg % NXCD, xcd = wgid % NXCD, off = wgid / NXCD; wgid = (xcd < r ? xcd * (q + 1) : r * (q + 1) + (xcd - r) * q) + off; }
        const int nig = WGM * nN, gid = wgid / nig, fm = gid * WGM, gsz = (nM - fm) < WGM ? (nM - fm) : WGM;
        u.pm = fm + ((wgid % nig) % gsz); u.pn = (wgid % nig) / gsz; u.ks = 0; return true;
    }
    __device__ __forceinline__ void a_ready(const Unit&) const {}
    __device__ __forceinline__ void done(const Unit&) const {}
};

typedef __bf16 bf16x2_t __attribute__((ext_vector_type(2)));
typedef float f32x2_t __attribute__((ext_vector_type(2)));
__device__ __forceinline__ unsigned cvt_pk_bf16(float lo, float hi) { const f32x2_t v = {lo, hi}; const bf16x2_t b = __builtin_convertvector(v, bf16x2_t); return __builtin_bit_cast(unsigned, b); }
typedef float f32x2 __attribute__((ext_vector_type(2)));
__device__ __forceinline__ f32x2 gelu_pk(f32x2 v) {
    const f32x2 av = __builtin_elementwise_abs(v), d = av * 0.2316418882f + 1.0f;
    f32x2 t; t.x = __builtin_amdgcn_rcpf(d.x); t.y = __builtin_amdgcn_rcpf(d.y);
    f32x2 q = t * 0.5307027145f + (-0.7265760135f); q = q * t + 0.7107068705f; q = q * t + (-0.142248368f); q = q * t + 0.127414796f; q = q * t;
    const f32x2 s = (v * v) * (-0.72134752044f);
    f32x2 e; e.x = __builtin_amdgcn_exp2f(s.x); e.y = __builtin_amdgcn_exp2f(s.y);
    const f32x2 m = v * (q * e), r = v - m;
    f32x2 o; o.x = v.x < 0.f ? m.x : r.x; o.y = v.y < 0.f ? m.y : r.y; return o;
}

template <int ACT  > struct EpiBf16 {
    static constexpr bool PERM = true, AFTER_DRAIN = false, HAS_MID = false; static_assert(ACT == 0 || ACT == 1, "EpiBf16: ACT is 0 (none) or 1 (gelu_pk)");
    bf16_t* O; int ldc; const float* bias; int split_cols; size_t split_stride; float scale0;
    __device__ __forceinline__ void operator()(const f32x4 (&acc)[2][2][4][2], const Unit& u, int wr, int wc, int fr, int fq) const {
        const int row0 = u.pm * BM + wr * 64 + fr; int colt = u.pn * BM; bf16_t* base = O;
        float sc = 1.f; if (split_cols) { const int t = colt / split_cols; base += (size_t)t * split_stride; colt -= t * split_cols; if (t == 0) sc = scale0; }
        const int col0 = colt + wc * 32 + 8 * fq, bcol0 = u.pn * BM + wc * 32 + 8 * fq;
        f32x4 bv[2][2];
#pragma unroll
        for (int bj = 0; bj < 2; ++bj)
#pragma unroll
            for (int n = 0; n < 2; ++n) bv[bj][n] = bias ? *(const f32x4*)(bias + bcol0 + bj * HALF + 4 * n) : (f32x4){0.f, 0.f, 0.f, 0.f};
#pragma unroll
        for (int ai = 0; ai < 2; ++ai)
#pragma unroll
            for (int m = 0; m < 4; ++m) { bf16_t* rowp = base + (size_t)(row0 + ai * HALF + m * 16) * ldc + col0;
#pragma unroll
                for (int bj = 0; bj < 2; ++bj) { f32x4 v0 = acc[ai][bj][m][0] + bv[bj][0], v1 = acc[ai][bj][m][1] + bv[bj][1];
                    if (ACT == 1) { f32x2 a = gelu_pk((f32x2){v0[0], v0[1]}), b = gelu_pk((f32x2){v0[2], v0[3]}), c = gelu_pk((f32x2){v1[0], v1[1]}), d = gelu_pk((f32x2){v1[2], v1[3]});
                        v0 = (f32x4){a.x, a.y, b.x, b.y}; v1 = (f32x4){c.x, c.y, d.x, d.y}; }
                    v0 = v0 * sc; v1 = v1 * sc; u32x4 w; w.x = cvt_pk_bf16(v0[0], v0[1]); w.y = cvt_pk_bf16(v0[2], v0[3]); w.z = cvt_pk_bf16(v1[0], v1[1]); w.w = cvt_pk_bf16(v1[2], v1[3]);
                    *(u32x4*)(rowp + bj * HALF) = w; } }
    }
};

template <class Epi, class Sched, bool ALIGN_EPI = false, bool SP2 = false>
__device__ __forceinline__ void gemm_phase(PG8_LAS unsigned char* lds, const Gemm g, const Sched& S, const Epi& E) {
    const int tid = threadIdx.x, wid = __builtin_amdgcn_readfirstlane(tid >> 6), lane = tid & 63, wr = wid >> 2, wc = wid & 3, fr = lane & 15, fq = lane >> 4;
    const int K = g.K, nt = K / BK;
    unsigned voffA[2], voffB[2];
#pragma unroll
    for (int i = 0; i < 2; ++i) { int R, C; stage_rc(tid * 16 + i * 8192, R, C); const int Rb = Epi::PERM ? ((R & ~31) + perm32(R & 31)) : R;
        voffA[i] = (unsigned)(R * g.lda + C) * 2u; voffB[i] = (unsigned)(Rb * g.ldb + C) * 2u; }
    const size_t kstep = (size_t)(BK * 2);
    const size_t hstepA = (size_t)HALF * g.lda * 2, hstepB = (size_t)HALF * g.ldb * 2;
    const size_t tstepA = 2 * hstepA, tstepB = 2 * hstepB;
    const unsigned ldsw = (unsigned)wid * 1024u;
    const int aoff = lds_byte(wr * 64 + fr, fq * 8), boff = lds_byte(wc * 32 + fr, fq * 8);
#define PG8_SA(b, h) (((b) * 2 + (h)) * HTB)
#define PG8_SB(b, h) ((4 + (b) * 2 + (h)) * HTB)
#define PG8_STAGE(bufoff, gbase, voff) do { _Pragma("unroll") for (int _i = 0; _i < 2; ++_i) \
        __builtin_amdgcn_global_load_lds((const unsigned*)((const char*)(gbase) + (voff)[_i]), (PG8_LAS unsigned*)(lds + (bufoff) + ldsw + _i * 8192), 16, 0, 0); } while (0)
#define PG8_LDA(dst, b, h) do { _Pragma("unroll") for (int m = 0; m < 4; ++m) _Pragma("unroll") for (int k = 0; k < 2; ++k) dst[m][k] = *(const PG8_LAS bf16x8*)(lds + PG8_SA(b, h) + aoff + m * 2048 + k * 1024); } while (0)
#define PG8_LDB(dst, b, h) do { _Pragma("unroll") for (int n = 0; n < 2; ++n) _Pragma("unroll") for (int k = 0; k < 2; ++k) dst[n][k] = *(const PG8_LAS bf16x8*)(lds + PG8_SB(b, h) + boff + n * 2048 + k * 1024); } while (0)
#define PG8_MMA(ai, bj, At, Bt) do { __builtin_amdgcn_s_setprio(1); _Pragma("unroll") for (int m = 0; m < 4; ++m) _Pragma("unroll") for (int n = 0; n < 2; ++n) _Pragma("unroll") for (int k = 0; k < 2; ++k) \
        acc[ai][bj][m][n] = __builtin_amdgcn_mfma_f32_16x16x32_bf16(Bt[n][k], At[m][k], acc[ai][bj][m][n], 0, 0, 0); __builtin_amdgcn_s_setprio(0); } while (0)
#define PG8_WAIT_V(n) asm volatile("s_waitcnt vmcnt(" #n ")" ::: "memory")
#define PG8_WAIT_L(n) asm volatile("s_waitcnt lgkmcnt(" #n ")" ::: "memory")
#define PG8_BAR __builtin_amdgcn_s_barrier()
#define PG8_SCHED __builtin_amdgcn_sched_barrier(0)
    Unit cur, nxt; int ui = 0;
    if (!S.next(0, cur)) return;
    f32x4 acc[2][2][4][2];
#pragma unroll
    for (int a = 0; a < 2; ++a)
#pragma unroll
        for (int b = 0; b < 2; ++b)
#pragma unroll
            for (int m = 0; m < 4; ++m)
#pragma unroll
                for (int n = 0; n < 2; ++n) acc[a][b][m][n] = (f32x4){0.f, 0.f, 0.f, 0.f};
    bf16x8 At[4][2], B0[2][2], B1[2][2];
    const char* cA = (const char*)g.A + (size_t)cur.pm * tstepA + (size_t)cur.ks * g.ksl; const char* cB = (const char*)g.Bt + (size_t)cur.pn * tstepB + (size_t)cur.ks * g.ksl;
    S.a_ready(cur);
    if constexpr (SP2) {
        PG8_STAGE(PG8_SB(0, 0), cB, voffB); PG8_STAGE(PG8_SB(0, 1), cB + hstepB, voffB); PG8_STAGE(PG8_SA(0, 0), cA, voffA); PG8_STAGE(PG8_SA(0, 1), cA + hstepA, voffA);
        if (wr == 1) PG8_BAR;
        PG8_WAIT_V(2); PG8_BAR;
        PG8_STAGE(PG8_SB(1, 0), cB + kstep, voffB); PG8_STAGE(PG8_SA(1, 0), cA + kstep, voffA); PG8_STAGE(PG8_SB(1, 1), cB + hstepB + kstep, voffB);
        PG8_WAIT_V(6); PG8_BAR;
    } else {
        PG8_STAGE(PG8_SB(0, 0), cB, voffB); PG8_STAGE(PG8_SA(0, 0), cA, voffA); PG8_STAGE(PG8_SB(0, 1), cB + hstepB, voffB); PG8_STAGE(PG8_SA(0, 1), cA + hstepA, voffA);
        if (wr == 1) PG8_BAR;
        PG8_WAIT_V(4); PG8_BAR;
        PG8_STAGE(PG8_SB(1, 0), cB + kstep, voffB); PG8_STAGE(PG8_SA(1, 0), cA + kstep, voffA); PG8_STAGE(PG8_SB(1, 1), cB + hstepB + kstep, voffB);
        PG8_WAIT_V(6); PG8_BAR;
    }
    for (;;) {
        const bool has_next = S.next(ui + 1, nxt);
        const char* nA = has_next ? (const char*)g.A + (size_t)nxt.pm * tstepA + (size_t)nxt.ks * g.ksl : cA; const char* nB = has_next ? (const char*)g.Bt + (size_t)nxt.pn * tstepB + (size_t)nxt.ks * g.ksl : cB;
        for (int t = 0; t < nt; t += 2) {
            const bool last = (t == nt - 2);
            const char* a1 = cA + (size_t)(t + 1) * kstep;
            const char* a2 = last ? nA : cA + (size_t)(t + 2) * kstep; const char* b2 = last ? nB : cB + (size_t)(t + 2) * kstep;
            const char* a3 = a2 + kstep; const char* b3 = b2 + kstep;
            if (last && has_next) S.a_ready(nxt);
            if constexpr (SP2) {
            PG8_LDB(B0, 0, 0); PG8_LDB(B1, 0, 1); PG8_SCHED; PG8_LDA(At, 0, 0); PG8_STAGE(PG8_SA(1, 1), a1 + hstepA, voffA);
            PG8_WAIT_V(8); PG8_WAIT_L(0); PG8_BAR; PG8_MMA(0, 0, At, B0); PG8_MMA(0, 1, At, B1); PG8_BAR; PG8_SCHED;
            PG8_LDA(At, 0, 1); PG8_STAGE(PG8_SB(0, 0), b2, voffB); PG8_STAGE(PG8_SB(0, 1), b2 + hstepB, voffB); PG8_STAGE(PG8_SA(0, 0), a2, voffA);
            PG8_WAIT_V(8); PG8_WAIT_L(0); PG8_BAR; PG8_MMA(1, 0, At, B0); PG8_MMA(1, 1, At, B1); PG8_BAR; PG8_SCHED;
            PG8_LDB(B0, 1, 0); PG8_LDB(B1, 1, 1); PG8_SCHED; PG8_LDA(At, 1, 0); PG8_STAGE(PG8_SA(0, 1), a2 + hstepA, voffA);
            PG8_WAIT_V(8); PG8_WAIT_L(0); PG8_BAR; PG8_MMA(0, 0, At, B0); PG8_MMA(0, 1, At, B1); PG8_BAR; PG8_SCHED;
            PG8_LDA(At, 1, 1); PG8_STAGE(PG8_SB(1, 0), b3, voffB); PG8_STAGE(PG8_SB(1, 1), b3 + hstepB, voffB); PG8_STAGE(PG8_SA(1, 0), a3, voffA);
            PG8_WAIT_V(8); PG8_WAIT_L(0); PG8_BAR; PG8_MMA(1, 0, At, B0); PG8_MMA(1, 1, At, B1); PG8_BAR; PG8_SCHED;
            } else {
            PG8_LDB(B0, 0, 0); PG8_SCHED; PG8_LDA(At, 0, 0); PG8_STAGE(PG8_SA(1, 1), a1 + hstepA, voffA);
            PG8_WAIT_L(8); PG8_BAR; PG8_WAIT_L(0); PG8_MMA(0, 0, At, B0); PG8_BAR; PG8_SCHED;
            PG8_LDB(B1, 0, 1); PG8_STAGE(PG8_SB(0, 0), b2, voffB);
            PG8_BAR; PG8_WAIT_L(0); PG8_MMA(0, 1, At, B1); PG8_BAR;
            PG8_LDA(At, 0, 1); PG8_STAGE(PG8_SA(0, 0), a2, voffA);
            PG8_BAR; PG8_WAIT_L(0); PG8_MMA(1, 0, At, B0); PG8_BAR; PG8_SCHED;
            PG8_STAGE(PG8_SB(0, 1), b2 + hstepB, voffB);
            PG8_WAIT_V(6); PG8_BAR; PG8_MMA(1, 1, At, B1); PG8_BAR;
            PG8_LDB(B0, 1, 0); PG8_SCHED; PG8_LDA(At, 1, 0); PG8_STAGE(PG8_SA(0, 1), a2 + hstepA, voffA);
            PG8_WAIT_L(8); PG8_BAR; PG8_WAIT_L(0); PG8_MMA(0, 0, At, B0); PG8_BAR; PG8_SCHED;
            PG8_LDB(B1, 1, 1); PG8_STAGE(PG8_SB(1, 0), b3, voffB);
            PG8_BAR; PG8_WAIT_L(0); PG8_MMA(0, 1, At, B1); PG8_BAR;
            PG8_LDA(At, 1, 1); PG8_STAGE(PG8_SA(1, 0), a3, voffA);
            PG8_BAR; PG8_WAIT_L(0); PG8_MMA(1, 0, At, B0); PG8_BAR; PG8_SCHED;
            PG8_STAGE(PG8_SB(1, 1), b3 + hstepB, voffB);
            PG8_WAIT_V(6); PG8_BAR; PG8_MMA(1, 1, At, B1); PG8_BAR;
            }
        }
        if constexpr (ALIGN_EPI) { if (wr == 0) PG8_BAR; }
        if constexpr (!Epi::AFTER_DRAIN) { if constexpr (Epi::HAS_MID) E.run(acc, cur, wr, wc, fr, fq); else E(acc, cur, wr, wc, fr, fq); S.done(cur); }
        if (!has_next) break;
        if (!Epi::HAS_MID || nxt.ks == 0) {
#pragma unroll
        for (int a = 0; a < 2; ++a)
#pragma unroll
            for (int b = 0; b < 2; ++b)
#pragma unroll
                for (int m = 0; m < 4; ++m)
#pragma unroll
                    for (int n = 0; n < 2; ++n) acc[a][b][m][n] = (f32x4){0.f, 0.f, 0.f, 0.f};
        }
        cur = nxt; cA = nA; cB = nB; ++ui;
        if constexpr (ALIGN_EPI) { if (wr == 1) PG8_BAR; }
    }
    PG8_WAIT_V(0);
    if constexpr (!ALIGN_EPI) { if (wr == 0) PG8_BAR; }
    PG8_BAR;
    if constexpr (Epi::AFTER_DRAIN) { E.fused(acc, cur, wr, wc, fr, fq, lds, wid, lane); S.done(cur); }
#undef PG8_SA
#undef PG8_SB
#undef PG8_STAGE
#undef PG8_LDA
#undef PG8_LDB
#undef PG8_MMA
#undef PG8_WAIT_V
#undef PG8_WAIT_L
#undef PG8_BAR
#undef PG8_SCHED
}
struct EpiF32 {
    static constexpr bool PERM = false, AFTER_DRAIN = false, HAS_MID = false;
    float* C; int ldc;
    __device__ __forceinline__ void operator()(const f32x4 (&acc)[2][2][4][2], const Unit& u, int wr, int wc, int fr, int fq) const {
        const int row0 = u.pm * BM + wr * 64 + fr, col0 = u.pn * BM + wc * 32 + 4 * fq;
#pragma unroll
        for (int ai = 0; ai < 2; ++ai)
#pragma unroll
            for (int m = 0; m < 4; ++m) { float* rowp = C + (size_t)(row0 + ai * HALF + m * 16) * ldc + col0;
#pragma unroll
                for (int bj = 0; bj < 2; ++bj)
#pragma unroll
                    for (int n = 0; n < 2; ++n) *(f32x4*)(rowp + bj * HALF + n * 16) = acc[ai][bj][m][n]; }
    }
};
__device__ __forceinline__ float bf_lo(unsigned w) { return __uint_as_float(w << 16); }
__device__ __forceinline__ float bf_hi(unsigned w) { return __uint_as_float(w & 0xffff0000u); }
__device__ __forceinline__ float sigm(float x) { return __builtin_amdgcn_rcpf(1.0f + __builtin_amdgcn_exp2f(-1.4426950408889634f * x)); }
template <int MODE> __device__ __forceinline__ float zact(float x, float lb) {
    if (MODE == 0) return x * sigm(x);
    if (MODE == 1) { const float f = lb + (1.0f - lb) * sigm(x); return 0.6931471805599453f * __builtin_amdgcn_logf(f); }
    if (MODE == 2) return x;
    if (MODE == 3) return x * sigm(1.5957691216057308f * (x + 0.044715f * x * x * x));
    return sigm(x);
}
template <int N> __device__ __forceinline__ float row_shr(float v) {
    return __builtin_bit_cast(float, __builtin_amdgcn_update_dpp(0, __builtin_bit_cast(int, v), 0x110 + N, 0xf, 0xf, true));
}
struct EpiZ {
    static constexpr bool PERM = true, AFTER_DRAIN = false, HAS_MID = false;
    bf16_t* Z; const float* lb; bf16_t* ZX;
    template <int MODE> __device__ __forceinline__ void run(const f32x4 (&acc)[2][2][4][2], const Unit& u, int wr, int wc, int fr, int fq) const {
        const int row0 = u.pm * BM + wr * 64 + fr, col0 = u.pn * BM + wc * 32 + 8 * fq;
        f32x4 lv[2][2];
#pragma unroll
        for (int bj = 0; bj < 2; ++bj)
#pragma unroll
            for (int n = 0; n < 2; ++n) lv[bj][n] = (MODE == 1) ? *(const f32x4*)(lb + (col0 - 1024) + bj * HALF + 4 * n) : (f32x4){0.f, 0.f, 0.f, 0.f};
#pragma unroll
        for (int ai = 0; ai < 2; ++ai)
#pragma unroll
            for (int m = 0; m < 4; ++m) { bf16_t* rowp = Z + (size_t)(row0 + ai * HALF + m * 16) * 6144 + col0;
#pragma unroll
                for (int bj = 0; bj < 2; ++bj) { const f32x4 a = acc[ai][bj][m][0], b = acc[ai][bj][m][1]; const f32x4 l0 = lv[bj][0], l1 = lv[bj][1];
                    u32x4 w; w.x = cvt_pk_bf16(zact<MODE>(a[0], l0[0]), zact<MODE>(a[1], l0[1])); w.y = cvt_pk_bf16(zact<MODE>(a[2], l0[2]), zact<MODE>(a[3], l0[3]));
                    w.z = cvt_pk_bf16(zact<MODE>(b[0], l1[0]), zact<MODE>(b[1], l1[1])); w.w = cvt_pk_bf16(zact<MODE>(b[2], l1[2]), zact<MODE>(b[3], l1[3]));
                    *(u32x4*)(rowp + bj * HALF) = w; } }
    }
    __device__ __forceinline__ void run_hgrn(const f32x4 (&acc)[2][2][4][2], const Unit& u, int wr, int wc, int fr, int fq) const {
        typedef unsigned u32x2 __attribute__((ext_vector_type(2)));
        const int row0 = u.pm * BM + wr * 64 + fr, col0 = u.pn * BM + wc * 32 + 8 * fq, kc0 = col0 - 1024;
#pragma unroll
        for (int ai = 0; ai < 2; ++ai)
#pragma unroll
            for (int bj = 0; bj < 2; ++bj)
#pragma unroll
                for (int n = 0; n < 2; ++n) { const f32x4 l4 = *(const f32x4*)(lb + kc0 + bj * HALF + 4 * n);
                    unsigned wE[4][2], wT[4][2], wH[4][2];
#pragma unroll
                    for (int e2 = 0; e2 < 2; ++e2) { float Ev[4][2], Tv[4][2], Hv[4][2];
#pragma unroll
                        for (int ee = 0; ee < 2; ++ee) { const int e = 2 * e2 + ee; const float lbv = l4[e]; float lfv[4], kkv[4];
#pragma unroll
                            for (int m = 0; m < 4; ++m) { const float x = acc[ai][bj][m][n][e]; const float s = sigm(x); const float f = lbv + (1.0f - lbv) * s;
                                lfv[m] = __builtin_amdgcn_logf(f); kkv[m] = (1.0f - lbv) * (1.0f - s); }
                            float run = 0.f, bc[4];
#pragma unroll
                            for (int m = 0; m < 4; ++m) { float v = lfv[m]; v += row_shr<1>(v); v += row_shr<2>(v); v += row_shr<4>(v); v += row_shr<8>(v);
                                const float tot = __shfl(v, 15, 16); bc[m] = v + run; run += tot; }
                            const float eL = __builtin_amdgcn_exp2f(run);
#pragma unroll
                            for (int m = 0; m < 4; ++m) { const float kt = kkv[m] * __builtin_amdgcn_exp2f(fminf(-bc[m], 120.f));
                                Ev[m][ee] = __builtin_amdgcn_exp2f(bc[m]); Tv[m][ee] = kt; Hv[m][ee] = kt * eL; } }
#pragma unroll
                        for (int m = 0; m < 4; ++m) { wE[m][e2] = cvt_pk_bf16(Ev[m][0], Ev[m][1]); wT[m][e2] = cvt_pk_bf16(Tv[m][0], Tv[m][1]); wH[m][e2] = cvt_pk_bf16(Hv[m][0], Hv[m][1]); } }
#pragma unroll
                    for (int m = 0; m < 4; ++m) { const size_t r = (size_t)(row0 + ai * HALF + m * 16);
                        *(u32x2*)(Z + r * 6144 + col0 + bj * HALF + 4 * n) = (u32x2){wE[m][0], wE[m][1]};
                        *(u32x2*)(ZX + r * 2048 + kc0 + bj * HALF + 4 * n) = (u32x2){wT[m][0], wT[m][1]};
                        *(u32x2*)(ZX + r * 2048 + 1024 + kc0 + bj * HALF + 4 * n) = (u32x2){wH[m][0], wH[m][1]}; }
                    asm volatile("" ::: "memory");
                }
    }
    __device__ __forceinline__ void operator()(const f32x4 (&acc)[2][2][4][2], const Unit& u, int wr, int wc, int fr, int fq) const {
        const int pn = u.pn;
        if (pn < 4) run<0>(acc, u, wr, wc, fr, fq);
        else if (pn < 8) { if (u.pm < 64) run_hgrn(acc, u, wr, wc, fr, fq); else run<1>(acc, u, wr, wc, fr, fq); }
        else if (pn < 10) run<2>(acc, u, wr, wc, fr, fq);
        else if (pn < 12) run<0>(acc, u, wr, wc, fr, fq);
        else if (pn < 16) run<3>(acc, u, wr, wc, fr, fq);
        else run<4>(acc, u, wr, wc, fr, fq);
    }
};
struct EpiGateF32 {
    static constexpr bool PERM = true, AFTER_DRAIN = false, HAS_MID = false;
    float* C; const bf16_t* Z; int gcol;
    __device__ __forceinline__ void operator()(const f32x4 (&acc)[2][2][4][2], const Unit& u, int wr, int wc, int fr, int fq) const {
        const int row0 = u.pm * BM + wr * 64 + fr, col0 = u.pn * BM + wc * 32 + 8 * fq;
#pragma unroll
        for (int ai = 0; ai < 2; ++ai)
#pragma unroll
            for (int m = 0; m < 4; ++m) { const size_t r = (size_t)(row0 + ai * HALF + m * 16);
#pragma unroll
                for (int bj = 0; bj < 2; ++bj) { const u32x4 gw = *(const u32x4*)(Z + r * 6144 + gcol + col0 + bj * HALF);
                    const f32x4 a = acc[ai][bj][m][0], b = acc[ai][bj][m][1];
                    f32x4 o0, o1; o0[0] = a[0] * bf_lo(gw.x); o0[1] = a[1] * bf_hi(gw.x); o0[2] = a[2] * bf_lo(gw.y); o0[3] = a[3] * bf_hi(gw.y);
                    o1[0] = b[0] * bf_lo(gw.z); o1[1] = b[1] * bf_hi(gw.z); o1[2] = b[2] * bf_lo(gw.w); o1[3] = b[3] * bf_hi(gw.w);
                    float* p = C + r * 1024 + col0 + bj * HALF; *(f32x4*)p = o0; *(f32x4*)(p + 4) = o1; } }
    }
};
struct EpiComb {
    static constexpr bool PERM = true, AFTER_DRAIN = false, HAS_MID = false;
    bf16_t* H; const float* Hf; const bf16_t* Z; int gcol;
    __device__ __forceinline__ void operator()(const f32x4 (&acc)[2][2][4][2], const Unit& u, int wr, int wc, int fr, int fq) const {
        const int row0 = u.pm * BM + wr * 64 + fr, col0 = u.pn * BM + wc * 32 + 8 * fq;
#pragma unroll
        for (int ai = 0; ai < 2; ++ai)
#pragma unroll
            for (int m = 0; m < 4; ++m) { const size_t r = (size_t)(row0 + ai * HALF + m * 16);
#pragma unroll
                for (int bj = 0; bj < 2; ++bj) { const u32x4 gw = *(const u32x4*)(Z + r * 6144 + gcol + col0 + bj * HALF);
                    const float* hp = Hf + r * 1024 + col0 + bj * HALF; const f32x4 h0 = *(const f32x4*)hp, h1 = *(const f32x4*)(hp + 4);
                    const f32x4 a = acc[ai][bj][m][0], b = acc[ai][bj][m][1];
                    u32x4 w; w.x = cvt_pk_bf16(h0[0] + a[0] * bf_lo(gw.x), h0[1] + a[1] * bf_hi(gw.x)); w.y = cvt_pk_bf16(h0[2] + a[2] * bf_lo(gw.y), h0[3] + a[3] * bf_hi(gw.y));
                    w.z = cvt_pk_bf16(h1[0] + b[0] * bf_lo(gw.z), h1[1] + b[1] * bf_hi(gw.z)); w.w = cvt_pk_bf16(h1[2] + b[2] * bf_lo(gw.w), h1[3] + b[3] * bf_hi(gw.w));
                    *(u32x4*)(H + r * 1024 + col0 + bj * HALF) = w; } }
    }
};

struct EpiP3 {
    static constexpr bool PERM = true, AFTER_DRAIN = false, HAS_MID = true;
    bf16_t* H; const bf16_t* Z; int gacol, gbcol;
    __device__ __forceinline__ void mid(f32x4 (&acc)[2][2][4][2], const Unit& u, int wr, int wc, int fr, int fq) const {
        const int row0 = u.pm * BM + wr * 64 + fr, col0 = u.pn * BM + wc * 32 + 8 * fq;
#pragma unroll
        for (int ai = 0; ai < 2; ++ai)
#pragma unroll
            for (int m = 0; m < 4; ++m) { const bf16_t* zr = Z + (size_t)(row0 + ai * HALF + m * 16) * 6144 + col0;
#pragma unroll
                for (int bj = 0; bj < 2; ++bj) { const u32x4 ga = *(const u32x4*)(zr + gacol + bj * HALF), gb = *(const u32x4*)(zr + gbcol + bj * HALF);
                    f32x4 r0, r1;
                    r0[0] = bf_lo(ga.x) * __builtin_amdgcn_rcpf(fmaxf(bf_lo(gb.x), 1e-30f)); r0[1] = bf_hi(ga.x) * __builtin_amdgcn_rcpf(fmaxf(bf_hi(gb.x), 1e-30f));
                    r0[2] = bf_lo(ga.y) * __builtin_amdgcn_rcpf(fmaxf(bf_lo(gb.y), 1e-30f)); r0[3] = bf_hi(ga.y) * __builtin_amdgcn_rcpf(fmaxf(bf_hi(gb.y), 1e-30f));
                    r1[0] = bf_lo(ga.z) * __builtin_amdgcn_rcpf(fmaxf(bf_lo(gb.z), 1e-30f)); r1[1] = bf_hi(ga.z) * __builtin_amdgcn_rcpf(fmaxf(bf_hi(gb.z), 1e-30f));
                    r1[2] = bf_lo(ga.w) * __builtin_amdgcn_rcpf(fmaxf(bf_lo(gb.w), 1e-30f)); r1[3] = bf_hi(ga.w) * __builtin_amdgcn_rcpf(fmaxf(bf_hi(gb.w), 1e-30f));
                    acc[ai][bj][m][0] = acc[ai][bj][m][0] * r0; acc[ai][bj][m][1] = acc[ai][bj][m][1] * r1; }
                asm volatile("" ::: "memory"); }
    }
    __device__ __forceinline__ void run(f32x4 (&acc)[2][2][4][2], const Unit& u, int wr, int wc, int fr, int fq) const { if (u.ks == 0) mid(acc, u, wr, wc, fr, fq); else fin(acc, u, wr, wc, fr, fq); }
    __device__ __forceinline__ void fin(const f32x4 (&acc)[2][2][4][2], const Unit& u, int wr, int wc, int fr, int fq) const {
        const int row0 = u.pm * BM + wr * 64 + fr, col0 = u.pn * BM + wc * 32 + 8 * fq;
#pragma unroll
        for (int ai = 0; ai < 2; ++ai)
#pragma unroll
            for (int m = 0; m < 4; ++m) { const size_t r = (size_t)(row0 + ai * HALF + m * 16);
#pragma unroll
                for (int bj = 0; bj < 2; ++bj) { const u32x4 gw = *(const u32x4*)(Z + r * 6144 + gbcol + col0 + bj * HALF);
                    const f32x4 a = acc[ai][bj][m][0], b = acc[ai][bj][m][1];
                    u32x4 w; w.x = cvt_pk_bf16(a[0] * bf_lo(gw.x), a[1] * bf_hi(gw.x)); w.y = cvt_pk_bf16(a[2] * bf_lo(gw.y), a[3] * bf_hi(gw.y));
                    w.z = cvt_pk_bf16(b[0] * bf_lo(gw.z), b[1] * bf_hi(gw.z)); w.w = cvt_pk_bf16(b[2] * bf_lo(gw.w), b[3] * bf_hi(gw.w));
                    *(u32x4*)(H + r * 1024 + col0 + bj * HALF) = w; } }
    }
};
struct PairKOrder {
    StaticOrder base;
    __device__ __forceinline__ bool next(int i, Unit& u) const { if (!base.next(i >> 1, u)) return false; u.ks = i & 1; return true; }
    __device__ __forceinline__ void a_ready(const Unit&) const {}
    __device__ __forceinline__ void done(const Unit&) const {}
};
struct SampleSplitOrder {
    int KS, c;
    __device__ __forceinline__ bool next(int i, Unit& u) const { if (i > 0 || c >= 8 * KS) return false; u.ks = c % KS; const int t = c / KS; u.pn = t & 3; u.pm = 64 + (t >> 2); return true; }
    __device__ __forceinline__ void a_ready(const Unit&) const {}
    __device__ __forceinline__ void done(const Unit&) const {}
};
struct EpiSlabF32 {
    static constexpr bool PERM = false, AFTER_DRAIN = false, HAS_MID = false;
    float* S;
    __device__ __forceinline__ void operator()(const f32x4 (&acc)[2][2][4][2], const Unit& u, int wr, int wc, int fr, int fq) const {
        const int row0 = (u.pm - 64) * BM + wr * 64 + fr, col0 = u.pn * BM + wc * 32 + 4 * fq; float* base = S + (size_t)u.ks * 512 * 1024;
#pragma unroll
        for (int ai = 0; ai < 2; ++ai)
#pragma unroll
            for (int m = 0; m < 4; ++m) { float* rowp = base + (size_t)(row0 + ai * HALF + m * 16) * 1024 + col0;
#pragma unroll
                for (int bj = 0; bj < 2; ++bj)
#pragma unroll
                    for (int n = 0; n < 2; ++n) *(f32x4*)(rowp + bj * HALF + n * 16) = acc[ai][bj][m][n]; }
    }
};
}
constexpr int NWAVES = 8, NT = 512;
constexpr int MP = 16384, MS = 512, M = MP + MS;
constexpr int D = 1024, DIN = 6144, FF = 2816, FF2 = 5632;
constexpr int ZQ = 0, ZF = 1024, ZI = 2048, ZOG = 2560, ZU = 3072, ZV = 3584, ZGA = 4096, ZGB = 5120;
constexpr float EPS = 1e-6f;
constexpr int LDO = 1024;
constexpr size_t O_YP = 0, O_YS = 16777216, O_SP = 17301504, O_SS = 17825792, O_CP = 26214400, O_CS = 26304512, O_VS = 27746304, O_END = 28008448;
constexpr size_t MiB = 1u << 20, KiB = 1u << 10;
constexpr size_t WS_CTL = 0, CTL_ZERO_BYTES = 1 * MiB;
constexpr size_t WS_WIN = 1 * MiB, WS_WPA = 13 * MiB, WS_WPB = 14 * MiB, WS_WO = 15 * MiB, WS_WUP = 17 * MiB, WS_WDN = 28 * MiB;
constexpr size_t WS_LB = 33 * MiB + 512 * KiB;
constexpr size_t WS_WSB = 33 * MiB + 576 * KiB;
constexpr size_t WS_XN = 34 * MiB;
constexpr size_t WS_Z = 67 * MiB;
constexpr size_t WS_OA = 265 * MiB;
constexpr size_t WS_HF = 298 * MiB;
constexpr size_t WS_H = 364 * MiB;
constexpr size_t WS_Y = 67 * MiB;
constexpr size_t WS_UP = 133 * MiB;
constexpr size_t WS_G = 314 * MiB + 512 * KiB;
constexpr size_t WS_SLAB8 = 34 * MiB;
constexpr size_t WS_SLAB4 = 406 * MiB;
constexpr size_t WS_SLABP = 414 * MiB;
constexpr size_t WS_END = 422 * MiB;
constexpr int CW_CNT = 8192;
constexpr int CW_BAR = 4096;

constexpr int RING_OFF = 0, RING_BYTES = 131072;
constexpr int LDSCTL_OFF = RING_BYTES, MISC_OFF = LDSCTL_OFF + 320;
constexpr int AUX_OFF = RING_BYTES + 1024;
constexpr int LDS_BYTES = 147456;

#define GAS __attribute__((address_space(1)))
#define LAS __attribute__((address_space(3)))
typedef unsigned short bf16;
typedef unsigned v4u __attribute__((ext_vector_type(4)));
typedef unsigned v2u __attribute__((ext_vector_type(2)));
typedef float f32x4 __attribute__((ext_vector_type(4)));
#define LDS_WAIT() asm volatile("s_waitcnt lgkmcnt(0)" ::: "memory")
__device__ __forceinline__ unsigned f2bf(float f) { unsigned u = __builtin_bit_cast(unsigned, f); return (u + 0x7fffu + ((u >> 16) & 1u)) >> 16; }
__device__ __forceinline__ unsigned pk2(float lo, float hi) { return f2bf(lo) | (f2bf(hi) << 16); }
__device__ __forceinline__ float bf2f(unsigned short h) { return __uint_as_float(((unsigned)h) << 16); }
__device__ __forceinline__ float bflo(unsigned w) { return __uint_as_float(w << 16); }
__device__ __forceinline__ float bfhi(unsigned w) { return __uint_as_float(w & 0xffff0000u); }
__device__ __forceinline__ float wave_sum(float v) {
#pragma unroll
    for (int o = 1; o < 64; o <<= 1) v += __shfl_xor(v, o);
    return v;
}

#define XB_TMO      128
#define XB_XCNT(j)  (256  + 64 * (j))
#define XB_XSUB(j)  (1280 + 64 * (j))
#define XB_XGEN(j)  (2304 + 64 * (j))
#define XB_TOP      3328
#define XB_TOPGEN   3392
#define XCD_BAR_WORDS 3456
#define XB_SPIN_CAP (1u << 18)
__device__ __forceinline__ unsigned xb_ld(unsigned* p)              { return __hip_atomic_load(p, __ATOMIC_RELAXED, __HIP_MEMORY_SCOPE_AGENT); }
__device__ __forceinline__ unsigned xb_add(unsigned* p, unsigned v) { return __hip_atomic_fetch_add(p, v, __ATOMIC_RELAXED, __HIP_MEMORY_SCOPE_AGENT); }
__device__ __forceinline__ unsigned xb_xcc_id() { return (unsigned)__builtin_amdgcn_s_getreg((3 << 11) | 20) & 0xFu; }
#define XB_SPIN(cond, bar) do { unsigned _sp = 0; while (cond) { __builtin_amdgcn_s_sleep(1); \
    if ((++_sp & 255u) == 0u) { if (xb_ld(&(bar)[XB_TMO])) break; if (_sp > XB_SPIN_CAP) { atomicAdd(&(bar)[XB_TMO], 1u); break; } } } } while (0)
struct XcdBarrier { unsigned* bar; unsigned x; volatile LAS unsigned* st; };
__device__ __forceinline__ XcdBarrier xcd_barrier_post(unsigned* bar, volatile LAS unsigned* st) {
    XcdBarrier b; b.bar = bar; b.x = xb_xcc_id(); b.st = st;
    if (threadIdx.x == 0) (void)xb_add(&bar[XB_XCNT(b.x)], 1u);
    return b;
}
__device__ __forceinline__ void xcd_barrier_complete(unsigned* bar, unsigned x, unsigned& nloc, unsigned& nx) {
    const unsigned G = gridDim.x * gridDim.y * gridDim.z;
    unsigned sum, cnt, mine, sp = 0u;
    for (;;) {
        sum = 0u; cnt = 0u; mine = 0u;
#pragma unroll
        for (unsigned j = 0; j < 16; ++j) { const unsigned c = xb_ld(&bar[XB_XCNT(j)]); sum += c; cnt += (c > 0u) ? 1u : 0u; mine = (j == x) ? c : mine; }
        if (sum == G) break;
        __builtin_amdgcn_s_sleep(1);
        if ((++sp & 255u) == 0u) { if (xb_ld(&bar[XB_TMO])) break; if (sp > XB_SPIN_CAP) { atomicAdd(&bar[XB_TMO], 1u); break; } }
    }
    nloc = mine > 0u ? mine : 1u; nx = cnt > 0u ? cnt : 1u;
}
__device__ __forceinline__ void xcd_barrier(const XcdBarrier& b) {
    asm volatile("s_waitcnt vmcnt(0)" ::: "memory");
    __syncthreads();
    if (threadIdx.x == 0) {
        unsigned* bar = b.bar;
        __builtin_amdgcn_s_waitcnt(0);
        unsigned nloc = b.st[0], nx = b.st[1];
        if (nloc == 0u) { xcd_barrier_complete(bar, b.x, nloc, nx); b.st[0] = nloc; b.st[1] = nx; }
        const unsigned old = xb_add(&bar[XB_XSUB(b.x)], 1u);
        const unsigned gen = old / nloc;
        if (old + 1u == (gen + 1u) * nloc) {
            __builtin_amdgcn_fence(__ATOMIC_RELEASE, "agent");
            asm volatile("s_waitcnt vmcnt(0)" ::: "memory");
            const unsigned og = xb_add(&bar[XB_TOP], 1u);
            const unsigned tg = og / nx;
            if (og + 1u == (tg + 1u) * nx) xb_add(&bar[XB_TOPGEN], 1u);
            else XB_SPIN(xb_ld(&bar[XB_TOPGEN]) == tg, bar);
            __builtin_amdgcn_fence(__ATOMIC_ACQUIRE, "agent");
            xb_add(&bar[XB_XGEN(b.x)], 1u);
            asm volatile("s_waitcnt vmcnt(0)" ::: "memory");
        } else {
            XB_SPIN(xb_ld(&bar[XB_XGEN(b.x)]) == gen, bar);
            __builtin_amdgcn_fence(__ATOMIC_ACQUIRE, "agent");
            asm volatile("s_waitcnt vmcnt(0)" ::: "memory");
        }
    }
    __syncthreads();
}

__device__ __forceinline__ void publish_count(unsigned* cnt) {
    asm volatile("s_waitcnt vmcnt(0)" ::: "memory"); __syncthreads();
    if (threadIdx.x == 0) { __builtin_amdgcn_fence(__ATOMIC_RELEASE, "agent"); asm volatile("s_waitcnt vmcnt(0)" ::: "memory"); (void)xb_add(cnt, 1u); }
}
__device__ __forceinline__ void wait_count(unsigned* cnt, unsigned need, unsigned* tmo) {
    if (threadIdx.x < 64) { unsigned sp = 0;
        while ((unsigned)__builtin_amdgcn_readfirstlane(xb_ld(cnt)) < need) { __builtin_amdgcn_s_sleep(2); if (++sp > (1u << 20)) { if (threadIdx.x == 0) atomicAdd(tmo, 1u); break; } }
        __builtin_amdgcn_fence(__ATOMIC_ACQUIRE, "agent"); asm volatile("s_waitcnt vmcnt(0)" ::: "memory"); }
    __syncthreads();
}

__device__ __forceinline__ void p0_transpose_item(const float* W, int N, bf16* WT, int ldwt, int koff, LAS float* scr, int item, int lane) {
    const int nblk = N / 32, kb = item / nblk, nb = item % nblk, k0 = 64 * kb, n0 = 32 * nb;
#pragma unroll 8
    for (int i = 0; i < 32; ++i) { const int kk = 2 * i + (lane >> 5); scr[kk * 33 + (lane & 31)] = W[(size_t)(k0 + kk) * N + n0 + (lane & 31)]; }
    LDS_WAIT(); asm volatile("" ::: "memory");
    const int c = lane & 7;
#pragma unroll
    for (int j = 0; j < 4; ++j) { const int n = (lane >> 3) + 8 * j; const LAS float* s = scr + (8 * c) * 33 + n;
        v4u o; o.x = pk2(s[0 * 33], s[1 * 33]); o.y = pk2(s[2 * 33], s[3 * 33]); o.z = pk2(s[4 * 33], s[5 * 33]); o.w = pk2(s[6 * 33], s[7 * 33]);
        *(GAS v4u*)(WT + (size_t)(n0 + n) * ldwt + koff + k0 + 8 * c) = o; }
    LDS_WAIT(); asm volatile("" ::: "memory");
}
__device__ __forceinline__ void rms_row_to_bf16(const float* xrow, const float* g, bf16* orow, int lane) {
    const GAS f32x4* xr = (const GAS f32x4*)xrow + lane; const GAS f32x4* gr = (const GAS f32x4*)g + lane;
    f32x4 v[4]; float s = 0.f;
#pragma unroll
    for (int j = 0; j < 4; ++j) { v[j] = xr[64 * j]; s += (v[j].x * v[j].x + v[j].y * v[j].y) + (v[j].z * v[j].z + v[j].w * v[j].w); }
    const float r = 1.0f / sqrtf(wave_sum(s) * (1.f / D) + EPS);
    GAS v2u* o8 = (GAS v2u*)orow + lane;
#pragma unroll
    for (int j = 0; j < 4; ++j) { const f32x4 gg = gr[64 * j]; v2u o; o.x = pk2(v[j].x * r * gg.x, v[j].y * r * gg.y); o.y = pk2(v[j].z * r * gg.z, v[j].w * r * gg.w); o8[64 * j] = o; }
}
constexpr int HG_TB = 16;
__device__ __forceinline__ void hgrn_recurrent(LAS unsigned char* lds, const bf16* Z, int row0, int T, int h, const float* S0, float* Sout, bf16* OA, const float* ng, int tid) {
    LAS float* Lq = (LAS float*)lds;
    LAS float* Lf = Lq + HG_TB * 128;
    LAS float* Li = Lf + HG_TB * 128;
    LAS float* Lo = Li + HG_TB * 64;
    const int lane = tid & 63, kg = tid >> 6;
    float S[16];
#pragma unroll
    for (int j = 0; j < 16; ++j) S[j] = S0 ? S0[(size_t)(16 * kg + j) * 64 + lane] : 0.f;
    const float gn = ng[lane];
    for (int t0 = 0; t0 < T; t0 += HG_TB) {
        const int nb = (T - t0) < HG_TB ? (T - t0) : HG_TB;
        for (int idx = tid; idx < nb * 128; idx += NT) { const int t = idx >> 7, k = idx & 127; const bf16* zr = Z + (size_t)(row0 + t0 + t) * DIN;
            Lq[idx] = bf2f(zr[ZQ + h * 128 + k]); Lf[idx] = __expf(bf2f(zr[ZF + h * 128 + k])); }
        for (int idx = tid; idx < nb * 64; idx += NT) { const int t = idx >> 6, v = idx & 63; Li[idx] = bf2f(Z[(size_t)(row0 + t0 + t) * DIN + ZI + h * 64 + v]); }
        __syncthreads();
        for (int t = 0; t < nb; ++t) {
            const float iv = Li[t * 64 + lane]; float o = 0.f;
#pragma unroll
            for (int jj = 0; jj < 4; ++jj) { const f32x4 f4 = *(const LAS f32x4*)(Lf + t * 128 + 16 * kg + 4 * jj), q4 = *(const LAS f32x4*)(Lq + t * 128 + 16 * kg + 4 * jj);
#pragma unroll
                for (int e = 0; e < 4; ++e) { const float f = f4[e]; S[4 * jj + e] = f * S[4 * jj + e] + (1.0f - f) * iv; o += q4[e] * S[4 * jj + e]; } }
            Lo[(t * 8 + kg) * 64 + lane] = o;
        }
        __syncthreads();
        for (int t = kg; t < nb; t += 8) {
            float o = 0.f;
#pragma unroll
            for (int w = 0; w < 8; ++w) o += Lo[(t * 8 + w) * 64 + lane];
            const float r = 1.0f / sqrtf(wave_sum(o * o) * (1.f / 64.f) + EPS);
            const size_t row = (size_t)(row0 + t0 + t);
            const float gs = bf2f(Z[row * DIN + ZOG + h * 64 + lane]);
            OA[row * 512 + h * 64 + lane] = (bf16)f2bf(o * r * gn * gs);
        }
    }
    if (Sout) {
#pragma unroll
        for (int j = 0; j < 16; ++j) Sout[(size_t)(16 * kg + j) * 64 + lane] = S[j];
    }
    __syncthreads();
}

__device__ __forceinline__ void gmlp_prompt_item(LAS unsigned char* lds, const bf16* Z, int r0, int g, const float* lng, const float* lnb, const float* ws, const float* bs, bf16* OB, int tid) {
    LAS float* VN = (LAS float*)lds;
    LAS float* WT = VN + 128 * 128;
    LAS float* ST = (LAS float*)(lds + AUX_OFF);
    const int lane = tid & 63, wave = tid >> 6;
    for (int rr = 0; rr < 16; ++rr) { const int row = 16 * wave + rr; const v4u w = *(const GAS v4u*)(Z + (size_t)(r0 + row) * DIN + ZV + 8 * lane);
        const float a0 = bflo(w.x), a1 = bfhi(w.x), a2 = bflo(w.y), a3 = bfhi(w.y), a4 = bflo(w.z), a5 = bfhi(w.z), a6 = bflo(w.w), a7 = bfhi(w.w);
        const float s = wave_sum(((a0 + a1) + (a2 + a3)) + ((a4 + a5) + (a6 + a7)));
        const float mean = s * (1.f / 512.f);
        const float d0 = a0 - mean, d1 = a1 - mean, d2 = a2 - mean, d3 = a3 - mean, d4 = a4 - mean, d5 = a5 - mean, d6 = a6 - mean, d7 = a7 - mean;
        const float q = wave_sum(((d0 * d0 + d1 * d1) + (d2 * d2 + d3 * d3)) + ((d4 * d4 + d5 * d5) + (d6 * d6 + d7 * d7)));
        if (lane == 0) { ST[2 * row] = mean; ST[2 * row + 1] = 1.0f / sqrtf(q * (1.f / 512.f) + EPS); } }
    const float* wg = ws + (size_t)g * 128 * 128;
    for (int idx = tid; idx < 128 * 32; idx += NT) { const int t = idx >> 5, s4 = (idx & 31) * 4; const f32x4 w = *(const GAS f32x4*)(wg + t * 128 + s4);
#pragma unroll
        for (int e = 0; e < 4; ++e) WT[(s4 + e) * 128 + t] = (s4 + e <= t) ? w[e] : 0.f; }
    __syncthreads();
    for (int idx = tid; idx < 128 * 16; idx += NT) { const int row = idx >> 4, oc = idx & 15; const v4u w = *(const GAS v4u*)(Z + (size_t)(r0 + row) * DIN + ZV + 128 * g + 8 * oc);
        const float mean = ST[2 * row], rstd = ST[2 * row + 1]; const float* gp = lng + 128 * g + 8 * oc; const float* bp = lnb + 128 * g + 8 * oc;
        f32x4 o0, o1; o0[0] = (bflo(w.x) - mean) * rstd * gp[0] + bp[0]; o0[1] = (bfhi(w.x) - mean) * rstd * gp[1] + bp[1]; o0[2] = (bflo(w.y) - mean) * rstd * gp[2] + bp[2]; o0[3] = (bfhi(w.y) - mean) * rstd * gp[3] + bp[3];
        o1[0] = (bflo(w.z) - mean) * rstd * gp[4] + bp[4]; o1[1] = (bfhi(w.z) - mean) * rstd * gp[5] + bp[5]; o1[2] = (bflo(w.w) - mean) * rstd * gp[6] + bp[6]; o1[3] = (bfhi(w.w) - mean) * rstd * gp[7] + bp[7];
        *(LAS f32x4*)(VN + row * 128 + 8 * oc) = o0; *(LAS f32x4*)(VN + row * 128 + 8 * oc + 4) = o1; }
    __syncthreads();
    const int c = tid & 127, tq = tid >> 7;
    float acc[32];
#pragma unroll
    for (int j = 0; j < 32; ++j) acc[j] = 0.f;
    const int smax = 32 * tq + 32;
    for (int s = 0; s < smax; ++s) { const float vn = VN[s * 128 + c]; const LAS float* wr_ = WT + s * 128 + 32 * tq;
#pragma unroll
        for (int j4 = 0; j4 < 8; ++j4) { const f32x4 w = *(const LAS f32x4*)(wr_ + 4 * j4);
#pragma unroll
            for (int e = 0; e < 4; ++e) acc[4 * j4 + e] += w[e] * vn; } }
    const float* bsg = bs + g * 128;
#pragma unroll
    for (int j = 0; j < 32; ++j) { const int t = 32 * tq + j; const size_t row = (size_t)(r0 + t);
        const float gu = bf2f(Z[row * DIN + ZU + 128 * g + c]);
        OB[row * 512 + 128 * g + c] = (bf16)f2bf(gu * (acc[j] + bsg[t])); }
    __syncthreads();
}

__device__ __forceinline__ void gmlp_sample_item(LAS unsigned char* lds, const bf16* Z, int sb, const float* lng, const float* lnb, const float* ws, const float* bs, bf16* OB, float* vs_out, int tid) {
    LAS float* VN = (LAS float*)lds;
    const int lane = tid & 63, wave = tid >> 6; const int r0 = MP + 4 * sb;
    if (wave < 4) { const int row = wave; const v4u w = *(const GAS v4u*)(Z + (size_t)(r0 + row) * DIN + ZV + 8 * lane);
        float a[8] = {bflo(w.x), bfhi(w.x), bflo(w.y), bfhi(w.y), bflo(w.z), bfhi(w.z), bflo(w.w), bfhi(w.w)};
        const float s = wave_sum(((a[0] + a[1]) + (a[2] + a[3])) + ((a[4] + a[5]) + (a[6] + a[7]))); const float mean = s * (1.f / 512.f); float q = 0.f;
#pragma unroll
        for (int e = 0; e < 8; ++e) { a[e] -= mean; q += a[e] * a[e]; }
        const float rstd = 1.0f / sqrtf(wave_sum(q) * (1.f / 512.f) + EPS);
#pragma unroll
        for (int e = 0; e < 8; ++e) { const float vn = a[e] * rstd * lng[8 * lane + e] + lnb[8 * lane + e]; VN[row * 512 + 8 * lane + e] = vn; vs_out[(size_t)(4 * sb + row) * 512 + 8 * lane + e] = vn; } }
    __syncthreads();
    for (int idx = tid; idx < 4 * 512; idx += NT) { const int t = idx >> 9, c = idx & 511, g = c >> 7; float s = bs[g * 128 + t];
        for (int q = 0; q <= t; ++q) s += ws[(size_t)g * 16384 + t * 128 + q] * VN[q * 512 + c];
        const size_t row = (size_t)(r0 + t); const float gu = bf2f(Z[row * DIN + ZU + c]);
        OB[row * LDO + c] = (bf16)f2bf(gu * s); }
    __syncthreads();
}

__device__ __forceinline__ void conv_gate_item(const bf16* UP, const float* cache, const float* cw, const float* cb, bf16* G, float* cp, float* cs, int rb, int oc) {
    const int j0 = 8 * oc; const int r0 = 16 * rb; const bool sample = r0 >= MP;
    float w0g[8], w1g[8], w2g[8], bg[8], w0v[8], w1v[8], w2v[8], bv[8];
#pragma unroll
    for (int e = 0; e < 8; ++e) { w0g[e] = cw[j0 + e]; w1g[e] = cw[FF2 + j0 + e]; w2g[e] = cw[2 * FF2 + j0 + e]; bg[e] = cb[j0 + e];
        w0v[e] = cw[FF + j0 + e]; w1v[e] = cw[FF2 + FF + j0 + e]; w2v[e] = cw[2 * FF2 + FF + j0 + e]; bv[e] = cb[FF + j0 + e]; }
    float g2[8], g1[8], v2[8], v1[8];
    if (!sample) {
        if ((r0 & 2047) == 0) {
#pragma unroll
            for (int e = 0; e < 8; ++e) { g2[e] = 0.f; g1[e] = 0.f; v2[e] = 0.f; v1[e] = 0.f; }
        } else {
            const v4u a = *(const GAS v4u*)(UP + (size_t)(r0 - 2) * FF2 + j0), b = *(const GAS v4u*)(UP + (size_t)(r0 - 1) * FF2 + j0);
            const v4u c = *(const GAS v4u*)(UP + (size_t)(r0 - 2) * FF2 + FF + j0), d = *(const GAS v4u*)(UP + (size_t)(r0 - 1) * FF2 + FF + j0);
            g2[0] = bflo(a.x); g2[1] = bfhi(a.x); g2[2] = bflo(a.y); g2[3] = bfhi(a.y); g2[4] = bflo(a.z); g2[5] = bfhi(a.z); g2[6] = bflo(a.w); g2[7] = bfhi(a.w);
            g1[0] = bflo(b.x); g1[1] = bfhi(b.x); g1[2] = bflo(b.y); g1[3] = bfhi(b.y); g1[4] = bflo(b.z); g1[5] = bfhi(b.z); g1[6] = bflo(b.w); g1[7] = bfhi(b.w);
            v2[0] = bflo(c.x); v2[1] = bfhi(c.x); v2[2] = bflo(c.y); v2[3] = bfhi(c.y); v2[4] = bflo(c.z); v2[5] = bfhi(c.z); v2[6] = bflo(c.w); v2[7] = bfhi(c.w);
            v1[0] = bflo(d.x); v1[1] = bfhi(d.x); v1[2] = bflo(d.y); v1[3] = bfhi(d.y); v1[4] = bflo(d.z); v1[5] = bfhi(d.z); v1[6] = bflo(d.w); v1[7] = bfhi(d.w);
        }
    }
#pragma unroll 4
    for (int i = 0; i < 16; ++i) {
        const int r = r0 + i;
        if (sample && (i & 3) == 0) { const int sb = (r - MP) >> 2; const float* c0 = cache + (size_t)sb * 2 * FF2;
#pragma unroll
            for (int e = 0; e < 8; ++e) { g2[e] = c0[j0 + e]; g1[e] = c0[FF2 + j0 + e]; v2[e] = c0[FF + j0 + e]; v1[e] = c0[FF2 + FF + j0 + e]; } }
        const v4u a = *(const GAS v4u*)(UP + (size_t)r * FF2 + j0), c = *(const GAS v4u*)(UP + (size_t)r * FF2 + FF + j0);
        float g0[8] = {bflo(a.x), bfhi(a.x), bflo(a.y), bfhi(a.y), bflo(a.z), bfhi(a.z), bflo(a.w), bfhi(a.w)};
        float v0[8] = {bflo(c.x), bfhi(c.x), bflo(c.y), bfhi(c.y), bflo(c.z), bfhi(c.z), bflo(c.w), bfhi(c.w)};
        float o[8];
#pragma unroll
        for (int e = 0; e < 8; ++e) { const float cg = bg[e] + w0g[e] * g2[e] + w1g[e] * g1[e] + w2g[e] * g0[e]; const float cv = bv[e] + w0v[e] * v2[e] + w1v[e] * v1[e] + w2v[e] * v0[e];
            const float ge = cg * pg8::sigm(1.5957691216057308f * (cg + 0.044715f * cg * cg * cg)); o[e] = ge * cv; }
        v4u ow; ow.x = pk2(o[0], o[1]); ow.y = pk2(o[2], o[3]); ow.z = pk2(o[4], o[5]); ow.w = pk2(o[6], o[7]);
        *(GAS v4u*)(G + (size_t)r * FF + j0) = ow;
        if (!sample) { const int t = r & 2047; if (t >= 2046) { float* dst = cp + ((size_t)(r >> 11) * 2 + (t - 2046)) * FF2;
#pragma unroll
                for (int e = 0; e < 8; ++e) { dst[j0 + e] = g0[e]; dst[FF + j0 + e] = v0[e]; } } }
        else { const int t = (r - MP) & 3; if (t >= 2) { float* dst = cs + ((size_t)((r - MP) >> 2) * 2 + (t - 2)) * FF2;
#pragma unroll
                for (int e = 0; e < 8; ++e) { dst[j0 + e] = g0[e]; dst[FF + j0 + e] = v0[e]; } } }
#pragma unroll
        for (int e = 0; e < 8; ++e) { g2[e] = g1[e]; g1[e] = g0[e]; v2[e] = v1[e]; v1[e] = v0[e]; }
    }
}
typedef short bf16x8v __attribute__((ext_vector_type(8)));
typedef short s16x4 __attribute__((ext_vector_type(4)));
constexpr int HC_PQ = 272, HC_PI = 144;
constexpr int HC_Q0 = 0, HC_KH0 = 17408, HC_I0 = 34816, HC_P0 = 44032, HC_D0 = 53248, HC_BUF = 53760;
constexpr int HC_KT = 2 * HC_BUF, HC_SSQ = HC_KT + 17408, HC_END = HC_SSQ + 1024;
static_assert(HC_END <= RING_BYTES, "HGRN LDS map");
#define HC_BAR() do { asm volatile("s_waitcnt lgkmcnt(0)" ::: "memory"); __builtin_amdgcn_s_barrier(); asm volatile("" ::: "memory"); } while (0)
__device__ __forceinline__ unsigned mul_bf2(unsigned a, unsigned b) { return pg8::cvt_pk_bf16(bflo(a) * bflo(b), bfhi(a) * bfhi(b)); }

struct HcRegs { v4u q[4], e[4], kt[4], kh[4], iv[2]; };
__device__ __forceinline__ void hc_load(HcRegs& R, const bf16* Z, const bf16* ZX, int grow0, int h, int ptid) {
#pragma unroll
    for (int j = 0; j < 4; ++j) { const int id = ptid + 256 * j, row = id >> 4, pc = id & 15; const size_t gr = (size_t)(grow0 + row);
        R.q[j] = *(const GAS v4u*)(Z + gr * DIN + ZQ + 128 * h + 8 * pc); R.e[j] = *(const GAS v4u*)(Z + gr * DIN + ZF + 128 * h + 8 * pc);
        R.kt[j] = *(const GAS v4u*)(ZX + gr * 2048 + 128 * h + 8 * pc); R.kh[j] = *(const GAS v4u*)(ZX + gr * 2048 + 1024 + 128 * h + 8 * pc); }
#pragma unroll
    for (int j = 0; j < 2; ++j) { const int id = ptid + 256 * j, row = id >> 3, pc = id & 7; R.iv[j] = *(const GAS v4u*)(Z + (size_t)(grow0 + row) * DIN + ZI + 64 * h + 8 * pc); }
}
__device__ __forceinline__ void hc_write(const HcRegs& R, LAS unsigned char* lds, LAS unsigned char* Bx, int ptid) {
#pragma unroll
    for (int j = 0; j < 4; ++j) { const int id = ptid + 256 * j, row = id >> 4, pc = id & 15;
        v4u qt; qt.x = mul_bf2(R.q[j].x, R.e[j].x); qt.y = mul_bf2(R.q[j].y, R.e[j].y); qt.z = mul_bf2(R.q[j].z, R.e[j].z); qt.w = mul_bf2(R.q[j].w, R.e[j].w);
        *(LAS v4u*)(Bx + HC_Q0 + row * HC_PQ + pc * 16) = qt;
        *(LAS v4u*)(lds + HC_KT + row * HC_PQ + pc * 16) = R.kt[j];
        *(LAS v4u*)(Bx + HC_KH0 + row * HC_PQ + pc * 16) = R.kh[j];
        if (row == 63) { LAS f32x4* dp = (LAS f32x4*)(Bx + HC_D0 + pc * 32);
            dp[0] = (f32x4){bflo(R.e[j].x), bfhi(R.e[j].x), bflo(R.e[j].y), bfhi(R.e[j].y)}; dp[1] = (f32x4){bflo(R.e[j].z), bfhi(R.e[j].z), bflo(R.e[j].w), bfhi(R.e[j].w)}; } }
#pragma unroll
    for (int j = 0; j < 2; ++j) { const int id = ptid + 256 * j, row = id >> 3, pc = id & 7; *(LAS v4u*)(Bx + HC_I0 + row * HC_PI + pc * 16) = R.iv[j]; }
}
__device__ __forceinline__ void hc_pcomp(LAS unsigned char* lds, LAS unsigned char* Bx, int pw, int c, int g) {
    const int ti = pw, t = 16 * ti + c;
#pragma unroll
    for (int si = 0; si < 4; ++si) { f32x4 acc = {0.f, 0.f, 0.f, 0.f};
        if (si <= ti) {
#pragma unroll
            for (int k4 = 0; k4 < 4; ++k4) { const bf16x8v a = *(const LAS bf16x8v*)(lds + HC_KT + (16 * si + c) * HC_PQ + (32 * k4 + 8 * g) * 2);
                const bf16x8v bq = *(const LAS bf16x8v*)(Bx + HC_Q0 + (16 * ti + c) * HC_PQ + (32 * k4 + 8 * g) * 2);
                acc = __builtin_amdgcn_mfma_f32_16x16x32_bf16(a, bq, acc, 0, 0, 0); } }
        const int s0 = 16 * si + 4 * g;
        v2u w; w.x = pg8::cvt_pk_bf16(s0 <= t ? acc[0] : 0.f, s0 + 1 <= t ? acc[1] : 0.f); w.y = pg8::cvt_pk_bf16(s0 + 2 <= t ? acc[2] : 0.f, s0 + 3 <= t ? acc[3] : 0.f);
        *(LAS v2u*)(Bx + HC_P0 + t * HC_PI + s0 * 2) = w; }
}
__device__ __forceinline__ bf16x8v hc_tr8(const LAS unsigned char* p, int rowpitch4) {
    const s16x4 v0 = __builtin_amdgcn_ds_read_tr16_b64_v4i16((LAS s16x4*)p), v1 = __builtin_amdgcn_ds_read_tr16_b64_v4i16((LAS s16x4*)(p + rowpitch4));
    return __builtin_shufflevector(v0, v1, 0, 1, 2, 3, 4, 5, 6, 7);
}
struct HcCons { f32x4 S[8]; f32x4 O[4]; float gs[16]; };
__device__ __forceinline__ void hc_main(HcCons& K, LAS unsigned char* lds, LAS unsigned char* Bx, int w, int c, int g, int q, int p, const bf16* Z, int grow0, int h) {
    const int vs = 16 * w;
    { const bf16* zc = Z + (size_t)grow0 * DIN + ZOG + 64 * h; const unsigned lo = (unsigned)(4 * g) * DIN + vs + c;
#pragma unroll
      for (int mt = 0; mt < 4; ++mt)
#pragma unroll
        for (int r = 0; r < 4; ++r) K.gs[4 * mt + r] = bf2f(zc[lo + (unsigned)(16 * mt + r) * DIN]); }
    bf16x8v bI[2];
#pragma unroll
    for (int ks = 0; ks < 2; ++ks) bI[ks] = hc_tr8(Bx + HC_I0 + (32 * ks + 8 * g + q) * HC_PI + (vs + 4 * p) * 2, 4 * HC_PI);
#pragma unroll
    for (int mt = 0; mt < 4; ++mt) { K.O[mt] = (f32x4){0.f, 0.f, 0.f, 0.f};
#pragma unroll
        for (int ks = 0; ks < 2; ++ks) { const bf16x8v a = *(const LAS bf16x8v*)(Bx + HC_P0 + (16 * mt + c) * HC_PI + (32 * ks + 8 * g) * 2);
            K.O[mt] = __builtin_amdgcn_mfma_f32_16x16x32_bf16(a, bI[ks], K.O[mt], 0, 0, 0); } }
#pragma unroll
    for (int k4 = 0; k4 < 4; ++k4) {
        v4u sb; sb.x = pg8::cvt_pk_bf16(K.S[2 * k4][0], K.S[2 * k4][1]); sb.y = pg8::cvt_pk_bf16(K.S[2 * k4][2], K.S[2 * k4][3]);
        sb.z = pg8::cvt_pk_bf16(K.S[2 * k4 + 1][0], K.S[2 * k4 + 1][1]); sb.w = pg8::cvt_pk_bf16(K.S[2 * k4 + 1][2], K.S[2 * k4 + 1][3]);
        const bf16x8v bS = __builtin_bit_cast(bf16x8v, sb);
#pragma unroll
        for (int mt = 0; mt < 4; ++mt) { const LAS unsigned char* qp = Bx + HC_Q0 + (16 * mt + c) * HC_PQ + (32 * k4 + 4 * g) * 2;
            const v2u a0 = *(const LAS v2u*)qp, a1 = *(const LAS v2u*)(qp + 32);
            const bf16x8v a = __builtin_bit_cast(bf16x8v, (v4u){a0.x, a0.y, a1.x, a1.y});
            K.O[mt] = __builtin_amdgcn_mfma_f32_16x16x32_bf16(a, bS, K.O[mt], 0, 0, 0); } }
#pragma unroll
    for (int kt = 0; kt < 8; ++kt) { const f32x4 d4 = *(const LAS f32x4*)(Bx + HC_D0 + (16 * kt + 4 * g) * 4); K.S[kt] = K.S[kt] * d4;
#pragma unroll
        for (int ks = 0; ks < 2; ++ks) { const bf16x8v a = hc_tr8(Bx + HC_KH0 + (32 * ks + 8 * g + q) * HC_PQ + (16 * kt + 4 * p) * 2, 4 * HC_PQ);
            K.S[kt] = __builtin_amdgcn_mfma_f32_16x16x32_bf16(a, bI[ks], K.S[kt], 0, 0, 0); } }
    float sq[16];
#pragma unroll
    for (int mt = 0; mt < 4; ++mt)
#pragma unroll
        for (int r = 0; r < 4; ++r) { float s = K.O[mt][r] * K.O[mt][r]; s += pg8::row_shr<1>(s); s += pg8::row_shr<2>(s); s += pg8::row_shr<4>(s); s += pg8::row_shr<8>(s); sq[4 * mt + r] = s; }
    if (c == 15) { LAS float* ssq = (LAS float*)(lds + HC_SSQ);
#pragma unroll
        for (int mt = 0; mt < 4; ++mt)
#pragma unroll
            for (int r = 0; r < 4; ++r) ssq[(16 * mt + 4 * g + r) * 4 + w] = sq[4 * mt + r]; }
}
__device__ __forceinline__ void hc_epi(const HcCons& K, LAS unsigned char* lds, int w, int c, int g, int grow0, int h, bf16* OA, float gn) {
    const LAS f32x4* ssq = (const LAS f32x4*)(lds + HC_SSQ); const int vs = 16 * w;
    bf16* oc = OA + (size_t)grow0 * LDO + 64 * h; const unsigned lo = (unsigned)(4 * g) * LDO + vs + c;
#pragma unroll
    for (int mt = 0; mt < 4; ++mt)
#pragma unroll
        for (int r = 0; r < 4; ++r) { const f32x4 p4 = ssq[16 * mt + 4 * g + r]; const float ss = (p4[0] + p4[1]) + (p4[2] + p4[3]);
            const float rn = __builtin_amdgcn_rsqf(ss * (1.f / 64.f) + EPS);
            oc[lo + (unsigned)(16 * mt + r) * LDO] = (bf16)f2bf(K.O[mt][r] * rn * gn * K.gs[4 * mt + r]); }
}
__device__ __forceinline__ void hgrn_chunked(LAS unsigned char* lds, const bf16* Z, const bf16* ZX, int b, int h, float* Sout, bf16* OA, const float* ng, int tid) {
    const int lane = tid & 63, wave = __builtin_amdgcn_readfirstlane(tid >> 6);
    const int c = lane & 15, g = lane >> 4, q = (lane & 15) >> 2, p = lane & 3;
    const int rowbase = b * 2048; constexpr int NCH = 32;
    if (wave >= 4) {
        const int ptid = tid - 256, pw = wave - 4;
        HcRegs R;
        hc_load(R, Z, ZX, rowbase, h, ptid);
        hc_write(R, lds, lds, ptid);
        hc_load(R, Z, ZX, rowbase + 64, h, ptid);
        HC_BAR();
        hc_pcomp(lds, lds, pw, c, g);
        HC_BAR();
        for (int ch = 0; ch < NCH; ++ch) {
            LAS unsigned char* Bn = lds + ((ch + 1) & 1) * HC_BUF;
            if (ch + 1 < NCH) { hc_write(R, lds, Bn, ptid); if (ch + 2 < NCH) hc_load(R, Z, ZX, rowbase + 64 * (ch + 2), h, ptid); }
            HC_BAR();
            if (ch + 1 < NCH) hc_pcomp(lds, Bn, pw, c, g);
            HC_BAR();
        }
    } else {
        const int w = wave; const float gn = ng[16 * w + c];
        HcCons K;
#pragma unroll
        for (int kt = 0; kt < 8; ++kt) K.S[kt] = (f32x4){0.f, 0.f, 0.f, 0.f};
        HC_BAR();
        HC_BAR();
        for (int ch = 0; ch < NCH; ++ch) {
            LAS unsigned char* Bc = lds + (ch & 1) * HC_BUF;
            hc_main(K, lds, Bc, w, c, g, q, p, Z, rowbase + 64 * ch, h);
            HC_BAR();
            hc_epi(K, lds, w, c, g, rowbase + 64 * ch, h, OA, gn);
            HC_BAR();
        }
#pragma unroll
        for (int kt = 0; kt < 8; ++kt)
#pragma unroll
            for (int r = 0; r < 4; ++r) Sout[(size_t)(16 * kt + 4 * g + r) * 64 + 16 * w + c] = K.S[kt][r];
    }
    __syncthreads();
}

__device__ __forceinline__ void hgrn_sample_wave(LAS unsigned char* wl, const bf16* Z, int sb, int h, const float* S0, float* Sout, bf16* OA, const float* ng, int lane) {
    LAS float* Lq = (LAS float*)wl; LAS float* Lf = Lq + 512;
    const int row0 = MP + 4 * sb;
    float S[128];
#pragma unroll
    for (int k = 0; k < 128; ++k) S[k] = S0[(size_t)k * 64 + lane];
    float iv[4], gs[4];
#pragma unroll
    for (int t = 0; t < 4; ++t) { const bf16* zr = Z + (size_t)(row0 + t) * DIN;
        Lq[t * 128 + lane] = bf2f(zr[ZQ + 128 * h + lane]); Lq[t * 128 + 64 + lane] = bf2f(zr[ZQ + 128 * h + 64 + lane]);
        Lf[t * 128 + lane] = __expf(bf2f(zr[ZF + 128 * h + lane])); Lf[t * 128 + 64 + lane] = __expf(bf2f(zr[ZF + 128 * h + 64 + lane]));
        iv[t] = bf2f(zr[ZI + 64 * h + lane]); gs[t] = bf2f(zr[ZOG + 64 * h + lane]); }
    LDS_WAIT(); asm volatile("" ::: "memory");
    float o[4] = {0.f, 0.f, 0.f, 0.f};
#pragma unroll
    for (int k4 = 0; k4 < 32; ++k4) {
#pragma unroll
        for (int t = 0; t < 4; ++t) { const f32x4 f4 = *(const LAS f32x4*)(Lf + t * 128 + 4 * k4), q4 = *(const LAS f32x4*)(Lq + t * 128 + 4 * k4);
#pragma unroll
            for (int e = 0; e < 4; ++e) { const float f = f4[e]; S[4 * k4 + e] = f * S[4 * k4 + e] + (1.0f - f) * iv[t]; o[t] += q4[e] * S[4 * k4 + e]; } } }
    const float gn = ng[lane];
#pragma unroll
    for (int t = 0; t < 4; ++t) { const float r = 1.0f / sqrtf(wave_sum(o[t] * o[t]) * (1.f / 64.f) + EPS);
        OA[(size_t)(row0 + t) * LDO + 64 * h + lane] = (bf16)f2bf(o[t] * r * gn * gs[t]); }
#pragma unroll
    for (int k = 0; k < 128; ++k) Sout[(size_t)k * 64 + lane] = S[k];
    LDS_WAIT(); asm volatile("" ::: "memory");
}
constexpr int GM_P = 272, GM_VN = 0, GM_W = 34816;
__device__ __forceinline__ void gmlp_prompt_bng(LAS unsigned char* lds, const bf16* Z, int r0, int g, const float* lng, const float* lnb, const bf16* WSB, const float* bs, bf16* OB, int tid) {
    const int lane = tid & 63, w = __builtin_amdgcn_readfirstlane(tid >> 6);
    const int c = lane & 15, g4 = lane >> 4, q = (lane & 15) >> 2, p = lane & 3;
    const int prow = tid >> 4, pc = tid & 15;
    float mean[4], rstd[4];
    {
        v4u vr[16];
#pragma unroll
        for (int j = 0; j < 16; ++j) vr[j] = *(const GAS v4u*)(Z + (size_t)(r0 + prow + 32 * (j >> 2)) * DIN + ZV + 128 * (j & 3) + 8 * pc);
#pragma unroll
        for (int jr = 0; jr < 4; ++jr) { float s = 0.f, qq = 0.f;
#pragma unroll
            for (int gq = 0; gq < 4; ++gq) { const v4u x = vr[4 * jr + gq];
                const float a0 = bflo(x.x), a1 = bfhi(x.x), a2 = bflo(x.y), a3 = bfhi(x.y), a4 = bflo(x.z), a5 = bfhi(x.z), a6 = bflo(x.w), a7 = bfhi(x.w);
                s += ((a0 + a1) + (a2 + a3)) + ((a4 + a5) + (a6 + a7)); qq += ((a0 * a0 + a1 * a1) + (a2 * a2 + a3 * a3)) + ((a4 * a4 + a5 * a5) + (a6 * a6 + a7 * a7)); }
            s += __shfl_xor(s, 1); qq += __shfl_xor(qq, 1); s += __shfl_xor(s, 2); qq += __shfl_xor(qq, 2); s += __shfl_xor(s, 4); qq += __shfl_xor(qq, 4); s += __shfl_xor(s, 8); qq += __shfl_xor(qq, 8);
            mean[jr] = s * (1.f / 512.f); const float var = qq * (1.f / 512.f) - mean[jr] * mean[jr]; rstd[jr] = 1.0f / sqrtf(fmaxf(var, 0.f) + EPS); }
    }
    asm volatile("" ::: "memory");
    {
        const f32x4 ga = *(const GAS f32x4*)(lng + 128 * g + 8 * pc), gb = *(const GAS f32x4*)(lng + 128 * g + 8 * pc + 4);
        const f32x4 ba = *(const GAS f32x4*)(lnb + 128 * g + 8 * pc), bb = *(const GAS f32x4*)(lnb + 128 * g + 8 * pc + 4);
        v4u xg[4];
#pragma unroll
        for (int jr = 0; jr < 4; ++jr) xg[jr] = *(const GAS v4u*)(Z + (size_t)(r0 + prow + 32 * jr) * DIN + ZV + 128 * g + 8 * pc);
#pragma unroll
        for (int jr = 0; jr < 4; ++jr) { const v4u x = xg[jr]; const float m_ = mean[jr], r_ = rstd[jr];
            v4u o; o.x = pg8::cvt_pk_bf16((bflo(x.x) - m_) * r_ * ga[0] + ba[0], (bfhi(x.x) - m_) * r_ * ga[1] + ba[1]); o.y = pg8::cvt_pk_bf16((bflo(x.y) - m_) * r_ * ga[2] + ba[2], (bfhi(x.y) - m_) * r_ * ga[3] + ba[3]);
            o.z = pg8::cvt_pk_bf16((bflo(x.z) - m_) * r_ * gb[0] + bb[0], (bfhi(x.z) - m_) * r_ * gb[1] + bb[1]); o.w = pg8::cvt_pk_bf16((bflo(x.w) - m_) * r_ * gb[2] + bb[2], (bfhi(x.w) - m_) * r_ * gb[3] + bb[3]);
            *(LAS v4u*)(lds + GM_VN + (prow + 32 * jr) * GM_P + pc * 16) = o; }
#pragma unroll
        for (int j2 = 0; j2 < 4; ++j2) { const int id = tid + 512 * j2, t = id >> 4, wp = id & 15;
            *(LAS v4u*)(lds + GM_W + t * GM_P + wp * 16) = *(const GAS v4u*)(WSB + (size_t)g * 16384 + t * 128 + 8 * wp); }
    }
    const size_t orow = (size_t)(r0 + 16 * w + c);
    v2u gu[8];
#pragma unroll
    for (int ct = 0; ct < 8; ++ct) gu[ct] = *(const GAS v2u*)(Z + orow * DIN + ZU + 128 * g + 16 * ct + 4 * g4);
    const float bsv = bs[g * 128 + 16 * w + c];
    __syncthreads();
    const int nks = (16 * w + 15) / 32 + 1;
    f32x4 acc[8];
#pragma unroll
    for (int ct = 0; ct < 8; ++ct) acc[ct] = (f32x4){0.f, 0.f, 0.f, 0.f};
    for (int ks = 0; ks < nks; ++ks) {
        const bf16x8v bW = *(const LAS bf16x8v*)(lds + GM_W + (16 * w + c) * GM_P + (32 * ks + 8 * g4) * 2);
#pragma unroll
        for (int ct = 0; ct < 8; ++ct) { const bf16x8v aV = hc_tr8(lds + GM_VN + (32 * ks + 8 * g4 + q) * GM_P + (16 * ct + 4 * p) * 2, 4 * GM_P);
            acc[ct] = __builtin_amdgcn_mfma_f32_16x16x32_bf16(aV, bW, acc[ct], 0, 0, 0); } }
#pragma unroll
    for (int ct = 0; ct < 8; ++ct) { v2u o; o.x = pg8::cvt_pk_bf16(bflo(gu[ct].x) * (acc[ct][0] + bsv), bfhi(gu[ct].x) * (acc[ct][1] + bsv)); o.y = pg8::cvt_pk_bf16(bflo(gu[ct].y) * (acc[ct][2] + bsv), bfhi(gu[ct].y) * (acc[ct][3] + bsv));
        *(GAS v2u*)(OB + orow * LDO + 128 * g + 16 * ct + 4 * g4) = o; }
    __syncthreads();
}
struct Args { const float* in[22]; float* out; unsigned char* ws; };
__global__ void __launch_bounds__(NWAVES * 64, 2) mk_fwd(Args args) {
    extern __shared__ __attribute__((aligned(16))) unsigned char lds[];
    LAS unsigned char* L = (LAS unsigned char*)lds;
    volatile LAS unsigned* MISC = (volatile LAS unsigned*)(L + MISC_OFF);
    const int tid = threadIdx.x, lane = tid & 63, wave = __builtin_amdgcn_readfirstlane(tid >> 6);
    const int G = gridDim.x, bx = blockIdx.x;
    const int vcu = (G % 8 == 0) ? (bx % 8) * (G / 8) + bx / 8 : bx;
    unsigned char* ws = args.ws;
    for (int u = tid; u < (LDS_BYTES - LDSCTL_OFF) / 4; u += NT) ((LAS unsigned*)(L + LDSCTL_OFF))[u] = 0u;
    __syncthreads();
    XcdBarrier bar = xcd_barrier_post((unsigned*)(ws + WS_CTL) + CW_BAR, MISC + 8);

    const float* x_prompt = args.in[0]; const float* x_sample = args.in[1]; const float* state_hgrn = args.in[2]; const float* cache_conv = args.in[3];
    const float* lb_param = args.in[4]; const float* mix_pre_g = args.in[5]; const float* w_in = args.in[6]; const float* hgrn_norm_g = args.in[7];
    const float* gmlp_ln_g = args.in[8]; const float* gmlp_ln_b = args.in[9]; const float* w_s = args.in[10]; const float* b_s = args.in[11];
    const float* w_pa = args.in[12]; const float* w_pb = args.in[13]; const float* w_o = args.in[14]; const float* mix_post_g = args.in[15];
    const float* ffn_pre_g = args.in[16]; const float* w_up = args.in[17]; const float* conv_w = args.in[18]; const float* conv_b = args.in[19];
    const float* w_down = args.in[20]; const float* ffn_post_g = args.in[21];
    float* out = args.out;
    bf16* WinT = (bf16*)(ws + WS_WIN); bf16* WpaT = (bf16*)(ws + WS_WPA); bf16* WpbT = (bf16*)(ws + WS_WPB); bf16* WoT = (bf16*)(ws + WS_WO);
    bf16* WupT = (bf16*)(ws + WS_WUP); bf16* WdnT = (bf16*)(ws + WS_WDN); float* LB = (float*)(ws + WS_LB); bf16* WSB = (bf16*)(ws + WS_WSB);
    bf16* XN = (bf16*)(ws + WS_XN); bf16* Z = (bf16*)(ws + WS_Z); bf16* OA = (bf16*)(ws + WS_OA); bf16* OB = OA + 512;
    float* HF = (float*)(ws + WS_HF); bf16* H = (bf16*)(ws + WS_H); float* Y = (float*)(ws + WS_Y); bf16* UP = (bf16*)(ws + WS_UP); bf16* GG = (bf16*)(ws + WS_G);
    float* SLAB8 = (float*)(ws + WS_SLAB8); float* SLAB4 = (float*)(ws + WS_SLAB4); float* SLABP = (float*)(ws + WS_SLABP);
    bf16* ZX = (bf16*)out;
    int KSUB = 256; asm volatile("" : "+s"(KSUB));
    float* X1 = out;

    {
        LAS float* scr = (LAS float*)(L + RING_OFF + wave * 16384);
        const int gw = vcu * NWAVES + wave, NGW = G * NWAVES;
        constexpr int I_IN = (D / 64) * (DIN / 32), I_PA = (512 / 64) * (D / 32), I_O = (D / 64) * (D / 32), I_UP = (D / 64) * (FF2 / 32), I_DN = (FF / 64) * (D / 32);
        constexpr int NITEMS = I_IN + 2 * I_PA + I_O + I_UP + I_DN;
        for (int it = gw; it < NITEMS; it += NGW) {
            int r = it;
            if (r < I_IN) { p0_transpose_item(w_in, DIN, WinT, D, 0, scr, r, lane); continue; } r -= I_IN;
            if (r < I_PA) { p0_transpose_item(w_pa, D, WpaT, D, 0, scr, r, lane); continue; } r -= I_PA;
            if (r < I_PA) { p0_transpose_item(w_pb, D, WpaT, D, 512, scr, r, lane); continue; } r -= I_PA;
            if (r < I_O) { p0_transpose_item(w_o, D, WoT, D, 0, scr, r, lane); continue; } r -= I_O;
            if (r < I_UP) { p0_transpose_item(w_up, FF2, WupT, D, 0, scr, r, lane); continue; } r -= I_UP;
            p0_transpose_item(w_down, D, WdnT, FF, 0, scr, r, lane);
        }
        for (int m = gw; m < M; m += NGW) { const float* xr = (m < MP) ? x_prompt + (size_t)m * D : x_sample + (size_t)(m - MP) * D; rms_row_to_bf16(xr, mix_pre_g, XN + (size_t)m * D, lane); }
        if (bx >= 8 && bx < 24) for (int i = (bx - 8) * 4096 + tid; i < (bx - 7) * 4096; i += NT) { const int t = (i >> 7) & 127, s_ = i & 127; WSB[i] = (bf16)f2bf(s_ <= t ? w_s[i] : 0.f); }
        if (bx == 0) for (int k = tid; k < 1024; k += NT) LB[k] = 1.0f / (1.0f + __expf(lb_param[1024 + k] - lb_param[k]));
    }
    xcd_barrier(bar);

    { pg8::Gemm g{XN, WinT, M, DIN, D, D, D, 0}; pg8::StaticOrder S; S.init(M, DIN, G, bx); pg8::EpiZ E{Z, LB, ZX};
      pg8::gemm_phase<pg8::EpiZ, pg8::StaticOrder, true, true>(L + RING_OFF, g, S, E); }
    xcd_barrier(bar);

    if (bx < 64) {
        const int b = bx >> 3, h = bx & 7;
        hgrn_chunked(L, Z, ZX, b, h, out + O_SP + (size_t)bx * 8192, OA, hgrn_norm_g, tid);
    } else {
        { const int wi = (bx - 64) * NWAVES + wave; if (wi < 1024) { const int sb = wi >> 3, h = wi & 7;
            hgrn_sample_wave(L + wave * 4096, Z, sb, h, state_hgrn + (size_t)wi * 8192, out + O_SS + (size_t)wi * 8192, OA, hgrn_norm_g, lane); } }
        __syncthreads();
        for (int it = bx - 64; it < 512 + 128; it += G - 64) {
            if (it < 512) { const int b = it >> 6, n = (it >> 2) & 15, g = it & 3; gmlp_prompt_bng(L, Z, b * 2048 + n * 128, g, gmlp_ln_g, gmlp_ln_b, WSB, b_s, OB, tid); }
            else gmlp_sample_item(L, Z, it - 512, gmlp_ln_g, gmlp_ln_b, w_s, b_s, OB, out + O_VS, tid);
        }
    }
    xcd_barrier(bar);

    { pg8::Gemm g{OA, WpaT, MP, D, 512, D, D, 1024}; pg8::PairKOrder S; S.base.init(MP, D, G, bx); pg8::EpiP3 E{H, Z, ZGA, ZGB};
      pg8::gemm_phase<pg8::EpiP3, pg8::PairKOrder, false, true>(L + RING_OFF, g, S, E); }
    { pg8::Gemm g{OA, WpaT, M, D, KSUB, D, D, 512}; pg8::SampleSplitOrder S{4, bx}; pg8::EpiSlabF32 E{SLABP};
      pg8::gemm_phase<pg8::EpiSlabF32, pg8::SampleSplitOrder, false, true>(L + RING_OFF, g, S, E); }
    xcd_barrier(bar);
    {
        for (int r = bx * 2 + (wave >> 2); r < bx * 2 + 2; r += 2) { const int cidx = (wave & 3) * 256 + lane * 4; const size_t o = (size_t)r * 1024 + cidx;
            const f32x4 a0 = *(const GAS f32x4*)(SLABP + o), a1 = *(const GAS f32x4*)(SLABP + 512 * 1024 + o), b0 = *(const GAS f32x4*)(SLABP + 2 * 512 * 1024 + o), b1 = *(const GAS f32x4*)(SLABP + 3 * 512 * 1024 + o);
            const v2u ga = *(const GAS v2u*)(Z + (size_t)(MP + r) * DIN + ZGA + cidx), gb = *(const GAS v2u*)(Z + (size_t)(MP + r) * DIN + ZGB + cidx);
            v2u hw; hw.x = pk2(bflo(ga.x) * (a0[0] + a1[0]) + bflo(gb.x) * (b0[0] + b1[0]), bfhi(ga.x) * (a0[1] + a1[1]) + bfhi(gb.x) * (b0[1] + b1[1]));
            hw.y = pk2(bflo(ga.y) * (a0[2] + a1[2]) + bflo(gb.y) * (b0[2] + b1[2]), bfhi(ga.y) * (a0[3] + a1[3]) + bfhi(gb.y) * (b0[3] + b1[3]));
            *(GAS v2u*)(H + (size_t)(MP + r) * D + cidx) = hw; }
        publish_count((unsigned*)(ws + WS_CTL) + CW_CNT);
    }
    { pg8::Gemm g{H, WoT, MP, D, D, D, D, 0}; pg8::StaticOrder S; S.init(MP, D, G, bx); pg8::EpiF32 E{Y, D};
      pg8::gemm_phase<pg8::EpiF32, pg8::StaticOrder, false, true>(L + RING_OFF, g, S, E); }
    wait_count((unsigned*)(ws + WS_CTL) + CW_CNT, (unsigned)G, (unsigned*)(ws + WS_CTL) + CW_BAR + XB_TMO);
    { pg8::Gemm g{H, WoT, M, D, KSUB, D, D, 512}; pg8::SampleSplitOrder S{4, bx}; pg8::EpiSlabF32 E{SLAB4};
      pg8::gemm_phase<pg8::EpiSlabF32, pg8::SampleSplitOrder, false, true>(L + RING_OFF, g, S, E); }
    xcd_barrier(bar);
    {
        const int gw = bx * NWAVES + wave, NGW = G * NWAVES;
        for (int m = gw; m < M; m += NGW) {
            const float* xr = (m < MP) ? x_prompt + (size_t)m * D : x_sample + (size_t)(m - MP) * D;
            const GAS f32x4* yr = (const GAS f32x4*)(Y + (size_t)m * D) + lane; const GAS f32x4* xv = (const GAS f32x4*)xr + lane;
            f32x4 y[4]; float s = 0.f;
#pragma unroll
            for (int j = 0; j < 4; ++j) { if (m < MP) y[j] = yr[64 * j]; else { const GAS f32x4* sp = (const GAS f32x4*)(SLAB4 + (size_t)(m - MP) * D) + lane + 64 * j; y[j] = (sp[0] + sp[512 * 256]) + (sp[2 * 512 * 256] + sp[3 * 512 * 256]); }
                s += (y[j].x * y[j].x + y[j].y * y[j].y) + (y[j].z * y[j].z + y[j].w * y[j].w); }
            const float r = 1.0f / sqrtf(wave_sum(s) * (1.f / D) + EPS); float s2 = 0.f;
            GAS f32x4* x1r = (GAS f32x4*)(X1 + (size_t)m * D) + lane;
#pragma unroll
            for (int j = 0; j < 4; ++j) { const f32x4 gg = ((const GAS f32x4*)mix_post_g)[lane + 64 * j]; const f32x4 xx = xv[64 * j];
                y[j].x = xx.x + y[j].x * r * gg.x; y[j].y = xx.y + y[j].y * r * gg.y; y[j].z = xx.z + y[j].z * r * gg.z; y[j].w = xx.w + y[j].w * r * gg.w;
                x1r[64 * j] = y[j]; s2 += (y[j].x * y[j].x + y[j].y * y[j].y) + (y[j].z * y[j].z + y[j].w * y[j].w); }
            const float r2 = 1.0f / sqrtf(wave_sum(s2) * (1.f / D) + EPS);
            GAS v2u* o8 = (GAS v2u*)(XN + (size_t)m * D) + lane;
#pragma unroll
            for (int j = 0; j < 4; ++j) { const f32x4 gg = ((const GAS f32x4*)ffn_pre_g)[lane + 64 * j]; v2u o; o.x = pk2(y[j].x * r2 * gg.x, y[j].y * r2 * gg.y); o.y = pk2(y[j].z * r2 * gg.z, y[j].w * r2 * gg.w); o8[64 * j] = o; }
        }
    }
    xcd_barrier(bar);
    { pg8::Gemm g{XN, WupT, M, FF2, D, D, D, 0}; pg8::StaticOrder S; S.init(M, FF2, G, bx); pg8::EpiBf16<0> E{UP, FF2, nullptr, 0, 0, 1.f};
      pg8::gemm_phase<pg8::EpiBf16<0>, pg8::StaticOrder, true, true>(L + RING_OFF, g, S, E); }
    xcd_barrier(bar);
    for (int it = bx; it < (M / 16) * (FF / 8) / NT; it += G) { const int idx = it * NT + tid; conv_gate_item(UP, cache_conv, conv_w, conv_b, GG, out + O_CP, out + O_CS, idx / (FF / 8), idx % (FF / 8)); }
    xcd_barrier(bar);
    { pg8::Gemm g{GG, WdnT, MP, D, FF, FF, FF, 0}; pg8::StaticOrder S; S.init(MP, D, G, bx); pg8::EpiF32 E{Y, D};
      pg8::gemm_phase<pg8::EpiF32, pg8::StaticOrder, false, true>(L + RING_OFF, g, S, E); }
    { pg8::Gemm g{GG, WdnT, M, D, KSUB, FF, FF, 512}; pg8::SampleSplitOrder S{11, bx}; pg8::EpiSlabF32 E{SLAB8};
      pg8::gemm_phase<pg8::EpiSlabF32, pg8::SampleSplitOrder, false, true>(L + RING_OFF, g, S, E); }
    xcd_barrier(bar);
    {
        const int gw = bx * NWAVES + wave, NGW = G * NWAVES;
        const bool bad = xb_ld((unsigned*)(ws + WS_CTL) + CW_BAR + XB_TMO) != 0u;
        for (int m = gw; m < M; m += NGW) {
            const GAS f32x4* yr = (const GAS f32x4*)(Y + (size_t)m * D) + lane; GAS f32x4* x1r = (GAS f32x4*)(X1 + (size_t)m * D) + lane;
            f32x4 y[4]; float s = 0.f;
#pragma unroll
            for (int j = 0; j < 4; ++j) { if (m < MP) y[j] = yr[64 * j]; else { const GAS f32x4* sp = (const GAS f32x4*)(SLAB8 + (size_t)(m - MP) * D) + lane + 64 * j; f32x4 a = sp[0];
#pragma unroll
                    for (int ks = 1; ks < 11; ++ks) a = a + sp[(size_t)ks * 512 * 256]; y[j] = a; }
                s += (y[j].x * y[j].x + y[j].y * y[j].y) + (y[j].z * y[j].z + y[j].w * y[j].w); }
            float r = 1.0f / sqrtf(wave_sum(s) * (1.f / D) + EPS); if (bad) r = __builtin_nanf("");
#pragma unroll
            for (int j = 0; j < 4; ++j) { const f32x4 gg = ((const GAS f32x4*)ffn_post_g)[lane + 64 * j]; f32x4 xx = x1r[64 * j];
                xx.x += y[j].x * r * gg.x; xx.y += y[j].y * r * gg.y; xx.z += y[j].z * r * gg.z; xx.w += y[j].w * r * gg.w; x1r[64 * j] = xx; }
        }
    }
}

extern "C" void kernel_launch(void* const* d_in, const int* in_sizes, int n_in, void* d_out, int out_size, void* d_ws, size_t ws_size, hipStream_t stream) {
    static int grid = 0;
    if (grid == 0) {
        if (n_in != 22 || (size_t)out_size != O_END || ws_size < WS_END) { fprintf(stderr, "kernel_launch: unexpected shapes (n_in %d out %d ws %zu)\n", n_in, out_size, ws_size); grid = -1; return; }
        int dev = 0, cus = 0, per_cu = 0;
        if (hipGetDevice(&dev) != hipSuccess || hipDeviceGetAttribute(&cus, hipDeviceAttributeMultiprocessorCount, dev) != hipSuccess) { grid = -1; return; }
        if (hipFuncSetAttribute((const void*)mk_fwd, hipFuncAttributeMaxDynamicSharedMemorySize, LDS_BYTES) != hipSuccess) { fprintf(stderr, "kernel_launch: hipFuncSetAttribute failed\n"); grid = -1; return; }
        if (hipOccupancyMaxActiveBlocksPerMultiprocessor(&per_cu, (const void*)mk_fwd, NWAVES * 64, LDS_BYTES) != hipSuccess || per_cu < 1) { fprintf(stderr, "kernel_launch: occupancy query says %d blocks per CU\n", per_cu); (void)hipGetLastError(); grid = -1; return; }
        grid = cus;
        if (grid != 256) { fprintf(stderr, "kernel_launch: built for 256 CUs, found %d\n", cus); grid = -1; return; }
    }
    if (grid < 0) return;
    (void)hipMemsetAsync((char*)d_ws + WS_CTL, 0, CTL_ZERO_BYTES, stream);
    Args a{};
    for (int i = 0; i < 22; ++i) a.in[i] = (const float*)d_in[i];
    a.out = (float*)d_out; a.ws = (unsigned char*)d_ws;
    hipLaunchKernelGGL(mk_fwd, dim3(grid), dim3(NWAVES * 64), LDS_BYTES, stream, a);
}
```
